# Optimizing an MI355X kernel written in HIP

```python
import jax, jax.numpy as jnp
from jax import lax
import numpy as np

D_MODEL = 1024
BATCH = 8
SEQ = 2048
DEPTH = 1
DEC_BATCH = 32
DEC_SEQ = 8
PAST_LEN = 16384
PAGE_SIZE = 128

CHUNK = 128
A_WIDTH = D_MODEL
A_GROUPS = 8
A_GROUP_DIM = A_WIDTH // A_GROUPS
HEAD_DIM = 64
B_SLOTS = 8
DILATED_PAIRS = ((128, 1), (512, 4), (2048, 16))
N_GROUPS_B = len(DILATED_PAIRS)
B_QKV = N_GROUPS_B * B_SLOTS * HEAD_DIM
B_OUT = B_SLOTS * HEAD_DIM
N_BRANCH = 2
IN_SIZES = (A_WIDTH, A_WIDTH, A_WIDTH, B_QKV, B_QKV, B_QKV, B_OUT, N_BRANCH * D_MODEL)
D_IN = sum(IN_SIZES)
SPLIT_IDX = tuple(int(i) for i in np.cumsum(IN_SIZES)[:-1])
EPS = 1e-6
NEG = -1e30

kernel_name = "hybrid_gmlp_dilated_attn_step"


def _rmsnorm(x, g):
    x32 = x.astype(jnp.float32)
    y = x32 * lax.rsqrt(jnp.mean(x32 * x32, axis=-1, keepdims=True) + EPS)
    return (y * g.astype(jnp.float32)).astype(x.dtype)


def _layernorm(x, g, b):
    x32 = x.astype(jnp.float32)
    mu = jnp.mean(x32, axis=-1, keepdims=True)
    var = jnp.mean(jnp.square(x32 - mu), axis=-1, keepdims=True)
    y = (x32 - mu) * lax.rsqrt(var + EPS)
    return (y * g.astype(jnp.float32) + b.astype(jnp.float32)).astype(x.dtype)


def _dilated_prompt(q, k, v, window, dilation):
    b, s, h, dh = q.shape
    n_back = window // dilation
    blk = n_back
    L = s // dilation
    nb = -(-L // blk)
    lp = nb * blk

    def to_phase(a):
        return a.reshape(b, L, dilation, h, dh).transpose(0, 2, 1, 3, 4)

    qp = jnp.pad(to_phase(q), ((0, 0), (0, 0), (0, lp - L), (0, 0), (0, 0)))
    pad_kv = ((0, 0), (0, 0), (blk, lp - L), (0, 0), (0, 0))
    kp = jnp.pad(to_phase(k), pad_kv)
    vp = jnp.pad(to_phase(v), pad_kv)

    def two_blocks(a):
        prev = a[:, :, :lp].reshape(b, dilation, nb, blk, h, dh)
        cur = a[:, :, blk:].reshape(b, dilation, nb, blk, h, dh)
        return jnp.concatenate([prev, cur], axis=3)

    kb, vb = two_blocks(kp), two_blocks(vp)
    qb = qp.reshape(b, dilation, nb, blk, h, dh)
    scores = jnp.einsum("bdnqhc,bdnkhc->bdnhqk", qb, kb).astype(jnp.float32) * (HEAD_DIM ** -0.5)
    qi = np.arange(lp).reshape(nb, blk, 1)
    ki = (np.arange(nb)[:, None, None] - 1) * blk + np.arange(2 * blk)[None, None, :]
    dist = qi - ki
    mask = (dist >= 0) & (dist <= n_back) & (ki >= 0)
    scores = jnp.where(mask[None, None, :, None], scores, NEG)
    m = jnp.max(scores, axis=-1)
    p = jnp.exp(scores - m[..., None])
    l = jnp.sum(p, axis=-1)
    acc = jnp.einsum("bdnhqk,bdnkhc->bdnqhc", p, vb.astype(jnp.float32))
    acc = acc.reshape(b, dilation, lp, h, dh)[:, :, :L].transpose(0, 2, 1, 3, 4).reshape(b, s, h, dh)

    def stat_back(a):
        a = a.transpose(0, 1, 2, 4, 3).reshape(b, dilation, lp, h)[:, :, :L]
        return a.transpose(0, 2, 1, 3).reshape(b, s, h)

    return acc, stat_back(m), stat_back(l)


def _dilated_sample(q, k, v, kv_cache, window, dilation):
    lw = kv_cache.shape[1]
    t = q.shape[1]
    n_keys = window // dilation + 1
    k_all = jnp.concatenate([kv_cache[:, :, 0], k], axis=1)
    v_all = jnp.concatenate([kv_cache[:, :, 1], v], axis=1)
    idx = lw + np.arange(t)[:, None] - dilation * np.arange(n_keys)[None, :]
    valid = idx >= 0
    idx = np.maximum(idx, 0)
    kg = k_all[:, idx]
    vg = v_all[:, idx]
    scores = jnp.einsum("bthc,btkhc->bthk", q, kg).astype(jnp.float32) * (HEAD_DIM ** -0.5)
    scores = jnp.where(valid[None, :, None, :], scores, NEG)
    m = jnp.max(scores, axis=-1)
    p = jnp.exp(scores - m[..., None])
    l = jnp.sum(p, axis=-1)
    acc = jnp.einsum("bthk,btkhc->bthc", p, vg.astype(jnp.float32))
    return acc, m, l


def _layer(x, c, kv_caches, w_cond, b_cond, g_pre, w_in, ln_v_g, ln_v_b,
           w_spatial, b_spatial, w_proj_a, w_proj_b, w_out, g_post):
    bsz, s, _ = x.shape
    mod = jax.nn.silu(c) @ w_cond + b_cond
    shift, scale, gate = jnp.split(mod, 3, axis=-1)
    h = _rmsnorm(x, g_pre) * (1 + scale[:, None, :]) + shift[:, None, :]
    proj = h @ w_in
    u_a, v_a, z_a, q, k, v, z_b, gate_logits = jnp.split(proj, SPLIT_IDX, axis=-1)

    v_n = _layernorm(v_a, ln_v_g, ln_v_b)
    causal = np.tril(np.ones((CHUNK, CHUNK), dtype=bool))
    w_sp = jnp.where(causal[None], w_spatial, 0)
    if kv_caches is None:
        vg = v_n.reshape(bsz, s // CHUNK, CHUNK, A_GROUPS, A_GROUP_DIM)
        zs = jnp.einsum("gts,bnsgc->bntgc", w_sp, vg) + b_spatial.T[None, None, :, :, None]
    else:
        vg = v_n.reshape(bsz, s, A_GROUPS, A_GROUP_DIM)
        zs = jnp.einsum("gts,bsgc->btgc", w_sp[:, :s, :s], vg) + b_spatial[:, :s].T[None, :, :, None]
    y_a = u_a * zs.reshape(bsz, s, A_WIDTH) * jax.nn.silu(z_a)

    q = q.reshape(bsz, s, N_GROUPS_B, B_SLOTS, HEAD_DIM)
    k = k.reshape(bsz, s, N_GROUPS_B, B_SLOTS, HEAD_DIM)
    v = v.reshape(bsz, s, N_GROUPS_B, B_SLOTS, HEAD_DIM)
    accs, ms, ls, kv_rows = [], [], [], []
    for gi, (window, dilation) in enumerate(DILATED_PAIRS):
        qg, kg, vg_ = q[:, :, gi], k[:, :, gi], v[:, :, gi]
        if kv_caches is None:
            acc, m, l = _dilated_prompt(qg, kg, vg_, window, dilation)
            kv_rows.append(jnp.stack([kg, vg_], axis=2)[:, s - min(window, s):])
        else:
            acc, m, l = _dilated_sample(qg, kg, vg_, kv_caches[gi], window, dilation)
            kv_rows.append(jnp.stack([kg, vg_], axis=2))
        accs.append(acc)
        ms.append(m)
        ls.append(l)
    ms = jnp.stack(ms)
    m_all = jnp.max(ms, axis=0)
    wts = jnp.exp(ms - m_all)
    den = jnp.sum(wts * jnp.stack(ls), axis=0)
    attn = jnp.sum(wts[..., None] * jnp.stack(accs), axis=0) / den[..., None]
    y_b = attn.reshape(bsz, s, B_OUT).astype(x.dtype) * jax.nn.silu(z_b)

    g_a, g_b = jnp.split(jax.nn.sigmoid(gate_logits), 2, axis=-1)
    merged = g_a * (y_a @ w_proj_a) + g_b * (y_b @ w_proj_b)
    out = merged @ w_out
    x_new = x + gate[:, None, :] * _rmsnorm(out, g_post)
    return x_new, kv_rows, v_n


def setup_inputs(seed: int = 0) -> dict:
    key = jax.random.key(seed)
    ks = jax.random.split(key, 24)
    f32 = jnp.float32

    def nrm(k_, shape, scale=1.0):
        return jax.random.normal(k_, shape, f32) * scale

    def cache_shape(window):
        return (DEPTH, DEC_BATCH, min(window, PAST_LEN), 2, B_SLOTS, HEAD_DIM)

    return {
        "x_prompt": nrm(ks[0], (BATCH, SEQ, D_MODEL)),
        "x_sample": nrm(ks[1], (DEC_BATCH, DEC_SEQ, D_MODEL)),
        "cache_kv_w128": nrm(ks[2], cache_shape(DILATED_PAIRS[0][0])),
        "cache_kv_w512": nrm(ks[3], cache_shape(DILATED_PAIRS[1][0])),
        "cache_kv_w2048": nrm(ks[4], cache_shape(DILATED_PAIRS[2][0])),
        "c_prompt": nrm(ks[5], (BATCH, D_MODEL)),
        "c_sample": nrm(ks[6], (DEC_BATCH, D_MODEL)),
        "w_cond": nrm(ks[7], (DEPTH, D_MODEL, 3 * D_MODEL), D_MODEL ** -0.5),
        "b_cond": nrm(ks[8], (DEPTH, 3 * D_MODEL), 0.02),
        "g_pre": 1.0 + nrm(ks[9], (DEPTH, D_MODEL), 0.02),
        "w_in": nrm(ks[10], (DEPTH, D_MODEL, D_IN), D_MODEL ** -0.5),
        "ln_v_g": 1.0 + nrm(ks[11], (DEPTH, A_WIDTH), 0.02),
        "ln_v_b": nrm(ks[12], (DEPTH, A_WIDTH), 0.02),
        "w_spatial": nrm(ks[13], (DEPTH, A_GROUPS, CHUNK, CHUNK), CHUNK ** -0.5),
        "b_spatial": 1.0 + nrm(ks[14], (DEPTH, A_GROUPS, CHUNK), 0.02),
        "w_proj_a": nrm(ks[15], (DEPTH, A_WIDTH, D_MODEL), A_WIDTH ** -0.5),
        "w_proj_b": nrm(ks[16], (DEPTH, B_OUT, D_MODEL), B_OUT ** -0.5),
        "w_out": nrm(ks[17], (DEPTH, D_MODEL, D_MODEL), D_MODEL ** -0.5),
        "g_post": 1.0 + nrm(ks[18], (DEPTH, D_MODEL), 0.02),
    }


def reference(x_prompt, x_sample, cache_kv_w128, cache_kv_w512, cache_kv_w2048, c_prompt, c_sample,
              w_cond, b_cond, g_pre, w_in, ln_v_g, ln_v_b, w_spatial, b_spatial,
              w_proj_a, w_proj_b, w_out, g_post):
    caches = (cache_kv_w128, cache_kv_w512, cache_kv_w2048)
    y_p, y_s = x_prompt, x_sample
    kv_p = [[] for _ in DILATED_PAIRS]
    kv_s = [[] for _ in DILATED_PAIRS]
    v_rows = []
    for layer in range(DEPTH):
        params = (w_cond[layer], b_cond[layer], g_pre[layer], w_in[layer], ln_v_g[layer], ln_v_b[layer],
                  w_spatial[layer], b_spatial[layer], w_proj_a[layer], w_proj_b[layer], w_out[layer],
                  g_post[layer])
        y_p, rows_p, _ = _layer(y_p, c_prompt, None, *params)
        layer_caches = (caches[0][layer], caches[1][layer], caches[2][layer])
        y_s, rows_s, v_n_s = _layer(y_s, c_sample, layer_caches, *params)
        for gi in range(N_GROUPS_B):
            kv_p[gi].append(rows_p[gi])
            kv_s[gi].append(rows_s[gi])
        v_rows.append(v_n_s)
    return (y_p, y_s,
            jnp.stack(kv_p[0]), jnp.stack(kv_p[1]), jnp.stack(kv_p[2]),
            jnp.stack(kv_s[0]), jnp.stack(kv_s[1]), jnp.stack(kv_s[2]),
            jnp.stack(v_rows))
```

```cpp
#include <hip/hip_runtime.h>
#include <hip/hip_cooperative_groups.h>
#include <cstdio>
#include <cstdint>
namespace cg = cooperative_groups;
namespace pg8 {
#define PG8_LAS __attribute__((address_space(3)))
typedef unsigned short bf16_t;
typedef short bf16x8 __attribute__((ext_vector_type(8)));
typedef float f32x4 __attribute__((ext_vector_type(4)));
typedef unsigned u32x4 __attribute__((ext_vector_type(4)));
constexpr int BM = 256, BK = 64, HALF = 128, HTB = HALF * BK * 2  , STAGE_BYTES = 8 * HTB, NXCD = 8, WGM = 8;

__host__ __device__ __forceinline__ int lds_byte(int r, int c) { const int st = (r >> 4) * 2 + (c >> 5), rr = r & 15, cc = c & 31, ob = rr * 64 + cc * 2; return st * 1024 + (ob ^ (((ob >> 9) & 1) << 5)); }
__host__ __device__ __forceinline__ void stage_rc(int b, int& R, int& C) { const int st = b / 1024, sb = b % 1024, swz = sb ^ (((sb >> 9) & 1) << 5); R = (st >> 1) * 16 + swz / 64; C = (st & 1) * 32 + (swz % 64) / 2; }
__host__ __device__ __forceinline__ int perm32(int rho) { const int n = rho >> 4, i = rho & 15; return 8 * (i >> 2) + 4 * n + (i & 3); }

struct Unit { int pm, pn; };
struct Gemm { const bf16_t* A; const bf16_t* Bt; int M, N, K; };

struct StaticOrder {
    int nM, nN, nwg, G, c;
    __host__ __device__ void init(int M, int N, int G_, int c_) { nM = M / BM; nN = N / BM; nwg = nM * nN; G = G_; c = c_; }
    __host__ __device__ bool next(int i, Unit& u) const {
        const long L = (long)i * G + c; if (L >= nwg) return false;
        int wgid = (int)L; { const int q = nwg / NXCD, r = nwg % NXCD, xcd = wgid % NXCD, off = wgid / NXCD; wgid = (xcd < r ? xcd * (q + 1) : r * (q + 1) + (xcd - r) * q) + off; }
        const int nig = WGM * nN, gid = wgid / nig, fm = gid * WGM, gsz = (nM - fm) < WGM ? (nM - fm) : WGM;
        u.pm = fm + ((wgid % nig) % gsz); u.pn = (wgid % nig) / gsz; return true;
    }
    __device__ __forceinline__ void a_ready(const Unit&) const {}
    __device__ __forceinline__ void done(const Unit&) const {}
};
__device__ __forceinline__ unsigned cvt_pk_bf16(float lo, float hi) { unsigned r; asm volatile("v_cvt_pk_bf16_f32 %0, %1, %2" : "=v"(r) : "v"(lo), "v"(hi)); return r; }
typedef float f32x2 __attribute__((ext_vector_type(2)));
template <class Epi, class Sched, bool ALIGN_EPI = false, bool SP2 = false>
__device__ __forceinline__ void gemm_phase(PG8_LAS unsigned char* lds, const Gemm g, const Sched& S, const Epi& E) {
    const int tid = threadIdx.x, wid = __builtin_amdgcn_readfirstlane(tid >> 6), lane = tid & 63, wr = wid >> 2, wc = wid & 3, fr = lane & 15, fq = lane >> 4;
    const int K = g.K, nt = K / BK;
    unsigned voffA[2], voffB[2];
#pragma unroll
    for (int i = 0; i < 2; ++i) { int R, C; stage_rc(tid * 16 + i * 8192, R, C); const int Rb = Epi::PERM ? ((R & ~31) + perm32(R & 31)) : R;
        voffA[i] = (unsigned)(R * K + C) * 2u; voffB[i] = (unsigned)(Rb * K + C) * 2u; }
    const size_t kstep = (size_t)(BK * 2);
    const size_t hstep = (size_t)HALF * K * 2;
    const size_t tstep = 2 * hstep;
    const unsigned ldsw = (unsigned)wid * 1024u;
    const int aoff = lds_byte(wr * 64 + fr, fq * 8), boff = lds_byte(wc * 32 + fr, fq * 8);
#define PG8_SA(b, h) (((b) * 2 + (h)) * HTB)
#define PG8_SB(b, h) ((4 + (b) * 2 + (h)) * HTB)
#define PG8_STAGE(bufoff, gbase, voff) do { _Pragma("unroll") for (int _i = 0; _i < 2; ++_i) \
        __builtin_amdgcn_global_load_lds((const unsigned*)((const char*)(gbase) + (voff)[_i]), (PG8_LAS unsigned*)(lds + (bufoff) + ldsw + _i * 8192), 16, 0, 0); } while (0)
#define PG8_LDA(dst, b, h) do { _Pragma("unroll") for (int m = 0; m < 4; ++m) _Pragma("unroll") for (int k = 0; k < 2; ++k) dst[m][k] = *(const PG8_LAS bf16x8*)(lds + PG8_SA(b, h) + aoff + m * 2048 + k * 1024); } while (0)
#define PG8_LDB(dst, b, h) do { _Pragma("unroll") for (int n = 0; n < 2; ++n) _Pragma("unroll") for (int k = 0; k < 2; ++k) dst[n][k] = *(const PG8_LAS bf16x8*)(lds + PG8_SB(b, h) + boff + n * 2048 + k * 1024); } while (0)
#define PG8_MMA(ai, bj, At, Bt) do { __builtin_amdgcn_s_setprio(1); _Pragma("unroll") for (int m = 0; m < 4; ++m) _Pragma("unroll") for (int n = 0; n < 2; ++n) _Pragma("unroll") for (int k = 0; k < 2; ++k) \
        acc[ai][bj][m][n] = __builtin_amdgcn_mfma_f32_16x16x32_bf16(Bt[n][k], At[m][k], acc[ai][bj][m][n], 0, 0, 0); __builtin_amdgcn_s_setprio(0); } while (0)
#define PG8_WAIT_V(n) asm volatile("s_waitcnt vmcnt(" #n ")" ::: "memory")
#define PG8_WAIT_L(n) asm volatile("s_waitcnt lgkmcnt(" #n ")" ::: "memory")
#define PG8_BAR __builtin_amdgcn_s_barrier()
#define PG8_SCHED __builtin_amdgcn_sched_barrier(0)
    Unit cur, nxt; int ui = 0;
    if (!S.next(0, cur)) return;
    f32x4 acc[2][2][4][2];
#pragma unroll
    for (int a = 0; a < 2; ++a)
#pragma unroll
        for (int b = 0; b < 2; ++b)
#pragma unroll
            for (int m = 0; m < 4; ++m)
#pragma unroll
                for (int n = 0; n < 2; ++n) acc[a][b][m][n] = (f32x4){0.f, 0.f, 0.f, 0.f};
    bf16x8 At[4][2], B0[2][2], B1[2][2];
    const char* cA = (const char*)g.A + (size_t)cur.pm * tstep; const char* cB = (const char*)g.Bt + (size_t)cur.pn * tstep;
    S.a_ready(cur);
    if constexpr (SP2) {
        PG8_STAGE(PG8_SB(0, 0), cB, voffB); PG8_STAGE(PG8_SB(0, 1), cB + hstep, voffB); PG8_STAGE(PG8_SA(0, 0), cA, voffA); PG8_STAGE(PG8_SA(0, 1), cA + hstep, voffA);
        if (wr == 1) PG8_BAR;
        PG8_WAIT_V(2); PG8_BAR;
        PG8_STAGE(PG8_SB(1, 0), cB + kstep, voffB); PG8_STAGE(PG8_SA(1, 0), cA + kstep, voffA); PG8_STAGE(PG8_SB(1, 1), cB + hstep + kstep, voffB);
        PG8_WAIT_V(6); PG8_BAR;
    } else {
        PG8_STAGE(PG8_SB(0, 0), cB, voffB); PG8_STAGE(PG8_SA(0, 0), cA, voffA); PG8_STAGE(PG8_SB(0, 1), cB + hstep, voffB); PG8_STAGE(PG8_SA(0, 1), cA + hstep, voffA);
        if (wr == 1) PG8_BAR;
        PG8_WAIT_V(4); PG8_BAR;
        PG8_STAGE(PG8_SB(1, 0), cB + kstep, voffB); PG8_STAGE(PG8_SA(1, 0), cA + kstep, voffA); PG8_STAGE(PG8_SB(1, 1), cB + hstep + kstep, voffB);
        PG8_WAIT_V(6); PG8_BAR;
    }
    for (;;) {
        const bool has_next = S.next(ui + 1, nxt);
        const char* nA = has_next ? (const char*)g.A + (size_t)nxt.pm * tstep : cA; const char* nB = has_next ? (const char*)g.Bt + (size_t)nxt.pn * tstep : cB;
        for (int t = 0; t < nt; t += 2) {
            const bool last = (t == nt - 2);
            const char* a1 = cA + (size_t)(t + 1) * kstep;
            const char* a2 = last ? nA : cA + (size_t)(t + 2) * kstep; const char* b2 = last ? nB : cB + (size_t)(t + 2) * kstep;
            const char* a3 = a2 + kstep; const char* b3 = b2 + kstep;
            if (last && has_next) S.a_ready(nxt);
            if constexpr (SP2) {
            PG8_LDB(B0, 0, 0); PG8_LDB(B1, 0, 1); PG8_SCHED; PG8_LDA(At, 0, 0); PG8_STAGE(PG8_SA(1, 1), a1 + hstep, voffA);
            PG8_WAIT_V(8); PG8_WAIT_L(0); PG8_BAR; PG8_MMA(0, 0, At, B0); PG8_MMA(0, 1, At, B1); PG8_BAR; PG8_SCHED;
            PG8_LDA(At, 0, 1); PG8_STAGE(PG8_SB(0, 0), b2, voffB); PG8_STAGE(PG8_SB(0, 1), b2 + hstep, voffB); PG8_STAGE(PG8_SA(0, 0), a2, voffA);
            PG8_WAIT_V(8); PG8_WAIT_L(0); PG8_BAR; PG8_MMA(1, 0, At, B0); PG8_MMA(1, 1, At, B1); PG8_BAR; PG8_SCHED;
            PG8_LDB(B0, 1, 0); PG8_LDB(B1, 1, 1); PG8_SCHED; PG8_LDA(At, 1, 0); PG8_STAGE(PG8_SA(0, 1), a2 + hstep, voffA);
            PG8_WAIT_V(8); PG8_WAIT_L(0); PG8_BAR; PG8_MMA(0, 0, At, B0); PG8_MMA(0, 1, At, B1); PG8_BAR; PG8_SCHED;
            PG8_LDA(At, 1, 1); PG8_STAGE(PG8_SB(1, 0), b3, voffB); PG8_STAGE(PG8_SB(1, 1), b3 + hstep, voffB); PG8_STAGE(PG8_SA(1, 0), a3, voffA);
            PG8_WAIT_V(8); PG8_WAIT_L(0); PG8_BAR; PG8_MMA(1, 0, At, B0); PG8_MMA(1, 1, At, B1); PG8_BAR; PG8_SCHED;
            } else {
            PG8_LDB(B0, 0, 0); PG8_SCHED; PG8_LDA(At, 0, 0); PG8_STAGE(PG8_SA(1, 1), a1 + hstep, voffA);
            PG8_WAIT_L(8); PG8_BAR; PG8_WAIT_L(0); PG8_MMA(0, 0, At, B0); PG8_BAR; PG8_SCHED;
            PG8_LDB(B1, 0, 1); PG8_STAGE(PG8_SB(0, 0), b2, voffB);
            PG8_BAR; PG8_WAIT_L(0); PG8_MMA(0, 1, At, B1); PG8_BAR;
            PG8_LDA(At, 0, 1); PG8_STAGE(PG8_SA(0, 0), a2, voffA);
            PG8_BAR; PG8_WAIT_L(0); PG8_MMA(1, 0, At, B0); PG8_BAR; PG8_SCHED;
            PG8_STAGE(PG8_SB(0, 1), b2 + hstep, voffB);
            PG8_WAIT_V(6); PG8_BAR; PG8_MMA(1, 1, At, B1); PG8_BAR;
            PG8_LDB(B0, 1, 0); PG8_SCHED; PG8_LDA(At, 1, 0); PG8_STAGE(PG8_SA(0, 1), a2 + hstep, voffA);
            PG8_WAIT_L(8); PG8_BAR; PG8_WAIT_L(0); PG8_MMA(0, 0, At, B0); PG8_BAR; PG8_SCHED;
            PG8_LDB(B1, 1, 1); PG8_STAGE(PG8_SB(1, 0), b3, voffB);
            PG8_BAR; PG8_WAIT_L(0); PG8_MMA(0, 1, At, B1); PG8_BAR;
            PG8_LDA(At, 1, 1); PG8_STAGE(PG8_SA(1, 0), a3, voffA);
            PG8_BAR; PG8_WAIT_L(0); PG8_MMA(1, 0, At, B0); PG8_BAR; PG8_SCHED;
            PG8_STAGE(PG8_SB(1, 1), b3 + hstep, voffB);
            PG8_WAIT_V(6); PG8_BAR; PG8_MMA(1, 1, At, B1); PG8_BAR;
            }
        }
        if constexpr (ALIGN_EPI) { if (wr == 0) PG8_BAR; }
        if constexpr (!Epi::AFTER_DRAIN) { E(acc, cur, wr, wc, fr, fq); S.done(cur); }
        if (!has_next) break;
#pragma unroll
        for (int a = 0; a < 2; ++a)
#pragma unroll
            for (int b = 0; b < 2; ++b)
#pragma unroll
                for (int m = 0; m < 4; ++m)
#pragma unroll
                    for (int n = 0; n < 2; ++n) acc[a][b][m][n] = (f32x4){0.f, 0.f, 0.f, 0.f};
        cur = nxt; cA = nA; cB = nB; ++ui;
        if constexpr (ALIGN_EPI) { if (wr == 1) PG8_BAR; }
    }
    PG8_WAIT_V(0);
    if constexpr (!ALIGN_EPI) { if (wr == 0) PG8_BAR; }
    PG8_BAR;
    if constexpr (Epi::AFTER_DRAIN) { E.fused(acc, cur, wr, wc, fr, fq, lds, wid, lane); S.done(cur); }
#undef PG8_SA
#undef PG8_SB
#undef PG8_STAGE
#undef PG8_LDA
#undef PG8_LDB
#undef PG8_MMA
#undef PG8_WAIT_V
#undef PG8_WAIT_L
#undef PG8_BAR
#undef PG8_SCHED
}
}

#define GAS __attribute__((address_space(1)))
#define LAS __attribute__((address_space(3)))
typedef unsigned short bf16;
typedef unsigned v4u __attribute__((ext_vector_type(4)));
typedef unsigned v2u __attribute__((ext_vector_type(2)));
typedef float f32x4 __attribute__((ext_vector_type(4)));
typedef float f32x2 __attribute__((ext_vector_type(2)));
typedef short bf16x8 __attribute__((ext_vector_type(8)));

constexpr int NWAVES = 8, NTHR = 512;
constexpr int DM = 1024, NBP = 8, SEQ = 2048, NBS = 32, TS = 8;
constexpr int MP = NBP * SEQ, MS = NBS * TS, MT = MP + MS;
constexpr int DIN = 10240;
constexpr int C_U = 0, C_V = 1024, C_Z = 2048, C_Q = 3072, C_K = 4608, C_VV = 6144, C_ZB = 7680, C_GA = 8192, C_GB = 9216;
constexpr float EPS = 1e-6f;
constexpr size_t O_Y = 0, O_KVP0 = (size_t)MT * DM, O_KVP1 = O_KVP0 + (size_t)8 * 128 * 1024, O_KVP2 = O_KVP1 + (size_t)8 * 512 * 1024,
                 O_KVS0 = O_KVP2 + (size_t)8 * 2048 * 1024, O_KVS1 = O_KVS0 + 262144, O_KVS2 = O_KVS1 + 262144, O_VCH = O_KVS2 + 262144, O_END = O_VCH + 262144;
constexpr size_t MiB = 1u << 20;
constexpr size_t WS_WIN = 2 * MiB, WS_WPA = 22 * MiB, WS_WPB = 24 * MiB, WS_WOUT = 25 * MiB, WS_MOD = 27 * MiB, WS_VST = 28 * MiB, WS_ML = 31 * MiB,
                 WS_H = 36 * MiB, WS_YA = 70 * MiB, WS_YB = 104 * MiB, WS_MRG = 122 * MiB, WS_O3 = 156 * MiB, WS_PART = 206 * MiB, WS_OUT = 272 * MiB,
                 WS_PROJ = 340 * MiB, WS_END = 672 * MiB;
static_assert(WS_PROJ + (size_t)MT * DIN * 2 <= WS_END, "ws map");
constexpr int LDS_BYTES = 147456;

#define LDS_WAIT() asm volatile("s_waitcnt lgkmcnt(0)" ::: "memory")
__device__ __forceinline__ unsigned f2bf(float f) { unsigned u = __builtin_bit_cast(unsigned, f); return (u + 0x7fffu + ((u >> 16) & 1u)) >> 16; }
__device__ __forceinline__ unsigned pk2(float lo, float hi) { return f2bf(lo) | (f2bf(hi) << 16); }
__device__ __forceinline__ float bflo(unsigned w) { return __builtin_bit_cast(float, w << 16); }
__device__ __forceinline__ float bfhi(unsigned w) { return __builtin_bit_cast(float, w & 0xffff0000u); }
__device__ __forceinline__ float bf2f(bf16 h) { return __builtin_bit_cast(float, (unsigned)h << 16); }
__device__ __forceinline__ float sigm(float x) { return 1.f / (1.f + __expf(-x)); }
__device__ __forceinline__ float silu(float x) { return x / (1.f + __expf(-x)); }
__device__ __forceinline__ float wave_sum(float v) {
#pragma unroll
    for (int o = 1; o < 64; o <<= 1) v += __shfl_xor(v, o);
    return v;
}
__device__ __forceinline__ float wave_max(float v) {
#pragma unroll
    for (int o = 1; o < 64; o <<= 1) v = fmaxf(v, __shfl_xor(v, o));
    return v;
}
__device__ __forceinline__ float rdlane(float v, int l) { return __builtin_bit_cast(float, __builtin_amdgcn_readlane(__builtin_bit_cast(int, v), l)); }

namespace pg8 {
struct EpiProj {
    static constexpr bool PERM = true, AFTER_DRAIN = false;
    bf16_t* P; float* out; float* vst;
    __device__ __forceinline__ void operator()(const f32x4 (&acc)[2][2][4][2], const Unit& u, int wr, int wc, int fr, int fq) const {
        const int row0 = u.pm * BM + wr * 64 + fr;
        const int colt = u.pn * BM + wc * 32 + 8 * fq;
#pragma unroll
        for (int ai = 0; ai < 2; ++ai)
#pragma unroll
            for (int m = 0; m < 4; ++m) { bf16_t* rowp = P + (size_t)(row0 + ai * HALF + m * 16) * DIN + colt;
#pragma unroll
                for (int bj = 0; bj < 2; ++bj) { const f32x4 v0 = acc[ai][bj][m][0], v1 = acc[ai][bj][m][1];
                    u32x4 w; w.x = cvt_pk_bf16(v0[0], v0[1]); w.y = cvt_pk_bf16(v0[2], v0[3]); w.z = cvt_pk_bf16(v1[0], v1[1]); w.w = cvt_pk_bf16(v1[2], v1[3]);
                    *(u32x4*)(rowp + bj * HALF) = w; } }
        if (u.pn >= 4 && u.pn < 8) {
#pragma unroll
            for (int ai = 0; ai < 2; ++ai)
#pragma unroll
                for (int m = 0; m < 4; ++m) { float s = 0.f, q = 0.f;
#pragma unroll
                    for (int bj = 0; bj < 2; ++bj)
#pragma unroll
                        for (int n = 0; n < 2; ++n) { const f32x4 x = acc[ai][bj][m][n]; s += (x[0] + x[1]) + (x[2] + x[3]); q += (x[0] * x[0] + x[1] * x[1]) + (x[2] * x[2] + x[3] * x[3]); }
                    s += __shfl_xor(s, 16); s += __shfl_xor(s, 32); q += __shfl_xor(q, 16); q += __shfl_xor(q, 32);
                    if (fq == 0) { float* d = vst + ((size_t)(row0 + ai * HALF + m * 16) * 16 + (u.pn - 4) * 4 + wc) * 2; *(f32x2*)d = (f32x2){s, q}; } }
        }
        if (u.pn >= 18 && u.pn < 30) {
            const int kv = u.pn >= 24 ? 1 : 0; const int t = u.pn - 18 - 6 * kv; const int g = t >> 1, half = t & 1;
            const int dcol = kv * 512 + half * 256 + wc * 32 + 8 * fq;
            const int R = g == 0 ? 128 : (g == 1 ? 512 : 2048);
            const size_t obp = g == 0 ? O_KVP0 : (g == 1 ? O_KVP1 : O_KVP2), obs = g == 0 ? O_KVS0 : (g == 1 ? O_KVS1 : O_KVS2);
#pragma unroll
            for (int ai = 0; ai < 2; ++ai)
#pragma unroll
                for (int m = 0; m < 4; ++m) { const int row = row0 + ai * HALF + m * 16; float* base = nullptr;
                    if (row < MP) { const int b = row >> 11, s = row & 2047, r = s - (2048 - R); if (r >= 0) base = out + obp + (size_t)(b * R + r) * 1024 + dcol; }
                    else base = out + obs + (size_t)(row - MP) * 1024 + dcol;
                    if (base) {
#pragma unroll
                        for (int bj = 0; bj < 2; ++bj)
#pragma unroll
                            for (int n = 0; n < 2; ++n) *(f32x4*)(base + bj * HALF + 4 * n) = acc[ai][bj][m][n]; } }
        }
    }
};
struct EpiGateA {
    static constexpr bool PERM = true, AFTER_DRAIN = false;
    const bf16_t* P; float* part;
    __device__ __forceinline__ void operator()(const f32x4 (&acc)[2][2][4][2], const Unit& u, int wr, int wc, int fr, int fq) const {
        const int row0 = u.pm * BM + wr * 64 + fr; const int colt = u.pn * BM + wc * 32 + 8 * fq;
#pragma unroll
        for (int ai = 0; ai < 2; ++ai)
#pragma unroll
            for (int m = 0; m < 4; ++m) { const size_t row = (size_t)(row0 + ai * HALF + m * 16); const bf16_t* gp = P + row * DIN + C_GA + colt; float* pp = part + row * DM + colt;
#pragma unroll
                for (int bj = 0; bj < 2; ++bj) { const u32x4 gw = *(const u32x4*)(gp + bj * HALF); const f32x4 a0 = acc[ai][bj][m][0], a1 = acc[ai][bj][m][1];
                    f32x4 o0, o1; o0[0] = a0[0] * sigm(bflo(gw.x)); o0[1] = a0[1] * sigm(bfhi(gw.x)); o0[2] = a0[2] * sigm(bflo(gw.y)); o0[3] = a0[3] * sigm(bfhi(gw.y));
                    o1[0] = a1[0] * sigm(bflo(gw.z)); o1[1] = a1[1] * sigm(bfhi(gw.z)); o1[2] = a1[2] * sigm(bflo(gw.w)); o1[3] = a1[3] * sigm(bfhi(gw.w));
                    *(f32x4*)(pp + bj * HALF) = o0; *(f32x4*)(pp + bj * HALF + 4) = o1; } }
    }
};
struct EpiGateB {
    static constexpr bool PERM = true, AFTER_DRAIN = false;
    const bf16_t* P; const float* part; bf16_t* mrg;
    __device__ __forceinline__ void operator()(const f32x4 (&acc)[2][2][4][2], const Unit& u, int wr, int wc, int fr, int fq) const {
        const int row0 = u.pm * BM + wr * 64 + fr; const int colt = u.pn * BM + wc * 32 + 8 * fq;
#pragma unroll
        for (int ai = 0; ai < 2; ++ai)
#pragma unroll
            for (int m = 0; m < 4; ++m) { const size_t row = (size_t)(row0 + ai * HALF + m * 16); const bf16_t* gp = P + row * DIN + C_GB + colt; const float* pp = part + row * DM + colt;
#pragma unroll
                for (int bj = 0; bj < 2; ++bj) { const u32x4 gw = *(const u32x4*)(gp + bj * HALF); const f32x4 a0 = acc[ai][bj][m][0], a1 = acc[ai][bj][m][1];
                    const f32x4 p0 = *(const f32x4*)(pp + bj * HALF), p1 = *(const f32x4*)(pp + bj * HALF + 4);
                    f32x4 o0, o1; o0[0] = p0[0] + a0[0] * sigm(bflo(gw.x)); o0[1] = p0[1] + a0[1] * sigm(bfhi(gw.x)); o0[2] = p0[2] + a0[2] * sigm(bflo(gw.y)); o0[3] = p0[3] + a0[3] * sigm(bfhi(gw.y));
                    o1[0] = p1[0] + a1[0] * sigm(bflo(gw.z)); o1[1] = p1[1] + a1[1] * sigm(bfhi(gw.z)); o1[2] = p1[2] + a1[2] * sigm(bflo(gw.w)); o1[3] = p1[3] + a1[3] * sigm(bfhi(gw.w));
                    u32x4 w; w.x = cvt_pk_bf16(o0[0], o0[1]); w.y = cvt_pk_bf16(o0[2], o0[3]); w.z = cvt_pk_bf16(o1[0], o1[1]); w.w = cvt_pk_bf16(o1[2], o1[3]);
                    *(u32x4*)(mrg + row * DM + colt + bj * HALF) = w; } }
    }
};
struct EpiF32 {
    static constexpr bool PERM = true, AFTER_DRAIN = false;
    float* O;
    __device__ __forceinline__ void operator()(const f32x4 (&acc)[2][2][4][2], const Unit& u, int wr, int wc, int fr, int fq) const {
        const int row0 = u.pm * BM + wr * 64 + fr; const int colt = u.pn * BM + wc * 32 + 8 * fq;
#pragma unroll
        for (int ai = 0; ai < 2; ++ai)
#pragma unroll
            for (int m = 0; m < 4; ++m) { float* pp = O + (size_t)(row0 + ai * HALF + m * 16) * DM + colt;
#pragma unroll
                for (int bj = 0; bj < 2; ++bj) { *(f32x4*)(pp + bj * HALF) = acc[ai][bj][m][0]; *(f32x4*)(pp + bj * HALF + 4) = acc[ai][bj][m][1]; } }
    }
};
}

__device__ __forceinline__ void p0_transpose_item(const float* W, int K, int N, bf16* WT, int row_off, LAS float* scr, int item, int lane) {
    const int nblk = N / 32, kb = item / nblk, nb = item % nblk, k0 = 64 * kb, n0 = 32 * nb;
#pragma unroll 8
    for (int i = 0; i < 32; ++i) { const int kk = 2 * i + (lane >> 5); scr[kk * 33 + (lane & 31)] = W[(size_t)(k0 + kk) * N + n0 + (lane & 31)]; }
    LDS_WAIT(); asm volatile("" ::: "memory");
    const int c = lane & 7;
#pragma unroll
    for (int j = 0; j < 4; ++j) { const int n = (lane >> 3) + 8 * j; const LAS float* s = scr + (8 * c) * 33 + n;
        v4u o; o.x = pk2(s[0 * 33], s[1 * 33]); o.y = pk2(s[2 * 33], s[3 * 33]); o.z = pk2(s[4 * 33], s[5 * 33]); o.w = pk2(s[6 * 33], s[7 * 33]);
        *(GAS v4u*)(WT + (size_t)(row_off + n0 + n) * K + k0 + 8 * c) = o; }
    LDS_WAIT(); asm volatile("" ::: "memory");
}
__device__ __forceinline__ void mod_task(int chunk, const float* cp, const float* cs, const float* Wc, const float* bc, float* MOD, LAS unsigned char* lds, int tid, int wave, int lane) {
    const int k0 = wave * 128;
    float sc0[40], sc1[40], acc[40];
#pragma unroll
    for (int r = 0; r < 40; ++r) { const float* crow = (r < 8) ? cp + r * 1024 : cs + (r - 8) * 1024; sc0[r] = silu(crow[k0 + lane]); sc1[r] = silu(crow[k0 + 64 + lane]); acc[r] = 0.f; }
    const float* wp = Wc + (size_t)k0 * 3072 + chunk * 64 + lane;
#pragma unroll 4
    for (int kk = 0; kk < 64; ++kk) { const float wv = wp[(size_t)kk * 3072];
#pragma unroll
        for (int r = 0; r < 40; ++r) acc[r] += rdlane(sc0[r], kk) * wv; }
#pragma unroll 4
    for (int kk = 0; kk < 64; ++kk) { const float wv = wp[(size_t)(64 + kk) * 3072];
#pragma unroll
        for (int r = 0; r < 40; ++r) acc[r] += rdlane(sc1[r], kk) * wv; }
    LAS float* red = (LAS float*)lds;
#pragma unroll
    for (int r = 0; r < 40; ++r) red[(wave * 40 + r) * 64 + lane] = acc[r];
    __syncthreads();
    for (int idx = tid; idx < 2560; idx += NTHR) { const int r = idx >> 6, cl = idx & 63; float s = 0.f;
#pragma unroll
        for (int w = 0; w < 8; ++w) s += red[(w * 40 + r) * 64 + cl];
        MOD[r * 3072 + chunk * 64 + cl] = s + bc[chunk * 64 + cl]; }
    __syncthreads();
}

__device__ __forceinline__ void attn_item(int idx, const bf16* PROJ, bf16* O3, float* ML, LAS unsigned char* lds, int tid, int wave, int lane) {
    const int g = idx >> 10; int rem = idx & 1023; const int b = rem >> 7; rem &= 127; const int h = rem >> 4; const int sub = rem & 15;
    int d, n, r;
    if (g == 0) { d = 1; n = sub; r = 0; } else if (g == 1) { d = 4; r = sub >> 2; n = sub & 3; } else { d = 16; r = sub; n = 0; }
    LAS bf16* Ks = (LAS bf16*)lds;
    LAS bf16* VT = (LAS bf16*)(lds + 36864);
    {
        const int key = tid >> 1, half = tid & 1; const int m = 128 * (n - 1) + key;
        v4u kk[4], vv[4];
        if (m >= 0) { const size_t row = (size_t)b * 2048 + (size_t)d * m + r; const bf16* src = PROJ + row * DIN + g * 512 + h * 64 + half * 32;
#pragma unroll
            for (int c = 0; c < 4; ++c) { kk[c] = *(const v4u*)(src + C_K + 8 * c); vv[c] = *(const v4u*)(src + C_VV + 8 * c); } }
        else {
#pragma unroll
            for (int c = 0; c < 4; ++c) { kk[c] = (v4u){0u, 0u, 0u, 0u}; vv[c] = (v4u){0u, 0u, 0u, 0u}; } }
#pragma unroll
        for (int c = 0; c < 4; ++c) *(LAS v4u*)(Ks + key * 72 + half * 32 + 8 * c) = kk[c];
#pragma unroll
        for (int c = 0; c < 4; ++c)
#pragma unroll
            for (int e = 0; e < 8; ++e) { const unsigned w = vv[c][e >> 1]; VT[(half * 32 + 8 * c + e) * 264 + key] = (bf16)((e & 1) ? (w >> 16) : (w & 0xffffu)); }
    }
    __syncthreads();
    const int fr = lane & 15, fq = lane >> 4;
    const int i = 16 * wave + fr;
    const size_t rowq = (size_t)b * 2048 + (size_t)d * (128 * n + i) + r;
    const bf16* qsrc = PROJ + rowq * DIN + C_Q + g * 512 + h * 64 + 8 * fq;
    const bf16x8 Q0 = *(const bf16x8*)qsrc, Q1 = *(const bf16x8*)(qsrc + 32);
    const int start = wave & ~1; const int lo = (n == 0) ? 8 : start;
    f32x4 S[10]; float mx = -1e30f;
#pragma unroll
    for (int p = 0; p < 10; ++p) { const int tile = start + p;
        if (tile >= lo) {
            const LAS bf16* kp = Ks + (tile * 16 + fr) * 72 + 8 * fq;
            const bf16x8 K0 = *(const LAS bf16x8*)kp, K1 = *(const LAS bf16x8*)(kp + 32);
            f32x4 s = (f32x4){0.f, 0.f, 0.f, 0.f};
            s = __builtin_amdgcn_mfma_f32_16x16x32_bf16(K0, Q0, s, 0, 0, 0); s = __builtin_amdgcn_mfma_f32_16x16x32_bf16(K1, Q1, s, 0, 0, 0);
#pragma unroll
            for (int e = 0; e < 4; ++e) { const int j = tile * 16 + 4 * fq + e; const bool valid = (j >= i) && (j <= i + 128); s[e] = valid ? s[e] * 0.125f : -1e30f; mx = fmaxf(mx, s[e]); }
            S[p] = s;
        } else S[p] = (f32x4){-1e30f, -1e30f, -1e30f, -1e30f};
    }
    mx = fmaxf(mx, __shfl_xor(mx, 16)); mx = fmaxf(mx, __shfl_xor(mx, 32));
    float l = 0.f;
#pragma unroll
    for (int p = 0; p < 10; ++p)
#pragma unroll
        for (int e = 0; e < 4; ++e) { const float ex = __expf(S[p][e] - mx); S[p][e] = ex; l += ex; }
    l += __shfl_xor(l, 16); l += __shfl_xor(l, 32);
    f32x4 O[4];
#pragma unroll
    for (int dt = 0; dt < 4; ++dt) O[dt] = (f32x4){0.f, 0.f, 0.f, 0.f};
#pragma unroll
    for (int pp = 0; pp < 5; ++pp) {
        if (start + 2 * pp >= lo) {
            v4u pw; pw.x = pk2(S[2 * pp][0], S[2 * pp][1]); pw.y = pk2(S[2 * pp][2], S[2 * pp][3]); pw.z = pk2(S[2 * pp + 1][0], S[2 * pp + 1][1]); pw.w = pk2(S[2 * pp + 1][2], S[2 * pp + 1][3]);
            const bf16x8 Pf = __builtin_bit_cast(bf16x8, pw);
            const int ka = (start + 2 * pp) * 16 + 4 * fq;
#pragma unroll
            for (int dt = 0; dt < 4; ++dt) { const LAS bf16* vp = VT + (16 * dt + fr) * 264 + ka;
                const v2u va = *(const LAS v2u*)vp, vb = *(const LAS v2u*)(vp + 16);
                const bf16x8 Vf = __builtin_bit_cast(bf16x8, (v4u){va.x, va.y, vb.x, vb.y});
                O[dt] = __builtin_amdgcn_mfma_f32_16x16x32_bf16(Vf, Pf, O[dt], 0, 0, 0); }
        }
    }
    const float inv = 1.f / l;
    bf16* op = O3 + ((size_t)g * MT + rowq) * 512 + h * 64 + 4 * fq;
#pragma unroll
    for (int dt = 0; dt < 4; ++dt) { v2u w; w.x = pk2(O[dt][0] * inv, O[dt][1] * inv); w.y = pk2(O[dt][2] * inv, O[dt][3] * inv); *(v2u*)(op + 16 * dt) = w; }
    if (fq == 0) { float* mp = ML + (((size_t)g * MT + rowq) * 8 + h) * 2; *(f32x2*)mp = (f32x2){mx, l}; }
    __syncthreads();
}

__device__ __forceinline__ void gmlp_item(int idx, const bf16* PROJ, const float* VST, const float* Wsp, const float* bsp, const float* lng, const float* lnb, bf16* YA,
                                          LAS unsigned char* lds, int tid, int wave, int lane) {
    const int ci = idx >> 3, g = idx & 7; const int row0 = ci * 128;
    LAS bf16* VT = (LAS bf16*)lds;
    LAS bf16* WS = (LAS bf16*)(lds + 34816);
    LAS float* st = (LAS float*)(lds + 69632);
    if (tid < 128) { const float* p = VST + (size_t)(row0 + tid) * 32; float s = 0.f, q = 0.f;
#pragma unroll
        for (int k = 0; k < 8; ++k) { const f32x4 a = ((const f32x4*)p)[k]; s += a[0] + a[2]; q += a[1] + a[3]; }
        const float mu = s * (1.f / 1024.f); const float var = q * (1.f / 1024.f) - mu * mu; st[2 * tid] = mu; st[2 * tid + 1] = rsqrtf(var + EPS); }
    { const int t = tid >> 2, sp = tid & 3; const float* wp = Wsp + ((size_t)g * 128 + t) * 128 + sp * 32;
#pragma unroll
        for (int c = 0; c < 4; ++c) { const f32x4 a = ((const f32x4*)wp)[2 * c], b2 = ((const f32x4*)wp)[2 * c + 1]; const int s0 = sp * 32 + 8 * c;
            float v[8] = {a[0], a[1], a[2], a[3], b2[0], b2[1], b2[2], b2[3]};
#pragma unroll
            for (int e = 0; e < 8; ++e) v[e] = (s0 + e <= t) ? v[e] : 0.f;
            v4u w; w.x = pk2(v[0], v[1]); w.y = pk2(v[2], v[3]); w.z = pk2(v[4], v[5]); w.w = pk2(v[6], v[7]);
            *(LAS v4u*)(WS + t * 136 + s0) = w; } }
    __syncthreads();
    { const int s = tid >> 2, cp = tid & 3; const float mu = st[2 * s], rstd = st[2 * s + 1]; const bf16* vp = PROJ + (size_t)(row0 + s) * DIN + C_V + g * 128 + cp * 32;
#pragma unroll
        for (int c = 0; c < 4; ++c) { const v4u raw = *(const v4u*)(vp + 8 * c); const int ch = g * 128 + cp * 32 + 8 * c;
            const f32x4 g0 = *(const f32x4*)(lng + ch), g1 = *(const f32x4*)(lng + ch + 4), b0 = *(const f32x4*)(lnb + ch), b1 = *(const f32x4*)(lnb + ch + 4);
            float x[8] = {bflo(raw.x), bfhi(raw.x), bflo(raw.y), bfhi(raw.y), bflo(raw.z), bfhi(raw.z), bflo(raw.w), bfhi(raw.w)};
            const float gg[8] = {g0[0], g0[1], g0[2], g0[3], g1[0], g1[1], g1[2], g1[3]}; const float bb[8] = {b0[0], b0[1], b0[2], b0[3], b1[0], b1[1], b1[2], b1[3]};
#pragma unroll
            for (int e = 0; e < 8; ++e) VT[(cp * 32 + 8 * c + e) * 136 + s] = (bf16)f2bf((x[e] - mu) * rstd * gg[e] + bb[e]); } }
    __syncthreads();
    const int fr = lane & 15, fq = lane >> 4;
    const int t = 16 * wave + fr; const int nks = (wave >> 1) + 1;
    f32x4 acc[8];
#pragma unroll
    for (int ct = 0; ct < 8; ++ct) acc[ct] = (f32x4){0.f, 0.f, 0.f, 0.f};
#pragma unroll
    for (int ks = 0; ks < 4; ++ks) {
        if (ks < nks) { const bf16x8 Wf = *(const LAS bf16x8*)(WS + t * 136 + 32 * ks + 8 * fq);
#pragma unroll
            for (int ct = 0; ct < 8; ++ct) { const bf16x8 Vf = *(const LAS bf16x8*)(VT + (16 * ct + fr) * 136 + 32 * ks + 8 * fq);
                acc[ct] = __builtin_amdgcn_mfma_f32_16x16x32_bf16(Vf, Wf, acc[ct], 0, 0, 0); } }
    }
    const size_t row = (size_t)row0 + t; const float bs = bsp[g * 128 + t];
    const bf16* up = PROJ + row * DIN + g * 128 + 4 * fq;
    bf16* yp = YA + row * DM + g * 128 + 4 * fq;
#pragma unroll
    for (int ct = 0; ct < 8; ++ct) { const v2u uu = *(const v2u*)(up + C_U + 16 * ct), zz = *(const v2u*)(up + C_Z + 16 * ct);
        const float y0 = bflo(uu.x) * (acc[ct][0] + bs) * silu(bflo(zz.x)), y1 = bfhi(uu.x) * (acc[ct][1] + bs) * silu(bfhi(zz.x));
        const float y2 = bflo(uu.y) * (acc[ct][2] + bs) * silu(bflo(zz.y)), y3 = bfhi(uu.y) * (acc[ct][3] + bs) * silu(bfhi(zz.y));
        v2u w; w.x = pk2(y0, y1); w.y = pk2(y2, y3); *(v2u*)(yp + 16 * ct) = w; }
    __syncthreads();
}

__device__ __forceinline__ void gmlp_sample_item(int b, const bf16* PROJ, const float* VST, const float* Wsp, const float* bsp, const float* lng, const float* lnb, bf16* YA, float* out,
                                                 LAS unsigned char* lds, int tid, int wave, int lane) {
    const int r0 = MP + b * 8;
    LAS float* st = (LAS float*)lds;
    if (tid < 8) { const float* p = VST + (size_t)(r0 + tid) * 32; float s = 0.f, q = 0.f;
#pragma unroll
        for (int k = 0; k < 8; ++k) { const f32x4 a = ((const f32x4*)p)[k]; s += a[0] + a[2]; q += a[1] + a[3]; }
        const float mu = s * (1.f / 1024.f); const float var = q * (1.f / 1024.f) - mu * mu; st[2 * tid] = mu; st[2 * tid + 1] = rsqrtf(var + EPS); }
    __syncthreads();
    const int ch = 2 * tid, g = wave;
    const float lg0 = lng[ch], lg1 = lng[ch + 1], lb0 = lnb[ch], lb1 = lnb[ch + 1];
    float vn0[8], vn1[8];
#pragma unroll
    for (int s = 0; s < 8; ++s) { const unsigned raw = *(const unsigned*)(PROJ + (size_t)(r0 + s) * DIN + C_V + ch); const float mu = st[2 * s], rstd = st[2 * s + 1];
        vn0[s] = (bflo(raw) - mu) * rstd * lg0 + lb0; vn1[s] = (bfhi(raw) - mu) * rstd * lg1 + lb1;
        *(f32x2*)(out + O_VCH + (size_t)(b * 8 + s) * 1024 + ch) = (f32x2){vn0[s], vn1[s]}; }
#pragma unroll
    for (int t = 0; t < 8; ++t) { float z0 = bsp[g * 128 + t], z1 = z0;
#pragma unroll
        for (int s = 0; s < 8; ++s) if (s <= t) { const float w = Wsp[((size_t)g * 128 + t) * 128 + s]; z0 += w * vn0[s]; z1 += w * vn1[s]; }
        const unsigned uu = *(const unsigned*)(PROJ + (size_t)(r0 + t) * DIN + C_U + ch), zz = *(const unsigned*)(PROJ + (size_t)(r0 + t) * DIN + C_Z + ch);
        *(unsigned*)(YA + (size_t)(r0 + t) * DM + ch) = pk2(bflo(uu) * z0 * silu(bflo(zz)), bfhi(uu) * z1 * silu(bfhi(zz))); }
    __syncthreads();
}

__device__ __forceinline__ void attn_sample_item(int idx, const bf16* PROJ, const float* c128, const float* c512, const float* c2048, bf16* O3, float* ML, int wave, int lane) {
    const int b = idx / 24; const int rem = idx - b * 24; const int g = rem >> 3, t = rem & 7; const int h = wave;
    const int lw = g == 0 ? 128 : (g == 1 ? 512 : 2048), d = g == 0 ? 1 : (g == 1 ? 4 : 16);
    const float* cache = (g == 0 ? c128 : (g == 1 ? c512 : c2048)) + (size_t)b * lw * 1024;
    const size_t rq = (size_t)MP + b * 8 + t;
    const float qv = bf2f(PROJ[rq * DIN + C_Q + g * 512 + h * 64 + lane]) * 0.125f;
    float s[3];
#pragma unroll
    for (int jj = 0; jj < 3; ++jj) { const int j = lane + 64 * jj; float a = -1e30f;
        if (j <= 128) { const int ix = lw + t - d * j; a = 0.f;
            if (ix >= lw) { const bf16* kp = PROJ + (size_t)(MP + b * 8 + ix - lw) * DIN + C_K + g * 512 + h * 64;
#pragma unroll
                for (int c = 0; c < 8; ++c) { const v4u raw = ((const v4u*)kp)[c];
                    a += bflo(raw.x) * rdlane(qv, 8 * c) + bfhi(raw.x) * rdlane(qv, 8 * c + 1) + bflo(raw.y) * rdlane(qv, 8 * c + 2) + bfhi(raw.y) * rdlane(qv, 8 * c + 3)
                       + bflo(raw.z) * rdlane(qv, 8 * c + 4) + bfhi(raw.z) * rdlane(qv, 8 * c + 5) + bflo(raw.w) * rdlane(qv, 8 * c + 6) + bfhi(raw.w) * rdlane(qv, 8 * c + 7); } }
            else { const float* kp = cache + (size_t)ix * 1024 + h * 64;
#pragma unroll
                for (int c = 0; c < 16; ++c) { const f32x4 kk = ((const f32x4*)kp)[c];
                    a += kk[0] * rdlane(qv, 4 * c) + kk[1] * rdlane(qv, 4 * c + 1) + kk[2] * rdlane(qv, 4 * c + 2) + kk[3] * rdlane(qv, 4 * c + 3); } }
        }
        s[jj] = a; }
    const float mx = wave_max(fmaxf(fmaxf(s[0], s[1]), s[2]));
    const float p0 = __expf(s[0] - mx), p1 = __expf(s[1] - mx), p2 = __expf(s[2] - mx);
    const float l = wave_sum(p0 + p1 + p2);
    float o = 0.f;
    const size_t vcol = (size_t)C_VV + g * 512 + h * 64 + lane;
#pragma unroll 8
    for (int j = 0; j < 129; ++j) { const float pj = (j < 64) ? rdlane(p0, j) : ((j < 128) ? rdlane(p1, j - 64) : rdlane(p2, 0));
        const int ix = lw + t - d * j;
        const float v = (ix >= lw) ? bf2f(PROJ[(size_t)(MP + b * 8 + ix - lw) * DIN + vcol]) : cache[(size_t)ix * 1024 + 512 + h * 64 + lane];
        o += pj * v; }
    O3[((size_t)g * MT + rq) * 512 + h * 64 + lane] = (bf16)f2bf(o / l);
    if (lane == 0) { float* mp = ML + (((size_t)g * MT + rq) * 8 + h) * 2; mp[0] = mx; mp[1] = l; }
}

struct Args { const float* in[19]; float* out; unsigned char* ws; };
__global__ void __launch_bounds__(NTHR, 2) fwd_kernel(Args args) {
    extern __shared__ __attribute__((aligned(16))) unsigned char lds_raw[];
    cg::grid_group grid = cg::this_grid();
    LAS unsigned char* lds = (LAS unsigned char*)lds_raw;
    const int tid = threadIdx.x, lane = tid & 63, wave = __builtin_amdgcn_readfirstlane(tid >> 6);
    const int G = gridDim.x, bx = blockIdx.x;
    const int gw = bx * NWAVES + wave, NGW = G * NWAVES;
    const float* xp = args.in[0]; const float* xs = args.in[1];
    const float* c128 = args.in[2]; const float* c512 = args.in[3]; const float* c2048 = args.in[4];
    const float* cpr = args.in[5]; const float* csm = args.in[6]; const float* wcond = args.in[7]; const float* bcond = args.in[8]; const float* gpre = args.in[9];
    const float* win = args.in[10]; const float* lng = args.in[11]; const float* lnb = args.in[12]; const float* wsp = args.in[13]; const float* bsp = args.in[14];
    const float* wpa = args.in[15]; const float* wpb = args.in[16]; const float* wout = args.in[17]; const float* gpost = args.in[18];
    float* out = args.out; unsigned char* ws = args.ws;
    bf16* WIN_T = (bf16*)(ws + WS_WIN); bf16* WPA_T = (bf16*)(ws + WS_WPA); bf16* WPB_T = (bf16*)(ws + WS_WPB); bf16* WOUT_T = (bf16*)(ws + WS_WOUT);
    float* MOD = (float*)(ws + WS_MOD); float* VST = (float*)(ws + WS_VST); float* ML = (float*)(ws + WS_ML);
    bf16* H = (bf16*)(ws + WS_H); bf16* YA = (bf16*)(ws + WS_YA); bf16* YB = (bf16*)(ws + WS_YB); bf16* MRG = (bf16*)(ws + WS_MRG); bf16* O3 = (bf16*)(ws + WS_O3);
    float* PART = (float*)(ws + WS_PART); float* OUTB = (float*)(ws + WS_OUT); bf16* PROJ = (bf16*)(ws + WS_PROJ);

    if (bx < 48) mod_task(bx, cpr, csm, wcond, bcond, MOD, lds, tid, wave, lane);
    {
        LAS float* scr = (LAS float*)(lds + wave * 16384);
        constexpr int I_IN = (1024 / 64) * (DIN / 32), I_PA = (1024 / 64) * (1024 / 32), I_PB = (512 / 64) * (1024 / 32), I_OUT = I_PA;
        constexpr int NITEMS = I_IN + I_PA + I_PB + I_OUT;
        for (int it = gw; it < NITEMS; it += NGW) {
            int r = it;
            if (r < I_IN) { p0_transpose_item(win, 1024, DIN, WIN_T, 0, scr, r, lane); continue; } r -= I_IN;
            if (r < I_PA) { p0_transpose_item(wpa, 1024, 1024, WPA_T, 0, scr, r, lane); continue; } r -= I_PA;
            if (r < I_PB) { p0_transpose_item(wpb, 512, 1024, WPB_T, 0, scr, r, lane); continue; } r -= I_PB;
            p0_transpose_item(wout, 1024, 1024, WOUT_T, 0, scr, r, lane);
        }
    }
    grid.sync();
    for (int row = gw; row < MT; row += NGW) {
        const float* xr = row < MP ? xp + (size_t)row * DM : xs + (size_t)(row - MP) * DM;
        const float* mod = MOD + (row < MP ? (row >> 11) : 8 + ((row - MP) >> 3)) * 3072;
        f32x4 v[4]; float ss = 0.f;
#pragma unroll
        for (int j = 0; j < 4; ++j) { v[j] = ((const f32x4*)xr)[lane + 64 * j]; ss += (v[j][0] * v[j][0] + v[j][1] * v[j][1]) + (v[j][2] * v[j][2] + v[j][3] * v[j][3]); }
        const float rstd = rsqrtf(wave_sum(ss) * (1.f / DM) + EPS);
#pragma unroll
        for (int j = 0; j < 4; ++j) { const int c = 4 * lane + 256 * j;
            const f32x4 gg = *(const f32x4*)(gpre + c), sh = *(const f32x4*)(mod + c), sc = *(const f32x4*)(mod + 1024 + c);
            const f32x4 hh = v[j] * rstd * gg * (sc + 1.f) + sh;
            v2u w; w.x = pk2(hh[0], hh[1]); w.y = pk2(hh[2], hh[3]); *(v2u*)(H + (size_t)row * DM + c) = w; }
    }
    grid.sync();
    {
        pg8::Gemm gm{H, WIN_T, MT, DIN, DM}; pg8::StaticOrder S; S.init(MT, DIN, G, bx);
        pg8::EpiProj E{PROJ, out, VST};
        pg8::gemm_phase<pg8::EpiProj, pg8::StaticOrder, true, true>(lds, gm, S, E);
    }
    grid.sync();
    {
        constexpr int N_ATT = 3072, N_GM = 1024, N_SA = 768, N_SG = 32, N_ALL = N_ATT + N_GM + N_SA + N_SG;
        for (int it = bx; it < N_ALL; it += G) {
            int r = it;
            if (r < N_ATT) { attn_item(r, PROJ, O3, ML, lds, tid, wave, lane); continue; } r -= N_ATT;
            if (r < N_GM) { gmlp_item(r, PROJ, VST, wsp, bsp, lng, lnb, YA, lds, tid, wave, lane); continue; } r -= N_GM;
            if (r < N_SA) { attn_sample_item(r, PROJ, c128, c512, c2048, O3, ML, wave, lane); continue; } r -= N_SA;
            gmlp_sample_item(r, PROJ, VST, wsp, bsp, lng, lnb, YA, out, lds, tid, wave, lane);
        }
    }
    grid.sync();
    for (int row = gw; row < MT; row += NGW) {
        const int head = lane >> 3;
        float mg[3], lg[3];
#pragma unroll
        for (int g = 0; g < 3; ++g) { const f32x2 a = *(const f32x2*)(ML + (((size_t)g * MT + row) * 8 + head) * 2); mg[g] = a[0]; lg[g] = a[1]; }
        const float mm = fmaxf(fmaxf(mg[0], mg[1]), mg[2]);
        float wg[3]; float den = 0.f;
#pragma unroll
        for (int g = 0; g < 3; ++g) { wg[g] = __expf(mg[g] - mm) * lg[g]; den += wg[g]; }
        const float rden = 1.f / den;
        float o[8] = {0.f, 0.f, 0.f, 0.f, 0.f, 0.f, 0.f, 0.f};
#pragma unroll
        for (int g = 0; g < 3; ++g) { const v4u raw = *(const v4u*)(O3 + ((size_t)g * MT + row) * 512 + lane * 8); const float w = wg[g] * rden;
            o[0] += w * bflo(raw.x); o[1] += w * bfhi(raw.x); o[2] += w * bflo(raw.y); o[3] += w * bfhi(raw.y); o[4] += w * bflo(raw.z); o[5] += w * bfhi(raw.z); o[6] += w * bflo(raw.w); o[7] += w * bfhi(raw.w); }
        const v4u zr = *(const v4u*)(PROJ + (size_t)row * DIN + C_ZB + lane * 8);
        v4u w; w.x = pk2(o[0] * silu(bflo(zr.x)), o[1] * silu(bfhi(zr.x))); w.y = pk2(o[2] * silu(bflo(zr.y)), o[3] * silu(bfhi(zr.y)));
        w.z = pk2(o[4] * silu(bflo(zr.z)), o[5] * silu(bfhi(zr.z))); w.w = pk2(o[6] * silu(bflo(zr.w)), o[7] * silu(bfhi(zr.w)));
        *(v4u*)(YB + (size_t)row * 512 + lane * 8) = w;
    }
    grid.sync();
    {
        pg8::Gemm gm{YA, WPA_T, MT, DM, DM}; pg8::StaticOrder S; S.init(MT, DM, G, bx);
        pg8::EpiGateA E{PROJ, PART};
        pg8::gemm_phase<pg8::EpiGateA, pg8::StaticOrder, true, true>(lds, gm, S, E);
    }
    {
        pg8::Gemm gm{YB, WPB_T, MT, DM, 512}; pg8::StaticOrder S; S.init(MT, DM, G, bx);
        pg8::EpiGateB E{PROJ, PART, MRG};
        pg8::gemm_phase<pg8::EpiGateB, pg8::StaticOrder, true, true>(lds, gm, S, E);
    }
    grid.sync();
    {
        pg8::Gemm gm{MRG, WOUT_T, MT, DM, DM}; pg8::StaticOrder S; S.init(MT, DM, G, bx);
        pg8::EpiF32 E{OUTB};
        pg8::gemm_phase<pg8::EpiF32, pg8::StaticOrder, true, true>(lds, gm, S, E);
    }
    grid.sync();
    for (int row = gw; row < MT; row += NGW) {
        const float* xr = row < MP ? xp + (size_t)row * DM : xs + (size_t)(row - MP) * DM;
        const float* gate = MOD + (row < MP ? (row >> 11) : 8 + ((row - MP) >> 3)) * 3072 + 2048;
        const float* orow = OUTB + (size_t)row * DM;
        f32x4 v[4]; float ss = 0.f;
#pragma unroll
        for (int j = 0; j < 4; ++j) { v[j] = ((const f32x4*)orow)[lane + 64 * j]; ss += (v[j][0] * v[j][0] + v[j][1] * v[j][1]) + (v[j][2] * v[j][2] + v[j][3] * v[j][3]); }
        const float rstd = rsqrtf(wave_sum(ss) * (1.f / DM) + EPS);
#pragma unroll
        for (int j = 0; j < 4; ++j) { const int c = 4 * lane + 256 * j;
            const f32x4 gp = *(const f32x4*)(gpost + c), gt = *(const f32x4*)(gate + c), xx = ((const f32x4*)xr)[lane + 64 * j];
            *(f32x4*)(out + (size_t)row * DM + c) = xx + gt * (v[j] * rstd * gp); }
    }
}

extern "C" void kernel_launch(void* const* d_in, const int* in_sizes, int n_in, void* d_out, int out_size, void* d_ws, size_t ws_size, hipStream_t stream) {
    static int grid = 0;
    if (grid == 0) {
        if (n_in != 19 || (size_t)out_size != O_END || ws_size < WS_END) { fprintf(stderr, "kernel_launch: unexpected shapes: n_in %d out %d ws %zu\n", n_in, out_size, ws_size); grid = -1; return; }
        int dev = 0, cus = 0, per_cu = 0;
        if (hipGetDevice(&dev) != hipSuccess || hipDeviceGetAttribute(&cus, hipDeviceAttributeMultiprocessorCount, dev) != hipSuccess) { fprintf(stderr, "kernel_launch: device query failed\n"); grid = -1; return; }
        if (hipFuncSetAttribute((const void*)fwd_kernel, hipFuncAttributeMaxDynamicSharedMemorySize, LDS_BYTES) != hipSuccess) { fprintf(stderr, "kernel_launch: hipFuncSetAttribute failed\n"); grid = -1; return; }
        if (hipOccupancyMaxActiveBlocksPerMultiprocessor(&per_cu, (const void*)fwd_kernel, NTHR, LDS_BYTES) != hipSuccess || per_cu < 1) { fprintf(stderr, "kernel_launch: occupancy query says %d blocks per CU\n", per_cu); }
        (void)hipGetLastError();
        grid = cus;
    }
    if (grid < 0) return;
    Args a{};
    for (int i = 0; i < 19; ++i) a.in[i] = (const float*)d_in[i];
    a.out = (float*)d_out; a.ws = (unsigned char*)d_ws;
    void* kargs[] = {&a};
    hipError_t e = hipLaunchCooperativeKernel((const void*)fwd_kernel, dim3(grid), dim3(NTHR), kargs, LDS_BYTES, stream);
    if (e != hipSuccess) fprintf(stderr, "kernel_launch: cooperative launch failed: %s (grid %d)\n", hipGetErrorString(e), grid);
}
```

```cpp
#include <hip/hip_runtime.h>
#include <hip/hip_cooperative_groups.h>
#include <cstdio>
#include <cstdint>
namespace cg = cooperative_groups;
namespace pg8 {
#define PG8_LAS __attribute__((address_space(3)))
typedef unsigned short bf16_t;
typedef short bf16x8 __attribute__((ext_vector_type(8)));
typedef float f32x4 __attribute__((ext_vector_type(4)));
typedef unsigned u32x4 __attribute__((ext_vector_type(4)));
constexpr int BM = 256, BK = 64, HALF = 128, HTB = HALF * BK * 2  , STAGE_BYTES = 8 * HTB, NXCD = 8, WGM = 8;

__host__ __device__ __forceinline__ int lds_byte(int r, int c) { const int st = (r >> 4) * 2 + (c >> 5), rr = r & 15, cc = c & 31, ob = rr * 64 + cc * 2; return st * 1024 + (ob ^ (((ob >> 9) & 1) << 5)); }
__host__ __device__ __forceinline__ void stage_rc(int b, int& R, int& C) { const int st = b / 1024, sb = b % 1024, swz = sb ^ (((sb >> 9) & 1) << 5); R = (st >> 1) * 16 + swz / 64; C = (st & 1) * 32 + (swz % 64) / 2; }
__host__ __device__ __forceinline__ int perm32(int rho) { const int n = rho >> 4, i = rho & 15; return 8 * (i >> 2) + 4 * n + (i & 3); }

struct Unit { int pm, pn; };
struct Gemm { const bf16_t* A; const bf16_t* Bt; int M, N, K; };

struct StaticOrder {
    int nM, nN, nwg, G, c;
    __host__ __device__ void init(int M, int N, int G_, int c_) { nM = M / BM; nN = N / BM; nwg = nM * nN; G = G_; c = c_; }
    __host__ __device__ bool next(int i, Unit& u) const {
        const long L = (long)i * G + c; if (L >= nwg) return false;
        int wgid = (int)L; { const int q = nwg / NXCD, r = nwg % NXCD, xcd = wgid % NXCD, off = wgid / NXCD; wgid = (xcd < r ? xcd * (q + 1) : r * (q + 1) + (xcd - r) * q) + off; }
        const int nig = WGM * nN, gid = wgid / nig, fm = gid * WGM, gsz = (nM - fm) < WGM ? (nM - fm) : WGM;
        u.pm = fm + ((wgid % nig) % gsz); u.pn = (wgid % nig) / gsz; return true;
    }
    __device__ __forceinline__ void a_ready(const Unit&) const {}
    __device__ __forceinline__ void done(const Unit&) const {}
};
__device__ __forceinline__ unsigned cvt_pk_bf16(float lo, float hi) { unsigned r; asm volatile("v_cvt_pk_bf16_f32 %0, %1, %2" : "=v"(r) : "v"(lo), "v"(hi)); return r; }
typedef float f32x2 __attribute__((ext_vector_type(2)));
template <class Epi, class Sched, bool ALIGN_EPI = false, bool SP2 = false>
__device__ __forceinline__ void gemm_phase(PG8_LAS unsigned char* lds, const Gemm g, const Sched& S, const Epi& E) {
    const int tid = threadIdx.x, wid = __builtin_amdgcn_readfirstlane(tid >> 6), lane = tid & 63, wr = wid >> 2, wc = wid & 3, fr = lane & 15, fq = lane >> 4;
    const int K = g.K, nt = K / BK;
    unsigned voffA[2], voffB[2];
#pragma unroll
    for (int i = 0; i < 2; ++i) { int R, C; stage_rc(tid * 16 + i * 8192, R, C); const int Rb = Epi::PERM ? ((R & ~31) + perm32(R & 31)) : R;
        voffA[i] = (unsigned)(R * K + C) * 2u; voffB[i] = (unsigned)(Rb * K + C) * 2u; }
    const size_t kstep = (size_t)(BK * 2);
    const size_t hstep = (size_t)HALF * K * 2;
    const size_t tstep = 2 * hstep;
    const unsigned ldsw = (unsigned)wid * 1024u;
    const int aoff = lds_byte(wr * 64 + fr, fq * 8), boff = lds_byte(wc * 32 + fr, fq * 8);
#define PG8_SA(b, h) (((b) * 2 + (h)) * HTB)
#define PG8_SB(b, h) ((4 + (b) * 2 + (h)) * HTB)
#define PG8_STAGE(bufoff, gbase, voff) do { _Pragma("unroll") for (int _i = 0; _i < 2; ++_i) \
        __builtin_amdgcn_global_load_lds((const unsigned*)((const char*)(gbase) + (voff)[_i]), (PG8_LAS unsigned*)(lds + (bufoff) + ldsw + _i * 8192), 16, 0, 0); } while (0)
#define PG8_LDA(dst, b, h) do { _Pragma("unroll") for (int m = 0; m < 4; ++m) _Pragma("unroll") for (int k = 0; k < 2; ++k) dst[m][k] = *(const PG8_LAS bf16x8*)(lds + PG8_SA(b, h) + aoff + m * 2048 + k * 1024); } while (0)
#define PG8_LDB(dst, b, h) do { _Pragma("unroll") for (int n = 0; n < 2; ++n) _Pragma("unroll") for (int k = 0; k < 2; ++k) dst[n][k] = *(const PG8_LAS bf16x8*)(lds + PG8_SB(b, h) + boff + n * 2048 + k * 1024); } while (0)
#define PG8_MMA(ai, bj, At, Bt) do { __builtin_amdgcn_s_setprio(1); _Pragma("unroll") for (int m = 0; m < 4; ++m) _Pragma("unroll") for (int n = 0; n < 2; ++n) _Pragma("unroll") for (int k = 0; k < 2; ++k) \
        acc[ai][bj][m][n] = __builtin_amdgcn_mfma_f32_16x16x32_bf16(Bt[n][k], At[m][k], acc[ai][bj][m][n], 0, 0, 0); __builtin_amdgcn_s_setprio(0); } while (0)
#define PG8_WAIT_V(n) asm volatile("s_waitcnt vmcnt(" #n ")" ::: "memory")
#define PG8_WAIT_L(n) asm volatile("s_waitcnt lgkmcnt(" #n ")" ::: "memory")
#define PG8_BAR __builtin_amdgcn_s_barrier()
#define PG8_SCHED __builtin_amdgcn_sched_barrier(0)
    Unit cur, nxt; int ui = 0;
    if (!S.next(0, cur)) return;
    f32x4 acc[2][2][4][2];
#pragma unroll
    for (int a = 0; a < 2; ++a)
#pragma unroll
        for (int b = 0; b < 2; ++b)
#pragma unroll
            for (int m = 0; m < 4; ++m)
#pragma unroll
                for (int n = 0; n < 2; ++n) acc[a][b][m][n] = (f32x4){0.f, 0.f, 0.f, 0.f};
    bf16x8 At[4][2], B0[2][2], B1[2][2];
    const char* cA = (const char*)g.A + (size_t)cur.pm * tstep; const char* cB = (const char*)g.Bt + (size_t)cur.pn * tstep;
    S.a_ready(cur);
    if constexpr (SP2) {
        PG8_STAGE(PG8_SB(0, 0), cB, voffB); PG8_STAGE(PG8_SB(0, 1), cB + hstep, voffB); PG8_STAGE(PG8_SA(0, 0), cA, voffA); PG8_STAGE(PG8_SA(0, 1), cA + hstep, voffA);
        if (wr == 1) PG8_BAR;
        PG8_WAIT_V(2); PG8_BAR;
        PG8_STAGE(PG8_SB(1, 0), cB + kstep, voffB); PG8_STAGE(PG8_SA(1, 0), cA + kstep, voffA); PG8_STAGE(PG8_SB(1, 1), cB + hstep + kstep, voffB);
        PG8_WAIT_V(6); PG8_BAR;
    } else {
        PG8_STAGE(PG8_SB(0, 0), cB, voffB); PG8_STAGE(PG8_SA(0, 0), cA, voffA); PG8_STAGE(PG8_SB(0, 1), cB + hstep, voffB); PG8_STAGE(PG8_SA(0, 1), cA + hstep, voffA);
        if (wr == 1) PG8_BAR;
        PG8_WAIT_V(4); PG8_BAR;
        PG8_STAGE(PG8_SB(1, 0), cB + kstep, voffB); PG8_STAGE(PG8_SA(1, 0), cA + kstep, voffA); PG8_STAGE(PG8_SB(1, 1), cB + hstep + kstep, voffB);
        PG8_WAIT_V(6); PG8_BAR;
    }
    for (;;) {
        const bool has_next = S.next(ui + 1, nxt);
        const char* nA = has_next ? (const char*)g.A + (size_t)nxt.pm * tstep : cA; const char* nB = has_next ? (const char*)g.Bt + (size_t)nxt.pn * tstep : cB;
        for (int t = 0; t < nt; t += 2) {
            const bool last = (t == nt - 2);
            const char* a1 = cA + (size_t)(t + 1) * kstep;
            const char* a2 = last ? nA : cA + (size_t)(t + 2) * kstep; const char* b2 = last ? nB : cB + (size_t)(t + 2) * kstep;
            const char* a3 = a2 + kstep; const char* b3 = b2 + kstep;
            if (last && has_next) S.a_ready(nxt);
            if constexpr (SP2) {
            PG8_LDB(B0, 0, 0); PG8_LDB(B1, 0, 1); PG8_SCHED; PG8_LDA(At, 0, 0); PG8_STAGE(PG8_SA(1, 1), a1 + hstep, voffA);
            PG8_WAIT_V(8); PG8_WAIT_L(0); PG8_BAR; PG8_MMA(0, 0, At, B0); PG8_MMA(0, 1, At, B1); PG8_BAR; PG8_SCHED;
            PG8_LDA(At, 0, 1); PG8_STAGE(PG8_SB(0, 0), b2, voffB); PG8_STAGE(PG8_SB(0, 1), b2 + hstep, voffB); PG8_STAGE(PG8_SA(0, 0), a2, voffA);
            PG8_WAIT_V(8); PG8_WAIT_L(0); PG8_BAR; PG8_MMA(1, 0, At, B0); PG8_MMA(1, 1, At, B1); PG8_BAR; PG8_SCHED;
            PG8_LDB(B0, 1, 0); PG8_LDB(B1, 1, 1); PG8_SCHED; PG8_LDA(At, 1, 0); PG8_STAGE(PG8_SA(0, 1), a2 + hstep, voffA);
            PG8_WAIT_V(8); PG8_WAIT_L(0); PG8_BAR; PG8_MMA(0, 0, At, B0); PG8_MMA(0, 1, At, B1); PG8_BAR; PG8_SCHED;
            PG8_LDA(At, 1, 1); PG8_STAGE(PG8_SB(1, 0), b3, voffB); PG8_STAGE(PG8_SB(1, 1), b3 + hstep, voffB); PG8_STAGE(PG8_SA(1, 0), a3, voffA);
            PG8_WAIT_V(8); PG8_WAIT_L(0); PG8_BAR; PG8_MMA(1, 0, At, B0); PG8_MMA(1, 1, At, B1); PG8_BAR; PG8_SCHED;
            } else {
            PG8_LDB(B0, 0, 0); PG8_SCHED; PG8_LDA(At, 0, 0); PG8_STAGE(PG8_SA(1, 1), a1 + hstep, voffA);
            PG8_WAIT_L(8); PG8_BAR; PG8_WAIT_L(0); PG8_MMA(0, 0, At, B0); PG8_BAR; PG8_SCHED;
            PG8_LDB(B1, 0, 1); PG8_STAGE(PG8_SB(0, 0), b2, voffB);
            PG8_BAR; PG8_WAIT_L(0); PG8_MMA(0, 1, At, B1); PG8_BAR;
            PG8_LDA(At, 0, 1); PG8_STAGE(PG8_SA(0, 0), a2, voffA);
            PG8_BAR; PG8_WAIT_L(0); PG8_MMA(1, 0, At, B0); PG8_BAR; PG8_SCHED;
            PG8_STAGE(PG8_SB(0, 1), b2 + hstep, voffB);
            PG8_WAIT_V(6); PG8_BAR; PG8_MMA(1, 1, At, B1); PG8_BAR;
            PG8_LDB(B0, 1, 0); PG8_SCHED; PG8_LDA(At, 1, 0); PG8_STAGE(PG8_SA(0, 1), a2 + hstep, voffA);
            PG8_WAIT_L(8); PG8_BAR; PG8_WAIT_L(0); PG8_MMA(0, 0, At, B0); PG8_BAR; PG8_SCHED;
            PG8_LDB(B1, 1, 1); PG8_STAGE(PG8_SB(1, 0), b3, voffB);
            PG8_BAR; PG8_WAIT_L(0); PG8_MMA(0, 1, At, B1); PG8_BAR;
            PG8_LDA(At, 1, 1); PG8_STAGE(PG8_SA(1, 0), a3, voffA);
            PG8_BAR; PG8_WAIT_L(0); PG8_MMA(1, 0, At, B0); PG8_BAR; PG8_SCHED;
            PG8_STAGE(PG8_SB(1, 1), b3 + hstep, voffB);
            PG8_WAIT_V(6); PG8_BAR; PG8_MMA(1, 1, At, B1); PG8_BAR;
            }
        }
        if constexpr (ALIGN_EPI) { if (wr == 0) PG8_BAR; }
        if constexpr (!Epi::AFTER_DRAIN) { E(acc, cur, wr, wc, fr, fq); S.done(cur); }
        if (!has_next) break;
#pragma unroll
        for (int a = 0; a < 2; ++a)
#pragma unroll
            for (int b = 0; b < 2; ++b)
#pragma unroll
                for (int m = 0; m < 4; ++m)
#pragma unroll
                    for (int n = 0; n < 2; ++n) acc[a][b][m][n] = (f32x4){0.f, 0.f, 0.f, 0.f};
        cur = nxt; cA = nA; cB = nB; ++ui;
        if constexpr (ALIGN_EPI) { if (wr == 1) PG8_BAR; }
    }
    PG8_WAIT_V(0);
    if constexpr (!ALIGN_EPI) { if (wr == 0) PG8_BAR; }
    PG8_BAR;
    if constexpr (Epi::AFTER_DRAIN) { E.fused(acc, cur, wr, wc, fr, fq, lds, wid, lane); S.done(cur); }
#undef PG8_SA
#undef PG8_SB
#undef PG8_STAGE
#undef PG8_LDA
#undef PG8_LDB
#undef PG8_MMA
#undef PG8_WAIT_V
#undef PG8_WAIT_L
#undef PG8_BAR
#undef PG8_SCHED
}
}

#define GAS __attribute__((address_space(1)))
#define LAS __attribute__((address_space(3)))
typedef unsigned short bf16;
typedef unsigned v4u __attribute__((ext_vector_type(4)));
typedef unsigned v2u __attribute__((ext_vector_type(2)));
typedef float f32x4 __attribute__((ext_vector_type(4)));
typedef float f32x2 __attribute__((ext_vector_type(2)));
typedef short bf16x8 __attribute__((ext_vector_type(8)));

constexpr int NWAVES = 8, NTHR = 512;
constexpr int DM = 1024, NBP = 8, SEQ = 2048, NBS = 32, TS = 8;
constexpr int MP = NBP * SEQ, MS = NBS * TS, MT = MP + MS;
constexpr int DIN = 10240;
constexpr int C_U = 0, C_V = 1024, C_Z = 2048, C_Q = 3072, C_K = 4608, C_VV = 6144, C_ZB = 7680, C_GA = 8192, C_GB = 9216;
constexpr float EPS = 1e-6f;
constexpr size_t O_Y = 0, O_KVP0 = (size_t)MT * DM, O_KVP1 = O_KVP0 + (size_t)8 * 128 * 1024, O_KVP2 = O_KVP1 + (size_t)8 * 512 * 1024,
                 O_KVS0 = O_KVP2 + (size_t)8 * 2048 * 1024, O_KVS1 = O_KVS0 + 262144, O_KVS2 = O_KVS1 + 262144, O_VCH = O_KVS2 + 262144, O_END = O_VCH + 262144;
constexpr size_t MiB = 1u << 20;
constexpr size_t WS_WIN = 2 * MiB, WS_WPA = 22 * MiB, WS_WPB = 24 * MiB, WS_WOUT = 25 * MiB, WS_MOD = 27 * MiB, WS_VST = 29 * MiB, WS_ML = 32 * MiB,
                 WS_H = 36 * MiB, WS_YA = 70 * MiB, WS_YB = 104 * MiB, WS_MRG = 122 * MiB, WS_O3 = 156 * MiB, WS_PART = 206 * MiB, WS_OUT = 272 * MiB,
                 WS_PROJ = 340 * MiB, WS_END = 672 * MiB;
static_assert(WS_PROJ + (size_t)MT * DIN * 2 <= WS_END, "ws map");
constexpr int LDS_BYTES = 147456;

#define LDS_WAIT() asm volatile("s_waitcnt lgkmcnt(0)" ::: "memory")
__device__ __forceinline__ unsigned f2bf(float f) { unsigned u = __builtin_bit_cast(unsigned, f); return (u + 0x7fffu + ((u >> 16) & 1u)) >> 16; }
__device__ __forceinline__ unsigned pk2(float lo, float hi) { return f2bf(lo) | (f2bf(hi) << 16); }
__device__ __forceinline__ float bflo(unsigned w) { return __builtin_bit_cast(float, w << 16); }
__device__ __forceinline__ float bfhi(unsigned w) { return __builtin_bit_cast(float, w & 0xffff0000u); }
__device__ __forceinline__ float bf2f(bf16 h) { return __builtin_bit_cast(float, (unsigned)h << 16); }
__device__ __forceinline__ float sigm(float x) { return 1.f / (1.f + __expf(-x)); }
__device__ __forceinline__ float silu(float x) { return x / (1.f + __expf(-x)); }
__device__ __forceinline__ float wave_sum(float v) {
#pragma unroll
    for (int o = 1; o < 64; o <<= 1) v += __shfl_xor(v, o);
    return v;
}
__device__ __forceinline__ float wave_max(float v) {
#pragma unroll
    for (int o = 1; o < 64; o <<= 1) v = fmaxf(v, __shfl_xor(v, o));
    return v;
}
__device__ __forceinline__ float rdlane(float v, int l) { return __builtin_bit_cast(float, __builtin_amdgcn_readlane(__builtin_bit_cast(int, v), l)); }

#define XB_TMO      128
#define XB_XCNT(j)  (256  + 64 * (j))
#define XB_XSUB(j)  (1280 + 64 * (j))
#define XB_XGEN(j)  (2304 + 64 * (j))
#define XB_TOP      3328
#define XB_TOPGEN   3392
#define XCD_BAR_WORDS 3456
#define XB_SPIN_CAP (1u << 18)

__device__ __forceinline__ unsigned xb_ld(unsigned* p)              { return __hip_atomic_load(p, __ATOMIC_RELAXED, __HIP_MEMORY_SCOPE_AGENT); }
__device__ __forceinline__ unsigned xb_add(unsigned* p, unsigned v) { return __hip_atomic_fetch_add(p, v, __ATOMIC_RELAXED, __HIP_MEMORY_SCOPE_AGENT); }
__device__ __forceinline__ unsigned xb_xcc_id() { return (unsigned)__builtin_amdgcn_s_getreg((3 << 11) | 20) & 0xFu; }
#define XB_SPIN(cond, bar) do { unsigned _sp = 0; while (cond) { __builtin_amdgcn_s_sleep(1); \
    if ((++_sp & 255u) == 0u) { if (xb_ld(&(bar)[XB_TMO])) break; if (_sp > XB_SPIN_CAP) { atomicAdd(&(bar)[XB_TMO], 1u); break; } } } } while (0)

struct XcdBarrier {
    unsigned* bar; unsigned x;
    volatile LAS unsigned* st;
};

__device__ __forceinline__ XcdBarrier xcd_barrier_post(unsigned* bar, volatile LAS unsigned* st) {
    XcdBarrier b; b.bar = bar; b.x = xb_xcc_id(); b.st = st;
    if (threadIdx.x == 0) (void)xb_add(&bar[XB_XCNT(b.x)], 1u);
    return b;
}
__device__ __forceinline__ void xcd_barrier_complete(unsigned* bar, unsigned x, unsigned& nloc, unsigned& nx) {
    const unsigned G = gridDim.x * gridDim.y * gridDim.z;
    unsigned sum, cnt, mine, sp = 0u;
    for (;;) {
        sum = 0u; cnt = 0u; mine = 0u;
#pragma unroll
        for (unsigned j = 0; j < 16; ++j) { const unsigned c = xb_ld(&bar[XB_XCNT(j)]); sum += c; cnt += (c > 0u) ? 1u : 0u; mine = (j == x) ? c : mine; }
        if (sum == G) break;
        __builtin_amdgcn_s_sleep(1);
        if ((++sp & 255u) == 0u) { if (xb_ld(&bar[XB_TMO])) break; if (sp > XB_SPIN_CAP) { atomicAdd(&bar[XB_TMO], 1u); break; } }
    }
    nloc = mine > 0u ? mine : 1u; nx = cnt > 0u ? cnt : 1u;
}

__device__ __forceinline__ void xcd_barrier(const XcdBarrier& b) {
    asm volatile("s_waitcnt vmcnt(0)" ::: "memory");
    __syncthreads();
    if (threadIdx.x == 0) {
        unsigned* bar = b.bar;
        __builtin_amdgcn_s_waitcnt(0);
        unsigned nloc = b.st[0], nx = b.st[1];
        if (nloc == 0u) { xcd_barrier_complete(bar, b.x, nloc, nx); b.st[0] = nloc; b.st[1] = nx; }
        const unsigned old = xb_add(&bar[XB_XSUB(b.x)], 1u);
        const unsigned gen = old / nloc;
        if (old + 1u == (gen + 1u) * nloc) {
            __builtin_amdgcn_fence(__ATOMIC_RELEASE, "agent");
            asm volatile("s_waitcnt vmcnt(0)" ::: "memory");
            const unsigned og = xb_add(&bar[XB_TOP], 1u);
            const unsigned tg = og / nx;
            if (og + 1u == (tg + 1u) * nx) xb_add(&bar[XB_TOPGEN], 1u);
            else XB_SPIN(xb_ld(&bar[XB_TOPGEN]) == tg, bar);
            __builtin_amdgcn_fence(__ATOMIC_ACQUIRE, "agent");
            xb_add(&bar[XB_XGEN(b.x)], 1u);
            asm volatile("s_waitcnt vmcnt(0)" ::: "memory");
        } else {
            XB_SPIN(xb_ld(&bar[XB_XGEN(b.x)]) == gen, bar);
            __builtin_amdgcn_fence(__ATOMIC_ACQUIRE, "agent");
            asm volatile("s_waitcnt vmcnt(0)" ::: "memory");
        }
    }
    __syncthreads();
}

namespace pg8 {
struct EpiProj {
    static constexpr bool PERM = true, AFTER_DRAIN = false;
    bf16_t* P; float* out; float* vst;
    __device__ __forceinline__ void operator()(const f32x4 (&acc)[2][2][4][2], const Unit& u, int wr, int wc, int fr, int fq) const {
        const int row0 = u.pm * BM + wr * 64 + fr;
        const int colt = u.pn * BM + wc * 32 + 8 * fq;
#pragma unroll
        for (int ai = 0; ai < 2; ++ai)
#pragma unroll
            for (int m = 0; m < 4; ++m) { bf16_t* rowp = P + (size_t)(row0 + ai * HALF + m * 16) * DIN + colt;
#pragma unroll
                for (int bj = 0; bj < 2; ++bj) { const f32x4 v0 = acc[ai][bj][m][0], v1 = acc[ai][bj][m][1];
                    u32x4 w; w.x = cvt_pk_bf16(v0[0], v0[1]); w.y = cvt_pk_bf16(v0[2], v0[3]); w.z = cvt_pk_bf16(v1[0], v1[1]); w.w = cvt_pk_bf16(v1[2], v1[3]);
                    *(u32x4*)(rowp + bj * HALF) = w; } }
        if (u.pn >= 4 && u.pn < 8) {
#pragma unroll
            for (int ai = 0; ai < 2; ++ai)
#pragma unroll
                for (int m = 0; m < 4; ++m) { float s = 0.f, q = 0.f;
#pragma unroll
                    for (int bj = 0; bj < 2; ++bj)
#pragma unroll
                        for (int n = 0; n < 2; ++n) { const f32x4 x = acc[ai][bj][m][n]; s += (x[0] + x[1]) + (x[2] + x[3]); q += (x[0] * x[0] + x[1] * x[1]) + (x[2] * x[2] + x[3] * x[3]); }
                    s += __shfl_xor(s, 16); s += __shfl_xor(s, 32); q += __shfl_xor(q, 16); q += __shfl_xor(q, 32);
                    if (fq == 0) { float* d = vst + ((size_t)(row0 + ai * HALF + m * 16) * 16 + (u.pn - 4) * 4 + wc) * 2; *(f32x2*)d = (f32x2){s, q}; } }
        }
        if (u.pn >= 18 && u.pn < 30) {
            const int kv = u.pn >= 24 ? 1 : 0; const int t = u.pn - 18 - 6 * kv; const int g = t >> 1, half = t & 1;
            const int dcol = kv * 512 + half * 256 + wc * 32 + 8 * fq;
            const int R = g == 0 ? 128 : (g == 1 ? 512 : 2048);
            const size_t obp = g == 0 ? O_KVP0 : (g == 1 ? O_KVP1 : O_KVP2), obs = g == 0 ? O_KVS0 : (g == 1 ? O_KVS1 : O_KVS2);
#pragma unroll
            for (int ai = 0; ai < 2; ++ai)
#pragma unroll
                for (int m = 0; m < 4; ++m) { const int row = row0 + ai * HALF + m * 16; float* base = nullptr;
                    if (row < MP) { const int b = row >> 11, s = row & 2047, r = s - (2048 - R); if (r >= 0) base = out + obp + (size_t)(b * R + r) * 1024 + dcol; }
                    else base = out + obs + (size_t)(row - MP) * 1024 + dcol;
                    if (base) {
#pragma unroll
                        for (int bj = 0; bj < 2; ++bj)
#pragma unroll
                            for (int n = 0; n < 2; ++n) *(f32x4*)(base + bj * HALF + 4 * n) = acc[ai][bj][m][n]; } }
        }
    }
};
struct EpiGateA {
    static constexpr bool PERM = true, AFTER_DRAIN = false;
    const bf16_t* P; float* part;
    __device__ __forceinline__ void operator()(const f32x4 (&acc)[2][2][4][2], const Unit& u, int wr, int wc, int fr, int fq) const {
        const int row0 = u.pm * BM + wr * 64 + fr; const int colt = u.pn * BM + wc * 32 + 8 * fq;
#pragma unroll
        for (int ai = 0; ai < 2; ++ai)
#pragma unroll
            for (int m = 0; m < 4; ++m) { const size_t row = (size_t)(row0 + ai * HALF + m * 16); const bf16_t* gp = P + row * DIN + C_GA + colt; float* pp = part + row * DM + colt;
#pragma unroll
                for (int bj = 0; bj < 2; ++bj) { const u32x4 gw = *(const u32x4*)(gp + bj * HALF); const f32x4 a0 = acc[ai][bj][m][0], a1 = acc[ai][bj][m][1];
                    f32x4 o0, o1; o0[0] = a0[0] * sigm(bflo(gw.x)); o0[1] = a0[1] * sigm(bfhi(gw.x)); o0[2] = a0[2] * sigm(bflo(gw.y)); o0[3] = a0[3] * sigm(bfhi(gw.y));
                    o1[0] = a1[0] * sigm(bflo(gw.z)); o1[1] = a1[1] * sigm(bfhi(gw.z)); o1[2] = a1[2] * sigm(bflo(gw.w)); o1[3] = a1[3] * sigm(bfhi(gw.w));
                    *(f32x4*)(pp + bj * HALF) = o0; *(f32x4*)(pp + bj * HALF + 4) = o1; } }
    }
};
struct EpiGateB {
    static constexpr bool PERM = true, AFTER_DRAIN = false;
    const bf16_t* P; const float* part; bf16_t* mrg;
    __device__ __forceinline__ void operator()(const f32x4 (&acc)[2][2][4][2], const Unit& u, int wr, int wc, int fr, int fq) const {
        const int row0 = u.pm * BM + wr * 64 + fr; const int colt = u.pn * BM + wc * 32 + 8 * fq;
#pragma unroll
        for (int ai = 0; ai < 2; ++ai)
#pragma unroll
            for (int m = 0; m < 4; ++m) { const size_t row = (size_t)(row0 + ai * HALF + m * 16); const bf16_t* gp = P + row * DIN + C_GB + colt; const float* pp = part + row * DM + colt;
#pragma unroll
                for (int bj = 0; bj < 2; ++bj) { const u32x4 gw = *(const u32x4*)(gp + bj * HALF); const f32x4 a0 = acc[ai][bj][m][0], a1 = acc[ai][bj][m][1];
                    const f32x4 p0 = *(const f32x4*)(pp + bj * HALF), p1 = *(const f32x4*)(pp + bj * HALF + 4);
                    f32x4 o0, o1; o0[0] = p0[0] + a0[0] * sigm(bflo(gw.x)); o0[1] = p0[1] + a0[1] * sigm(bfhi(gw.x)); o0[2] = p0[2] + a0[2] * sigm(bflo(gw.y)); o0[3] = p0[3] + a0[3] * sigm(bfhi(gw.y));
                    o1[0] = p1[0] + a1[0] * sigm(bflo(gw.z)); o1[1] = p1[1] + a1[1] * sigm(bfhi(gw.z)); o1[2] = p1[2] + a1[2] * sigm(bflo(gw.w)); o1[3] = p1[3] + a1[3] * sigm(bfhi(gw.w));
                    u32x4 w; w.x = cvt_pk_bf16(o0[0], o0[1]); w.y = cvt_pk_bf16(o0[2], o0[3]); w.z = cvt_pk_bf16(o1[0], o1[1]); w.w = cvt_pk_bf16(o1[2], o1[3]);
                    *(u32x4*)(mrg + row * DM + colt + bj * HALF) = w; } }
    }
};
struct EpiF32 {
    static constexpr bool PERM = true, AFTER_DRAIN = false;
    float* O;
    __device__ __forceinline__ void operator()(const f32x4 (&acc)[2][2][4][2], const Unit& u, int wr, int wc, int fr, int fq) const {
        const int row0 = u.pm * BM + wr * 64 + fr; const int colt = u.pn * BM + wc * 32 + 8 * fq;
#pragma unroll
        for (int ai = 0; ai < 2; ++ai)
#pragma unroll
            for (int m = 0; m < 4; ++m) { float* pp = O + (size_t)(row0 + ai * HALF + m * 16) * DM + colt;
#pragma unroll
                for (int bj = 0; bj < 2; ++bj) { *(f32x4*)(pp + bj * HALF) = acc[ai][bj][m][0]; *(f32x4*)(pp + bj * HALF + 4) = acc[ai][bj][m][1]; } }
    }
};
}

__device__ __forceinline__ void p0_transpose_item(const float* W, int K, int N, bf16* WT, int row_off, LAS float* scr, int item, int lane) {
    const int nblk = N / 32, kb = item / nblk, nb = item % nblk, k0 = 64 * kb, n0 = 32 * nb;
#pragma unroll 8
    for (int i = 0; i < 32; ++i) { const int kk = 2 * i + (lane >> 5); scr[kk * 33 + (lane & 31)] = W[(size_t)(k0 + kk) * N + n0 + (lane & 31)]; }
    LDS_WAIT(); asm volatile("" ::: "memory");
    const int c = lane & 7;
#pragma unroll
    for (int j = 0; j < 4; ++j) { const int n = (lane >> 3) + 8 * j; const LAS float* s = scr + (8 * c) * 33 + n;
        v4u o; o.x = pk2(s[0 * 33], s[1 * 33]); o.y = pk2(s[2 * 33], s[3 * 33]); o.z = pk2(s[4 * 33], s[5 * 33]); o.w = pk2(s[6 * 33], s[7 * 33]);
        *(GAS v4u*)(WT + (size_t)(row_off + n0 + n) * K + k0 + 8 * c) = o; }
    LDS_WAIT(); asm volatile("" ::: "memory");
}
__device__ __forceinline__ void mod_task(int task, const float* cp, const float* cs, const float* Wc, const float* bc, float* MODP, LAS unsigned char* lds, int tid, int wave, int lane) {
    const int chunk = task >> 2, kq = task & 3;
    const int k0 = kq * 256 + wave * 32;
    float sc[40], acc[40];
#pragma unroll
    for (int r = 0; r < 40; ++r) { const float* crow = (r < 8) ? cp + r * 1024 : cs + (r - 8) * 1024; sc[r] = silu(crow[k0 + (lane & 31)]); acc[r] = 0.f; }
    const float* wp = Wc + (size_t)k0 * 3072 + chunk * 64 + lane;
#pragma unroll 8
    for (int kk = 0; kk < 32; ++kk) { const float wv = wp[(size_t)kk * 3072];
#pragma unroll
        for (int r = 0; r < 40; ++r) acc[r] += rdlane(sc[r], kk) * wv; }
    LAS float* red = (LAS float*)lds;
#pragma unroll
    for (int r = 0; r < 40; ++r) red[(wave * 40 + r) * 64 + lane] = acc[r];
    __syncthreads();
    for (int idx = tid; idx < 2560; idx += NTHR) { const int r = idx >> 6, cl = idx & 63; float s = 0.f;
#pragma unroll
        for (int w = 0; w < 8; ++w) s += red[(w * 40 + r) * 64 + cl];
        if (kq == 0) s += bc[chunk * 64 + cl];
        MODP[((size_t)kq * 40 + r) * 3072 + chunk * 64 + cl] = s; }
    __syncthreads();
}

__device__ __forceinline__ void attn_item(int idx, const bf16* PROJ, bf16* O3, float* ML, LAS unsigned char* lds, int tid, int wave, int lane) {
    const int g = idx >> 10; int rem = idx & 1023; const int b = rem >> 7; rem &= 127; const int h = rem >> 4; const int sub = rem & 15;
    int d, n, r;
    if (g == 0) { d = 1; n = sub; r = 0; } else if (g == 1) { d = 4; r = sub >> 2; n = sub & 3; } else { d = 16; r = sub; n = 0; }
    LAS bf16* Ks = (LAS bf16*)lds;
    LAS bf16* VT = (LAS bf16*)(lds + 36864);
    {
        const int key = tid >> 1, half = tid & 1; const int m = 128 * (n - 1) + key;
        v4u kk[4], vv[4];
        if (m >= 0) { const size_t row = (size_t)b * 2048 + (size_t)d * m + r; const bf16* src = PROJ + row * DIN + g * 512 + h * 64 + half * 32;
#pragma unroll
            for (int c = 0; c < 4; ++c) { kk[c] = *(const v4u*)(src + C_K + 8 * c); vv[c] = *(const v4u*)(src + C_VV + 8 * c); } }
        else {
#pragma unroll
            for (int c = 0; c < 4; ++c) { kk[c] = (v4u){0u, 0u, 0u, 0u}; vv[c] = (v4u){0u, 0u, 0u, 0u}; } }
#pragma unroll
        for (int c = 0; c < 4; ++c) *(LAS v4u*)(Ks + key * 72 + half * 32 + 8 * c) = kk[c];
#pragma unroll
        for (int c = 0; c < 4; ++c)
#pragma unroll
            for (int e = 0; e < 8; ++e) { const unsigned w = vv[c][e >> 1]; VT[(half * 32 + 8 * c + e) * 264 + key] = (bf16)((e & 1) ? (w >> 16) : (w & 0xffffu)); }
    }
    __syncthreads();
    const int fr = lane & 15, fq = lane >> 4;
    const int i = 16 * wave + fr;
    const size_t rowq = (size_t)b * 2048 + (size_t)d * (128 * n + i) + r;
    const bf16* qsrc = PROJ + rowq * DIN + C_Q + g * 512 + h * 64 + 8 * fq;
    const bf16x8 Q0 = *(const bf16x8*)qsrc, Q1 = *(const bf16x8*)(qsrc + 32);
    const int start = wave & ~1; const int lo = (n == 0) ? 8 : start;
    f32x4 S[10]; float mx = -1e30f;
#pragma unroll
    for (int p = 0; p < 10; ++p) { const int tile = start + p;
        if (tile >= lo) {
            const LAS bf16* kp = Ks + (tile * 16 + fr) * 72 + 8 * fq;
            const bf16x8 K0 = *(const LAS bf16x8*)kp, K1 = *(const LAS bf16x8*)(kp + 32);
            f32x4 s = (f32x4){0.f, 0.f, 0.f, 0.f};
            s = __builtin_amdgcn_mfma_f32_16x16x32_bf16(K0, Q0, s, 0, 0, 0); s = __builtin_amdgcn_mfma_f32_16x16x32_bf16(K1, Q1, s, 0, 0, 0);
#pragma unroll
            for (int e = 0; e < 4; ++e) { const int j = tile * 16 + 4 * fq + e; const bool valid = (j >= i) && (j <= i + 128); s[e] = valid ? s[e] * 0.125f : -1e30f; mx = fmaxf(mx, s[e]); }
            S[p] = s;
        } else S[p] = (f32x4){-1e30f, -1e30f, -1e30f, -1e30f};
    }
    mx = fmaxf(mx, __shfl_xor(mx, 16)); mx = fmaxf(mx, __shfl_xor(mx, 32));
    float l = 0.f;
#pragma unroll
    for (int p = 0; p < 10; ++p)
#pragma unroll
        for (int e = 0; e < 4; ++e) { const float ex = __expf(S[p][e] - mx); S[p][e] = ex; l += ex; }
    l += __shfl_xor(l, 16); l += __shfl_xor(l, 32);
    f32x4 O[4];
#pragma unroll
    for (int dt = 0; dt < 4; ++dt) O[dt] = (f32x4){0.f, 0.f, 0.f, 0.f};
#pragma unroll
    for (int pp = 0; pp < 5; ++pp) {
        if (start + 2 * pp >= lo) {
            v4u pw; pw.x = pk2(S[2 * pp][0], S[2 * pp][1]); pw.y = pk2(S[2 * pp][2], S[2 * pp][3]); pw.z = pk2(S[2 * pp + 1][0], S[2 * pp + 1][1]); pw.w = pk2(S[2 * pp + 1][2], S[2 * pp + 1][3]);
            const bf16x8 Pf = __builtin_bit_cast(bf16x8, pw);
            const int ka = (start + 2 * pp) * 16 + 4 * fq;
#pragma unroll
            for (int dt = 0; dt < 4; ++dt) { const LAS bf16* vp = VT + (16 * dt + fr) * 264 + ka;
                const v2u va = *(const LAS v2u*)vp, vb = *(const LAS v2u*)(vp + 16);
                const bf16x8 Vf = __builtin_bit_cast(bf16x8, (v4u){va.x, va.y, vb.x, vb.y});
                O[dt] = __builtin_amdgcn_mfma_f32_16x16x32_bf16(Vf, Pf, O[dt], 0, 0, 0); }
        }
    }
    const float inv = 1.f / l;
    bf16* op = O3 + ((size_t)g * MT + rowq) * 512 + h * 64 + 4 * fq;
#pragma unroll
    for (int dt = 0; dt < 4; ++dt) { v2u w; w.x = pk2(O[dt][0] * inv, O[dt][1] * inv); w.y = pk2(O[dt][2] * inv, O[dt][3] * inv); *(v2u*)(op + 16 * dt) = w; }
    if (fq == 0) { float* mp = ML + (((size_t)g * MT + rowq) * 8 + h) * 2; *(f32x2*)mp = (f32x2){mx, l}; }
    __syncthreads();
}

__device__ __forceinline__ void gmlp_item(int idx, const bf16* PROJ, const float* VST, const float* Wsp, const float* bsp, const float* lng, const float* lnb, bf16* YA,
                                          LAS unsigned char* lds, int tid, int wave, int lane) {
    const int ci = idx >> 3, g = idx & 7; const int row0 = ci * 128;
    LAS bf16* VT = (LAS bf16*)lds;
    LAS bf16* WS = (LAS bf16*)(lds + 34816);
    LAS float* st = (LAS float*)(lds + 69632);
    if (tid < 128) { const float* p = VST + (size_t)(row0 + tid) * 32; float s = 0.f, q = 0.f;
#pragma unroll
        for (int k = 0; k < 8; ++k) { const f32x4 a = ((const f32x4*)p)[k]; s += a[0] + a[2]; q += a[1] + a[3]; }
        const float mu = s * (1.f / 1024.f); const float var = q * (1.f / 1024.f) - mu * mu; st[2 * tid] = mu; st[2 * tid + 1] = rsqrtf(var + EPS); }
    { const int t = tid >> 2, sp = tid & 3; const float* wp = Wsp + ((size_t)g * 128 + t) * 128 + sp * 32;
#pragma unroll
        for (int c = 0; c < 4; ++c) { const f32x4 a = ((const f32x4*)wp)[2 * c], b2 = ((const f32x4*)wp)[2 * c + 1]; const int s0 = sp * 32 + 8 * c;
            float v[8] = {a[0], a[1], a[2], a[3], b2[0], b2[1], b2[2], b2[3]};
#pragma unroll
            for (int e = 0; e < 8; ++e) v[e] = (s0 + e <= t) ? v[e] : 0.f;
            v4u w; w.x = pk2(v[0], v[1]); w.y = pk2(v[2], v[3]); w.z = pk2(v[4], v[5]); w.w = pk2(v[6], v[7]);
            *(LAS v4u*)(WS + t * 136 + s0) = w; } }
    __syncthreads();
    { const int s = tid >> 2, cp = tid & 3; const float mu = st[2 * s], rstd = st[2 * s + 1]; const bf16* vp = PROJ + (size_t)(row0 + s) * DIN + C_V + g * 128 + cp * 32;
#pragma unroll
        for (int c = 0; c < 4; ++c) { const v4u raw = *(const v4u*)(vp + 8 * c); const int ch = g * 128 + cp * 32 + 8 * c;
            const f32x4 g0 = *(const f32x4*)(lng + ch), g1 = *(const f32x4*)(lng + ch + 4), b0 = *(const f32x4*)(lnb + ch), b1 = *(const f32x4*)(lnb + ch + 4);
            float x[8] = {bflo(raw.x), bfhi(raw.x), bflo(raw.y), bfhi(raw.y), bflo(raw.z), bfhi(raw.z), bflo(raw.w), bfhi(raw.w)};
            const float gg[8] = {g0[0], g0[1], g0[2], g0[3], g1[0], g1[1], g1[2], g1[3]}; const float bb[8] = {b0[0], b0[1], b0[2], b0[3], b1[0], b1[1], b1[2], b1[3]};
#pragma unroll
            for (int e = 0; e < 8; ++e) VT[(cp * 32 + 8 * c + e) * 136 + s] = (bf16)f2bf((x[e] - mu) * rstd * gg[e] + bb[e]); } }
    __syncthreads();
    const int fr = lane & 15, fq = lane >> 4;
    const int t = 16 * wave + fr; const int nks = (wave >> 1) + 1;
    f32x4 acc[8];
#pragma unroll
    for (int ct = 0; ct < 8; ++ct) acc[ct] = (f32x4){0.f, 0.f, 0.f, 0.f};
#pragma unroll
    for (int ks = 0; ks < 4; ++ks) {
        if (ks < nks) { const bf16x8 Wf = *(const LAS bf16x8*)(WS + t * 136 + 32 * ks + 8 * fq);
#pragma unroll
            for (int ct = 0; ct < 8; ++ct) { const bf16x8 Vf = *(const LAS bf16x8*)(VT + (16 * ct + fr) * 136 + 32 * ks + 8 * fq);
                acc[ct] = __builtin_amdgcn_mfma_f32_16x16x32_bf16(Vf, Wf, acc[ct], 0, 0, 0); } }
    }
    const size_t row = (size_t)row0 + t; const float bs = bsp[g * 128 + t];
    const bf16* up = PROJ + row * DIN + g * 128 + 4 * fq;
    bf16* yp = YA + row * DM + g * 128 + 4 * fq;
#pragma unroll
    for (int ct = 0; ct < 8; ++ct) { const v2u uu = *(const v2u*)(up + C_U + 16 * ct), zz = *(const v2u*)(up + C_Z + 16 * ct);
        const float y0 = bflo(uu.x) * (acc[ct][0] + bs) * silu(bflo(zz.x)), y1 = bfhi(uu.x) * (acc[ct][1] + bs) * silu(bfhi(zz.x));
        const float y2 = bflo(uu.y) * (acc[ct][2] + bs) * silu(bflo(zz.y)), y3 = bfhi(uu.y) * (acc[ct][3] + bs) * silu(bfhi(zz.y));
        v2u w; w.x = pk2(y0, y1); w.y = pk2(y2, y3); *(v2u*)(yp + 16 * ct) = w; }
    __syncthreads();
}

__device__ __forceinline__ void gmlp_sample_item(int b, const bf16* PROJ, const float* VST, const float* Wsp, const float* bsp, const float* lng, const float* lnb, bf16* YA, float* out,
                                                 LAS unsigned char* lds, int tid, int wave, int lane) {
    const int r0 = MP + b * 8;
    LAS float* st = (LAS float*)lds;
    if (tid < 8) { const float* p = VST + (size_t)(r0 + tid) * 32; float s = 0.f, q = 0.f;
#pragma unroll
        for (int k = 0; k < 8; ++k) { const f32x4 a = ((const f32x4*)p)[k]; s += a[0] + a[2]; q += a[1] + a[3]; }
        const float mu = s * (1.f / 1024.f); const float var = q * (1.f / 1024.f) - mu * mu; st[2 * tid] = mu; st[2 * tid + 1] = rsqrtf(var + EPS); }
    __syncthreads();
    const int ch = 2 * tid, g = wave;
    const float lg0 = lng[ch], lg1 = lng[ch + 1], lb0 = lnb[ch], lb1 = lnb[ch + 1];
    float vn0[8], vn1[8];
#pragma unroll
    for (int s = 0; s < 8; ++s) { const unsigned raw = *(const unsigned*)(PROJ + (size_t)(r0 + s) * DIN + C_V + ch); const float mu = st[2 * s], rstd = st[2 * s + 1];
        vn0[s] = (bflo(raw) - mu) * rstd * lg0 + lb0; vn1[s] = (bfhi(raw) - mu) * rstd * lg1 + lb1;
        *(f32x2*)(out + O_VCH + (size_t)(b * 8 + s) * 1024 + ch) = (f32x2){vn0[s], vn1[s]}; }
#pragma unroll
    for (int t = 0; t < 8; ++t) { float z0 = bsp[g * 128 + t], z1 = z0;
#pragma unroll
        for (int s = 0; s < 8; ++s) if (s <= t) { const float w = Wsp[((size_t)g * 128 + t) * 128 + s]; z0 += w * vn0[s]; z1 += w * vn1[s]; }
        const unsigned uu = *(const unsigned*)(PROJ + (size_t)(r0 + t) * DIN + C_U + ch), zz = *(const unsigned*)(PROJ + (size_t)(r0 + t) * DIN + C_Z + ch);
        *(unsigned*)(YA + (size_t)(r0 + t) * DM + ch) = pk2(bflo(uu) * z0 * silu(bflo(zz)), bfhi(uu) * z1 * silu(bfhi(zz))); }
    __syncthreads();
}

__device__ __forceinline__ f32x4 sa_load(const bf16* PROJ, const float* cache, int b, int lw, int ix, int pcol, int ccol, bool maybe_new) {
    if (maybe_new && ix >= lw) { const v2u raw = *(const v2u*)(PROJ + (size_t)(MP + b * 8 + ix - lw) * DIN + pcol); return (f32x4){bflo(raw.x), bfhi(raw.x), bflo(raw.y), bfhi(raw.y)}; }
    const int ic = ix < lw ? ix : lw - 1;
    return *(const f32x4*)(cache + (size_t)ic * 1024 + ccol);
}
__device__ __forceinline__ void attn_sample_item(int idx, const bf16* PROJ, const float* c128, const float* c512, const float* c2048, bf16* O3, float* ML, int wave, int lane) {
    const int b = idx / 24; const int rem = idx - b * 24; const int g = rem >> 3, t = rem & 7; const int h = wave;
    const int lw = g == 0 ? 128 : (g == 1 ? 512 : 2048), d = g == 0 ? 1 : (g == 1 ? 4 : 16);
    const float* cache = (g == 0 ? c128 : (g == 1 ? c512 : c2048)) + (size_t)b * lw * 1024;
    const size_t rq = (size_t)MP + b * 8 + t;
    const int ks = lane >> 4, dq = lane & 15;
    const int hc = g * 512 + h * 64 + 4 * dq;
    const v2u qraw = *(const v2u*)(PROJ + rq * DIN + C_Q + hc);
    const float q0 = bflo(qraw.x) * 0.125f, q1 = bfhi(qraw.x) * 0.125f, q2 = bflo(qraw.y) * 0.125f, q3 = bfhi(qraw.y) * 0.125f;
    float s[33]; float mx = -1e30f;
#pragma unroll
    for (int it = 0; it < 33; ++it) {
        int j = 4 * it + ks; const bool ok = (it < 32) || (ks == 0); if (!ok) j = 128;
        const int ix = lw + t - d * j;
        const f32x4 kk = sa_load(PROJ, cache, b, lw, ix, C_K + hc, h * 64 + 4 * dq, it < 2);
        float a = (kk[0] * q0 + kk[1] * q1) + (kk[2] * q2 + kk[3] * q3);
        a += __shfl_xor(a, 1); a += __shfl_xor(a, 2); a += __shfl_xor(a, 4); a += __shfl_xor(a, 8);
        s[it] = ok ? a : -1e30f; mx = fmaxf(mx, s[it]);
    }
    mx = fmaxf(mx, __shfl_xor(mx, 16)); mx = fmaxf(mx, __shfl_xor(mx, 32));
    float l = 0.f;
#pragma unroll
    for (int it = 0; it < 33; ++it) { s[it] = __expf(s[it] - mx); l += s[it]; }
    l += __shfl_xor(l, 16); l += __shfl_xor(l, 32);
    f32x4 o = (f32x4){0.f, 0.f, 0.f, 0.f};
#pragma unroll
    for (int it = 0; it < 33; ++it) {
        int j = 4 * it + ks; if (!((it < 32) || (ks == 0))) j = 128;
        const int ix = lw + t - d * j;
        const f32x4 vv = sa_load(PROJ, cache, b, lw, ix, C_VV + hc, 512 + h * 64 + 4 * dq, it < 2);
        o += vv * s[it];
    }
#pragma unroll
    for (int e = 0; e < 4; ++e) { o[e] += __shfl_xor(o[e], 16); o[e] += __shfl_xor(o[e], 32); }
    const float inv = 1.f / l;
    if (ks == 0) { v2u w; w.x = pk2(o[0] * inv, o[1] * inv); w.y = pk2(o[2] * inv, o[3] * inv); *(v2u*)(O3 + ((size_t)g * MT + rq) * 512 + h * 64 + 4 * dq) = w; }
    if (lane == 0) { float* mp = ML + (((size_t)g * MT + rq) * 8 + h) * 2; mp[0] = mx; mp[1] = l; }
}

struct Args { const float* in[19]; float* out; unsigned char* ws; };
__global__ void __launch_bounds__(NTHR, 2) fwd_kernel(Args args) {
    extern __shared__ __attribute__((aligned(16))) unsigned char lds_raw[];
    cg::grid_group grid = cg::this_grid();
    LAS unsigned char* lds = (LAS unsigned char*)lds_raw;
    const int tid = threadIdx.x, lane = tid & 63, wave = __builtin_amdgcn_readfirstlane(tid >> 6);
    const int G = gridDim.x, bx = blockIdx.x;
    const int gw = bx * NWAVES + wave, NGW = G * NWAVES;
    const float* xp = args.in[0]; const float* xs = args.in[1];
    const float* c128 = args.in[2]; const float* c512 = args.in[3]; const float* c2048 = args.in[4];
    const float* cpr = args.in[5]; const float* csm = args.in[6]; const float* wcond = args.in[7]; const float* bcond = args.in[8]; const float* gpre = args.in[9];
    const float* win = args.in[10]; const float* lng = args.in[11]; const float* lnb = args.in[12]; const float* wsp = args.in[13]; const float* bsp = args.in[14];
    const float* wpa = args.in[15]; const float* wpb = args.in[16]; const float* wout = args.in[17]; const float* gpost = args.in[18];
    float* out = args.out; unsigned char* ws = args.ws;
    bf16* WIN_T = (bf16*)(ws + WS_WIN); bf16* WPA_T = (bf16*)(ws + WS_WPA); bf16* WPB_T = (bf16*)(ws + WS_WPB); bf16* WOUT_T = (bf16*)(ws + WS_WOUT);
    float* MOD = (float*)(ws + WS_MOD); float* VST = (float*)(ws + WS_VST); float* ML = (float*)(ws + WS_ML);
    bf16* H = (bf16*)(ws + WS_H); bf16* YA = (bf16*)(ws + WS_YA); bf16* YB = (bf16*)(ws + WS_YB); bf16* MRG = (bf16*)(ws + WS_MRG); bf16* O3 = (bf16*)(ws + WS_O3);
    float* PART = (float*)(ws + WS_PART); float* OUTB = (float*)(ws + WS_OUT); bf16* PROJ = (bf16*)(ws + WS_PROJ);

    unsigned* barw = (unsigned*)(ws + 16384);
    volatile LAS unsigned* bst = (volatile LAS unsigned*)(lds + 139264);
    if (tid < 2) bst[tid] = 0u;
    if (bx == 0) for (int u = tid; u < XCD_BAR_WORDS; u += NTHR) barw[u] = 0u;
    if (bx < 192) mod_task(bx, cpr, csm, wcond, bcond, MOD, lds, tid, wave, lane);
    {
        LAS float* scr = (LAS float*)(lds + wave * 16384);
        constexpr int I_IN = (1024 / 64) * (DIN / 32), I_PA = (1024 / 64) * (1024 / 32), I_PB = (512 / 64) * (1024 / 32), I_OUT = I_PA;
        constexpr int NITEMS = I_IN + I_PA + I_PB + I_OUT;
        for (int it = gw; it < NITEMS; it += NGW) {
            int r = it;
            if (r < I_IN) { p0_transpose_item(win, 1024, DIN, WIN_T, 0, scr, r, lane); continue; } r -= I_IN;
            if (r < I_PA) { p0_transpose_item(wpa, 1024, 1024, WPA_T, 0, scr, r, lane); continue; } r -= I_PA;
            if (r < I_PB) { p0_transpose_item(wpb, 512, 1024, WPB_T, 0, scr, r, lane); continue; } r -= I_PB;
            p0_transpose_item(wout, 1024, 1024, WOUT_T, 0, scr, r, lane);
        }
    }
    grid.sync();
    const XcdBarrier xbar = xcd_barrier_post(barw, bst);
    for (int rb = gw; rb < MT / 8; rb += NGW) {
        const int rowb = rb * 8;
        const float* mod = MOD + (rowb < MP ? (rowb >> 11) : 8 + ((rowb - MP) >> 3)) * 3072;
        f32x4 gs[4], sh[4];
#pragma unroll
        for (int j = 0; j < 4; ++j) { const int c = 4 * lane + 256 * j; f32x4 a = (f32x4){0.f, 0.f, 0.f, 0.f}, s2 = (f32x4){1.f, 1.f, 1.f, 1.f};
#pragma unroll
            for (int q = 0; q < 4; ++q) { a += *(const f32x4*)(mod + (size_t)q * 40 * 3072 + c); s2 += *(const f32x4*)(mod + (size_t)q * 40 * 3072 + 1024 + c); }
            sh[j] = a; gs[j] = s2 * *(const f32x4*)(gpre + c); }
#pragma unroll 2
        for (int i = 0; i < 8; ++i) { const int row = rowb + i;
            const float* xr = row < MP ? xp + (size_t)row * DM : xs + (size_t)(row - MP) * DM;
            f32x4 v[4]; float ss = 0.f;
#pragma unroll
            for (int j = 0; j < 4; ++j) { v[j] = ((const f32x4*)xr)[lane + 64 * j]; ss += (v[j][0] * v[j][0] + v[j][1] * v[j][1]) + (v[j][2] * v[j][2] + v[j][3] * v[j][3]); }
            const float rstd = rsqrtf(wave_sum(ss) * (1.f / DM) + EPS);
#pragma unroll
            for (int j = 0; j < 4; ++j) { const int c = 4 * lane + 256 * j; const f32x4 hh = v[j] * rstd * gs[j] + sh[j];
                v2u w; w.x = pk2(hh[0], hh[1]); w.y = pk2(hh[2], hh[3]); *(v2u*)(H + (size_t)row * DM + c) = w; } }
    }
    xcd_barrier(xbar);
    {
        pg8::Gemm gm{H, WIN_T, MT, DIN, DM}; pg8::StaticOrder S; S.init(MT, DIN, G, bx);
        pg8::EpiProj E{PROJ, out, VST};
        pg8::gemm_phase<pg8::EpiProj, pg8::StaticOrder, true, true>(lds, gm, S, E);
    }
    xcd_barrier(xbar);
    {
        constexpr int N_ATT = 3072, N_GM = 1024, N_SA = 768, N_SG = 32, N_ALL = N_ATT + N_GM + N_SA + N_SG;
        for (int it = bx; it < N_ALL; it += G) {
            int r = it;
            if (r < N_ATT) { attn_item(r, PROJ, O3, ML, lds, tid, wave, lane); continue; } r -= N_ATT;
            if (r < N_GM) { gmlp_item(r, PROJ, VST, wsp, bsp, lng, lnb, YA, lds, tid, wave, lane); continue; } r -= N_GM;
            if (r < N_SA) { attn_sample_item(r, PROJ, c128, c512, c2048, O3, ML, wave, lane); continue; } r -= N_SA;
            gmlp_sample_item(r, PROJ, VST, wsp, bsp, lng, lnb, YA, out, lds, tid, wave, lane);
        }
    }
    xcd_barrier(xbar);
    for (int row = gw; row < MT; row += NGW) {
        const int head = lane >> 3;
        float mg[3], lg[3];
#pragma unroll
        for (int g = 0; g < 3; ++g) { const f32x2 a = *(const f32x2*)(ML + (((size_t)g * MT + row) * 8 + head) * 2); mg[g] = a[0]; lg[g] = a[1]; }
        const float mm = fmaxf(fmaxf(mg[0], mg[1]), mg[2]);
        float wg[3]; float den = 0.f;
#pragma unroll
        for (int g = 0; g < 3; ++g) { wg[g] = __expf(mg[g] - mm) * lg[g]; den += wg[g]; }
        const float rden = 1.f / den;
        float o[8] = {0.f, 0.f, 0.f, 0.f, 0.f, 0.f, 0.f, 0.f};
#pragma unroll
        for (int g = 0; g < 3; ++g) { const v4u raw = *(const v4u*)(O3 + ((size_t)g * MT + row) * 512 + lane * 8); const float w = wg[g] * rden;
            o[0] += w * bflo(raw.x); o[1] += w * bfhi(raw.x); o[2] += w * bflo(raw.y); o[3] += w * bfhi(raw.y); o[4] += w * bflo(raw.z); o[5] += w * bfhi(raw.z); o[6] += w * bflo(raw.w); o[7] += w * bfhi(raw.w); }
        const v4u zr = *(const v4u*)(PROJ + (size_t)row * DIN + C_ZB + lane * 8);
        v4u w; w.x = pk2(o[0] * silu(bflo(zr.x)), o[1] * silu(bfhi(zr.x))); w.y = pk2(o[2] * silu(bflo(zr.y)), o[3] * silu(bfhi(zr.y)));
        w.z = pk2(o[4] * silu(bflo(zr.z)), o[5] * silu(bfhi(zr.z))); w.w = pk2(o[6] * silu(bflo(zr.w)), o[7] * silu(bfhi(zr.w)));
        *(v4u*)(YB + (size_t)row * 512 + lane * 8) = w;
    }
    xcd_barrier(xbar);
    {
        pg8::Gemm gm{YA, WPA_T, MT, DM, DM}; pg8::StaticOrder S; S.init(MT, DM, G, bx);
        pg8::EpiGateA E{PROJ, PART};
        pg8::gemm_phase<pg8::EpiGateA, pg8::StaticOrder, true, true>(lds, gm, S, E);
    }
    {
        pg8::Gemm gm{YB, WPB_T, MT, DM, 512}; pg8::StaticOrder S; S.init(MT, DM, G, bx);
        pg8::EpiGateB E{PROJ, PART, MRG};
        pg8::gemm_phase<pg8::EpiGateB, pg8::StaticOrder, true, true>(lds, gm, S, E);
    }
    xcd_barrier(xbar);
    {
        pg8::Gemm gm{MRG, WOUT_T, MT, DM, DM}; pg8::StaticOrder S; S.init(MT, DM, G, bx);
        pg8::EpiF32 E{OUTB};
        pg8::gemm_phase<pg8::EpiF32, pg8::StaticOrder, true, true>(lds, gm, S, E);
    }
    xcd_barrier(xbar);
    for (int rb = gw; rb < MT / 8; rb += NGW) {
        const int rowb = rb * 8;
        const float* gate = MOD + (rowb < MP ? (rowb >> 11) : 8 + ((rowb - MP) >> 3)) * 3072 + 2048;
        f32x4 gt[4];
#pragma unroll
        for (int j = 0; j < 4; ++j) { const int c = 4 * lane + 256 * j; f32x4 a = (f32x4){0.f, 0.f, 0.f, 0.f};
#pragma unroll
            for (int q = 0; q < 4; ++q) a += *(const f32x4*)(gate + (size_t)q * 40 * 3072 + c);
            gt[j] = a * *(const f32x4*)(gpost + c); }
#pragma unroll 2
        for (int i = 0; i < 8; ++i) { const int row = rowb + i;
            const float* xr = row < MP ? xp + (size_t)row * DM : xs + (size_t)(row - MP) * DM;
            const float* orow = OUTB + (size_t)row * DM;
            f32x4 v[4]; float ss = 0.f;
#pragma unroll
            for (int j = 0; j < 4; ++j) { v[j] = ((const f32x4*)orow)[lane + 64 * j]; ss += (v[j][0] * v[j][0] + v[j][1] * v[j][1]) + (v[j][2] * v[j][2] + v[j][3] * v[j][3]); }
            const float rstd = rsqrtf(wave_sum(ss) * (1.f / DM) + EPS);
#pragma unroll
            for (int j = 0; j < 4; ++j) { const int c = 4 * lane + 256 * j; const f32x4 xx = ((const f32x4*)xr)[lane + 64 * j];
                *(f32x4*)(out + (size_t)row * DM + c) = xx + gt[j] * (v[j] * rstd); } }
    }
}

extern "C" void kernel_launch(void* const* d_in, const int* in_sizes, int n_in, void* d_out, int out_size, void* d_ws, size_t ws_size, hipStream_t stream) {
    static int grid = 0;
    if (grid == 0) {
        if (n_in != 19 || (size_t)out_size != O_END || ws_size < WS_END) { fprintf(stderr, "kernel_launch: unexpected shapes: n_in %d out %d ws %zu\n", n_in, out_size, ws_size); grid = -1; return; }
        int dev = 0, cus = 0, per_cu = 0;
        if (hipGetDevice(&dev) != hipSuccess || hipDeviceGetAttribute(&cus, hipDeviceAttributeMultiprocessorCount, dev) != hipSuccess) { fprintf(stderr, "kernel_launch: device query failed\n"); grid = -1; return; }
        if (hipFuncSetAttribute((const void*)fwd_kernel, hipFuncAttributeMaxDynamicSharedMemorySize, LDS_BYTES) != hipSuccess) { fprintf(stderr, "kernel_launch: hipFuncSetAttribute failed\n"); grid = -1; return; }
        if (hipOccupancyMaxActiveBlocksPerMultiprocessor(&per_cu, (const void*)fwd_kernel, NTHR, LDS_BYTES) != hipSuccess || per_cu < 1) { fprintf(stderr, "kernel_launch: occupancy query says %d blocks per CU\n", per_cu); }
        (void)hipGetLastError();
        grid = cus;
    }
    if (grid < 0) return;
    Args a{};
    for (int i = 0; i < 19; ++i) a.in[i] = (const float*)d_in[i];
    a.out = (float*)d_out; a.ws = (unsigned char*)d_ws;
    void* kargs[] = {&a};
    hipError_t e = hipLaunchCooperativeKernel((const void*)fwd_kernel, dim3(grid), dim3(NTHR), kargs, LDS_BYTES, stream);
    if (e != hipSuccess) fprintf(stderr, "kernel_launch: cooperative launch failed: %s (grid %d)\n", hipGetErrorString(e), grid);
}
```

```cpp
#include <hip/hip_runtime.h>
#include <hip/hip_cooperative_groups.h>
#include <cstdio>
#include <cstdint>
namespace cg = cooperative_groups;
namespace pg8 {
#define PG8_LAS __attribute__((address_space(3)))
typedef unsigned short bf16_t;
typedef short bf16x8 __attribute__((ext_vector_type(8)));
typedef float f32x4 __attribute__((ext_vector_type(4)));
typedef unsigned u32x4 __attribute__((ext_vector_type(4)));
constexpr int BM = 256, BK = 64, HALF = 128, HTB = HALF * BK * 2  , STAGE_BYTES = 8 * HTB, NXCD = 8, WGM = 8;

__host__ __device__ __forceinline__ int lds_byte(int r, int c) { const int st = (r >> 4) * 2 + (c >> 5), rr = r & 15, cc = c & 31, ob = rr * 64 + cc * 2; return st * 1024 + (ob ^ (((ob >> 9) & 1) << 5)); }
__host__ __device__ __forceinline__ void stage_rc(int b, int& R, int& C) { const int st = b / 1024, sb = b % 1024, swz = sb ^ (((sb >> 9) & 1) << 5); R = (st >> 1) * 16 + swz / 64; C = (st & 1) * 32 + (swz % 64) / 2; }
__host__ __device__ __forceinline__ int perm32(int rho) { const int n = rho >> 4, i = rho & 15; return 8 * (i >> 2) + 4 * n + (i & 3); }

struct Unit { int pm, pn; };
struct Gemm { const bf16_t* A; const bf16_t* Bt; int M, N, K; };

struct StaticOrder {
    int nM, nN, nwg, G, c;
    __host__ __device__ void init(int M, int N, int G_, int c_) { nM = M / BM; nN = N / BM; nwg = nM * nN; G = G_; c = c_; }
    __host__ __device__ bool next(int i, Unit& u) const {
        const long L = (long)i * G + c; if (L >= nwg) return false;
        int wgid = (int)L; { const int q = nwg / NXCD, r = nwg % NXCD, xcd = wgid % NXCD, off = wgid / NXCD; wgid = (xcd < r ? xcd * (q + 1) : r * (q + 1) + (xcd - r) * q) + off; }
        const int nig = WGM * nN, gid = wgid / nig, fm = gid * WGM, gsz = (nM - fm) < WGM ? (nM - fm) : WGM;
        u.pm = fm + ((wgid % nig) % gsz); u.pn = (wgid % nig) / gsz; return true;
    }
    __device__ __forceinline__ void a_ready(const Unit&) const {}
    __device__ __forceinline__ void done(const Unit&) const {}
};
__device__ __forceinline__ unsigned cvt_pk_bf16(float lo, float hi) { unsigned r; asm volatile("v_cvt_pk_bf16_f32 %0, %1, %2" : "=v"(r) : "v"(lo), "v"(hi)); return r; }
typedef float f32x2 __attribute__((ext_vector_type(2)));
template <class Epi, class Sched, bool ALIGN_EPI = false, bool SP2 = false>
__device__ __forceinline__ void gemm_phase(PG8_LAS unsigned char* lds, const Gemm g, const Sched& S, const Epi& E) {
    const int tid = threadIdx.x, wid = __builtin_amdgcn_readfirstlane(tid >> 6), lane = tid & 63, wr = wid >> 2, wc = wid & 3, fr = lane & 15, fq = lane >> 4;
    const int K = g.K, nt = K / BK;
    unsigned voffA[2], voffB[2];
#pragma unroll
    for (int i = 0; i < 2; ++i) { int R, C; stage_rc(tid * 16 + i * 8192, R, C); const int Rb = Epi::PERM ? ((R & ~31) + perm32(R & 31)) : R;
        voffA[i] = (unsigned)(R * K + C) * 2u; voffB[i] = (unsigned)(Rb * K + C) * 2u; }
    const size_t kstep = (size_t)(BK * 2);
    const size_t hstep = (size_t)HALF * K * 2;
    const size_t tstep = 2 * hstep;
    const unsigned ldsw = (unsigned)wid * 1024u;
    const int aoff = lds_byte(wr * 64 + fr, fq * 8), boff = lds_byte(wc * 32 + fr, fq * 8);
#define PG8_SA(b, h) (((b) * 2 + (h)) * HTB)
#define PG8_SB(b, h) ((4 + (b) * 2 + (h)) * HTB)
#define PG8_STAGE(bufoff, gbase, voff) do { _Pragma("unroll") for (int _i = 0; _i < 2; ++_i) \
        __builtin_amdgcn_global_load_lds((const unsigned*)((const char*)(gbase) + (voff)[_i]), (PG8_LAS unsigned*)(lds + (bufoff) + ldsw + _i * 8192), 16, 0, 0); } while (0)
#define PG8_LDA(dst, b, h) do { _Pragma("unroll") for (int m = 0; m < 4; ++m) _Pragma("unroll") for (int k = 0; k < 2; ++k) dst[m][k] = *(const PG8_LAS bf16x8*)(lds + PG8_SA(b, h) + aoff + m * 2048 + k * 1024); } while (0)
#define PG8_LDB(dst, b, h) do { _Pragma("unroll") for (int n = 0; n < 2; ++n) _Pragma("unroll") for (int k = 0; k < 2; ++k) dst[n][k] = *(const PG8_LAS bf16x8*)(lds + PG8_SB(b, h) + boff + n * 2048 + k * 1024); } while (0)
#define PG8_MMA(ai, bj, At, Bt) do { __builtin_amdgcn_s_setprio(1); _Pragma("unroll") for (int m = 0; m < 4; ++m) _Pragma("unroll") for (int n = 0; n < 2; ++n) _Pragma("unroll") for (int k = 0; k < 2; ++k) \
        acc[ai][bj][m][n] = __builtin_amdgcn_mfma_f32_16x16x32_bf16(Bt[n][k], At[m][k], acc[ai][bj][m][n], 0, 0, 0); __builtin_amdgcn_s_setprio(0); } while (0)
#define PG8_WAIT_V(n) asm volatile("s_waitcnt vmcnt(" #n ")" ::: "memory")
#define PG8_WAIT_L(n) asm volatile("s_waitcnt lgkmcnt(" #n ")" ::: "memory")
#define PG8_BAR __builtin_amdgcn_s_barrier()
#define PG8_SCHED __builtin_amdgcn_sched_barrier(0)
    Unit cur, nxt; int ui = 0;
    if (!S.next(0, cur)) return;
    f32x4 acc[2][2][4][2];
#pragma unroll
    for (int a = 0; a < 2; ++a)
#pragma unroll
        for (int b = 0; b < 2; ++b)
#pragma unroll
            for (int m = 0; m < 4; ++m)
#pragma unroll
                for (int n = 0; n < 2; ++n) acc[a][b][m][n] = (f32x4){0.f, 0.f, 0.f, 0.f};
    bf16x8 At[4][2], B0[2][2], B1[2][2];
    const char* cA = (const char*)g.A + (size_t)cur.pm * tstep; const char* cB = (const char*)g.Bt + (size_t)cur.pn * tstep;
    S.a_ready(cur);
    if constexpr (SP2) {
        PG8_STAGE(PG8_SB(0, 0), cB, voffB); PG8_STAGE(PG8_SB(0, 1), cB + hstep, voffB); PG8_STAGE(PG8_SA(0, 0), cA, voffA); PG8_STAGE(PG8_SA(0, 1), cA + hstep, voffA);
        if (wr == 1) PG8_BAR;
        PG8_WAIT_V(2); PG8_BAR;
        PG8_STAGE(PG8_SB(1, 0), cB + kstep, voffB); PG8_STAGE(PG8_SA(1, 0), cA + kstep, voffA); PG8_STAGE(PG8_SB(1, 1), cB + hstep + kstep, voffB);
        PG8_WAIT_V(6); PG8_BAR;
    } else {
        PG8_STAGE(PG8_SB(0, 0), cB, voffB); PG8_STAGE(PG8_SA(0, 0), cA, voffA); PG8_STAGE(PG8_SB(0, 1), cB + hstep, voffB); PG8_STAGE(PG8_SA(0, 1), cA + hstep, voffA);
        if (wr == 1) PG8_BAR;
        PG8_WAIT_V(4); PG8_BAR;
        PG8_STAGE(PG8_SB(1, 0), cB + kstep, voffB); PG8_STAGE(PG8_SA(1, 0), cA + kstep, voffA); PG8_STAGE(PG8_SB(1, 1), cB + hstep + kstep, voffB);
        PG8_WAIT_V(6); PG8_BAR;
    }
    for (;;) {
        const bool has_next = S.next(ui + 1, nxt);
        const char* nA = has_next ? (const char*)g.A + (size_t)nxt.pm * tstep : cA; const char* nB = has_next ? (const char*)g.Bt + (size_t)nxt.pn * tstep : cB;
        for (int t = 0; t < nt; t += 2) {
            const bool last = (t == nt - 2);
            const char* a1 = cA + (size_t)(t + 1) * kstep;
            const char* a2 = last ? nA : cA + (size_t)(t + 2) * kstep; const char* b2 = last ? nB : cB + (size_t)(t + 2) * kstep;
            const char* a3 = a2 + kstep; const char* b3 = b2 + kstep;
            if (last && has_next) S.a_ready(nxt);
            if constexpr (SP2) {
            PG8_LDB(B0, 0, 0); PG8_LDB(B1, 0, 1); PG8_SCHED; PG8_LDA(At, 0, 0); PG8_STAGE(PG8_SA(1, 1), a1 + hstep, voffA);
            PG8_WAIT_V(8); PG8_WAIT_L(0); PG8_BAR; PG8_MMA(0, 0, At, B0); PG8_MMA(0, 1, At, B1); PG8_BAR; PG8_SCHED;
            PG8_LDA(At, 0, 1); PG8_STAGE(PG8_SB(0, 0), b2, voffB); PG8_STAGE(PG8_SB(0, 1), b2 + hstep, voffB); PG8_STAGE(PG8_SA(0, 0), a2, voffA);
            PG8_WAIT_V(8); PG8_WAIT_L(0); PG8_BAR; PG8_MMA(1, 0, At, B0); PG8_MMA(1, 1, At, B1); PG8_BAR; PG8_SCHED;
            PG8_LDB(B0, 1, 0); PG8_LDB(B1, 1, 1); PG8_SCHED; PG8_LDA(At, 1, 0); PG8_STAGE(PG8_SA(0, 1), a2 + hstep, voffA);
            PG8_WAIT_V(8); PG8_WAIT_L(0); PG8_BAR; PG8_MMA(0, 0, At, B0); PG8_MMA(0, 1, At, B1); PG8_BAR; PG8_SCHED;
            PG8_LDA(At, 1, 1); PG8_STAGE(PG8_SB(1, 0), b3, voffB); PG8_STAGE(PG8_SB(1, 1), b3 + hstep, voffB); PG8_STAGE(PG8_SA(1, 0), a3, voffA);
            PG8_WAIT_V(8); PG8_WAIT_L(0); PG8_BAR; PG8_MMA(1, 0, At, B0); PG8_MMA(1, 1, At, B1); PG8_BAR; PG8_SCHED;
            } else {
            PG8_LDB(B0, 0, 0); PG8_SCHED; PG8_LDA(At, 0, 0); PG8_STAGE(PG8_SA(1, 1), a1 + hstep, voffA);
            PG8_WAIT_L(8); PG8_BAR; PG8_WAIT_L(0); PG8_MMA(0, 0, At, B0); PG8_BAR; PG8_SCHED;
            PG8_LDB(B1, 0, 1); PG8_STAGE(PG8_SB(0, 0), b2, voffB);
            PG8_BAR; PG8_WAIT_L(0); PG8_MMA(0, 1, At, B1); PG8_BAR;
            PG8_LDA(At, 0, 1); PG8_STAGE(PG8_SA(0, 0), a2, voffA);
            PG8_BAR; PG8_WAIT_L(0); PG8_MMA(1, 0, At, B0); PG8_BAR; PG8_SCHED;
            PG8_STAGE(PG8_SB(0, 1), b2 + hstep, voffB);
            PG8_WAIT_V(6); PG8_BAR; PG8_MMA(1, 1, At, B1); PG8_BAR;
            PG8_LDB(B0, 1, 0); PG8_SCHED; PG8_LDA(At, 1, 0); PG8_STAGE(PG8_SA(0, 1), a2 + hstep, voffA);
            PG8_WAIT_L(8); PG8_BAR; PG8_WAIT_L(0); PG8_MMA(0, 0, At, B0); PG8_BAR; PG8_SCHED;
            PG8_LDB(B1, 1, 1); PG8_STAGE(PG8_SB(1, 0), b3, voffB);
            PG8_BAR; PG8_WAIT_L(0); PG8_MMA(0, 1, At, B1); PG8_BAR;
            PG8_LDA(At, 1, 1); PG8_STAGE(PG8_SA(1, 0), a3, voffA);
            PG8_BAR; PG8_WAIT_L(0); PG8_MMA(1, 0, At, B0); PG8_BAR; PG8_SCHED;
            PG8_STAGE(PG8_SB(1, 1), b3 + hstep, voffB);
            PG8_WAIT_V(6); PG8_BAR; PG8_MMA(1, 1, At, B1); PG8_BAR;
            }
        }
        if constexpr (ALIGN_EPI) { if (wr == 0) PG8_BAR; }
        if constexpr (!Epi::AFTER_DRAIN) { E(acc, cur, wr, wc, fr, fq); S.done(cur); }
        if (!has_next) break;
#pragma unroll
        for (int a = 0; a < 2; ++a)
#pragma unroll
            for (int b = 0; b < 2; ++b)
#pragma unroll
                for (int m = 0; m < 4; ++m)
#pragma unroll
                    for (int n = 0; n < 2; ++n) acc[a][b][m][n] = (f32x4){0.f, 0.f, 0.f, 0.f};
        cur = nxt; cA = nA; cB = nB; ++ui;
        if constexpr (ALIGN_EPI) { if (wr == 1) PG8_BAR; }
    }
    PG8_WAIT_V(0);
    if constexpr (!ALIGN_EPI) { if (wr == 0) PG8_BAR; }
    PG8_BAR;
    if constexpr (Epi::AFTER_DRAIN) { E.fused(acc, cur, wr, wc, fr, fq, lds, wid, lane); S.done(cur); }
#undef PG8_SA
#undef PG8_SB
#undef PG8_STAGE
#undef PG8_LDA
#undef PG8_LDB
#undef PG8_MMA
#undef PG8_WAIT_V
#undef PG8_WAIT_L
#undef PG8_BAR
#undef PG8_SCHED
}
}

#define GAS __attribute__((address_space(1)))
#define LAS __attribute__((address_space(3)))
typedef unsigned short bf16;
typedef unsigned v4u __attribute__((ext_vector_type(4)));
typedef unsigned v2u __attribute__((ext_vector_type(2)));
typedef float f32x4 __attribute__((ext_vector_type(4)));
typedef float f32x2 __attribute__((ext_vector_type(2)));
typedef short bf16x8 __attribute__((ext_vector_type(8)));

constexpr int NWAVES = 8, NTHR = 512;
constexpr int DM = 1024, NBP = 8, SEQ = 2048, NBS = 32, TS = 8;
constexpr int MP = NBP * SEQ, MS = NBS * TS, MT = MP + MS;
constexpr int DIN = 10240;
constexpr int C_U = 0, C_V = 1024, C_Z = 2048, C_Q = 3072, C_K = 4608, C_VV = 6144, C_ZB = 7680, C_GA = 8192, C_GB = 9216;
constexpr float EPS = 1e-6f;
constexpr size_t O_Y = 0, O_KVP0 = (size_t)MT * DM, O_KVP1 = O_KVP0 + (size_t)8 * 128 * 1024, O_KVP2 = O_KVP1 + (size_t)8 * 512 * 1024,
                 O_KVS0 = O_KVP2 + (size_t)8 * 2048 * 1024, O_KVS1 = O_KVS0 + 262144, O_KVS2 = O_KVS1 + 262144, O_VCH = O_KVS2 + 262144, O_END = O_VCH + 262144;
constexpr size_t MiB = 1u << 20;
constexpr size_t WS_WIN = 2 * MiB, WS_WPA = 22 * MiB, WS_WPB = 24 * MiB, WS_WOUT = 25 * MiB, WS_MOD = 27 * MiB, WS_VST = 29 * MiB, WS_ML = 32 * MiB,
                 WS_H = 36 * MiB, WS_YA = 70 * MiB, WS_YB = 104 * MiB, WS_MRG = 122 * MiB, WS_O3 = 156 * MiB, WS_PART = 206 * MiB, WS_OUT = 272 * MiB,
                 WS_PROJ = 340 * MiB, WS_END = 672 * MiB;
static_assert(WS_PROJ + (size_t)MT * DIN * 2 <= WS_END, "ws map");
constexpr int LDS_BYTES = 147456;

#define LDS_WAIT() asm volatile("s_waitcnt lgkmcnt(0)" ::: "memory")
__device__ __forceinline__ unsigned f2bf(float f) { unsigned u = __builtin_bit_cast(unsigned, f); return (u + 0x7fffu + ((u >> 16) & 1u)) >> 16; }
__device__ __forceinline__ unsigned pk2(float lo, float hi) { return f2bf(lo) | (f2bf(hi) << 16); }
__device__ __forceinline__ float bflo(unsigned w) { return __builtin_bit_cast(float, w << 16); }
__device__ __forceinline__ float bfhi(unsigned w) { return __builtin_bit_cast(float, w & 0xffff0000u); }
__device__ __forceinline__ float bf2f(bf16 h) { return __builtin_bit_cast(float, (unsigned)h << 16); }
__device__ __forceinline__ float sigm(float x) { return 1.f / (1.f + __expf(-x)); }
__device__ __forceinline__ float silu(float x) { return x / (1.f + __expf(-x)); }
__device__ __forceinline__ float wave_sum(float v) {
#pragma unroll
    for (int o = 1; o < 64; o <<= 1) v += __shfl_xor(v, o);
    return v;
}
__device__ __forceinline__ float wave_max(float v) {
#pragma unroll
    for (int o = 1; o < 64; o <<= 1) v = fmaxf(v, __shfl_xor(v, o));
    return v;
}
__device__ __forceinline__ float rdlane(float v, int l) { return __builtin_bit_cast(float, __builtin_amdgcn_readlane(__builtin_bit_cast(int, v), l)); }

#define XB_TMO      128
#define XB_XCNT(j)  (256  + 64 * (j))
#define XB_XSUB(j)  (1280 + 64 * (j))
#define XB_XGEN(j)  (2304 + 64 * (j))
#define XB_TOP      3328
#define XB_TOPGEN   3392
#define XCD_BAR_WORDS 3456
#define XB_SPIN_CAP (1u << 18)

__device__ __forceinline__ unsigned xb_ld(unsigned* p)              { return __hip_atomic_load(p, __ATOMIC_RELAXED, __HIP_MEMORY_SCOPE_AGENT); }
__device__ __forceinline__ unsigned xb_add(unsigned* p, unsigned v) { return __hip_atomic_fetch_add(p, v, __ATOMIC_RELAXED, __HIP_MEMORY_SCOPE_AGENT); }
__device__ __forceinline__ unsigned xb_xcc_id() { return (unsigned)__builtin_amdgcn_s_getreg((3 << 11) | 20) & 0xFu; }
#define XB_SPIN(cond, bar) do { unsigned _sp = 0; while (cond) { __builtin_amdgcn_s_sleep(1); \
    if ((++_sp & 255u) == 0u) { if (xb_ld(&(bar)[XB_TMO])) break; if (_sp > XB_SPIN_CAP) { atomicAdd(&(bar)[XB_TMO], 1u); break; } } } } while (0)

struct XcdBarrier {
    unsigned* bar; unsigned x;
    volatile LAS unsigned* st;
};

__device__ __forceinline__ XcdBarrier xcd_barrier_post(unsigned* bar, volatile LAS unsigned* st) {
    XcdBarrier b; b.bar = bar; b.x = xb_xcc_id(); b.st = st;
    if (threadIdx.x == 0) (void)xb_add(&bar[XB_XCNT(b.x)], 1u);
    return b;
}
__device__ __forceinline__ void xcd_barrier_complete(unsigned* bar, unsigned x, unsigned& nloc, unsigned& nx) {
    const unsigned G = gridDim.x * gridDim.y * gridDim.z;
    unsigned sum, cnt, mine, sp = 0u;
    for (;;) {
        sum = 0u; cnt = 0u; mine = 0u;
#pragma unroll
        for (unsigned j = 0; j < 16; ++j) { const unsigned c = xb_ld(&bar[XB_XCNT(j)]); sum += c; cnt += (c > 0u) ? 1u : 0u; mine = (j == x) ? c : mine; }
        if (sum == G) break;
        __builtin_amdgcn_s_sleep(1);
        if ((++sp & 255u) == 0u) { if (xb_ld(&bar[XB_TMO])) break; if (sp > XB_SPIN_CAP) { atomicAdd(&bar[XB_TMO], 1u); break; } }
    }
    nloc = mine > 0u ? mine : 1u; nx = cnt > 0u ? cnt : 1u;
}

__device__ __forceinline__ void xcd_barrier(const XcdBarrier& b) {
    asm volatile("s_waitcnt vmcnt(0)" ::: "memory");
    __syncthreads();
    if (threadIdx.x == 0) {
        unsigned* bar = b.bar;
        __builtin_amdgcn_s_waitcnt(0);
        unsigned nloc = b.st[0], nx = b.st[1];
        if (nloc == 0u) { xcd_barrier_complete(bar, b.x, nloc, nx); b.st[0] = nloc; b.st[1] = nx; }
        const unsigned old = xb_add(&bar[XB_XSUB(b.x)], 1u);
        const unsigned gen = old / nloc;
        if (old + 1u == (gen + 1u) * nloc) {
            __builtin_amdgcn_fence(__ATOMIC_RELEASE, "agent");
            asm volatile("s_waitcnt vmcnt(0)" ::: "memory");
            const unsigned og = xb_add(&bar[XB_TOP], 1u);
            const unsigned tg = og / nx;
            if (og + 1u == (tg + 1u) * nx) xb_add(&bar[XB_TOPGEN], 1u);
            else XB_SPIN(xb_ld(&bar[XB_TOPGEN]) == tg, bar);
            __builtin_amdgcn_fence(__ATOMIC_ACQUIRE, "agent");
            xb_add(&bar[XB_XGEN(b.x)], 1u);
            asm volatile("s_waitcnt vmcnt(0)" ::: "memory");
        } else {
            XB_SPIN(xb_ld(&bar[XB_XGEN(b.x)]) == gen, bar);
            __builtin_amdgcn_fence(__ATOMIC_ACQUIRE, "agent");
            asm volatile("s_waitcnt vmcnt(0)" ::: "memory");
        }
    }
    __syncthreads();
}

namespace pg8 {
struct EpiProj {
    static constexpr bool PERM = true, AFTER_DRAIN = false;
    bf16_t* P; float* out; float* vst;
    __device__ __forceinline__ void operator()(const f32x4 (&acc)[2][2][4][2], const Unit& u, int wr, int wc, int fr, int fq) const {
        const int row0 = u.pm * BM + wr * 64 + fr;
        const int colt = u.pn * BM + wc * 32 + 8 * fq;
#pragma unroll
        for (int ai = 0; ai < 2; ++ai)
#pragma unroll
            for (int m = 0; m < 4; ++m) { bf16_t* rowp = P + (size_t)(row0 + ai * HALF + m * 16) * DIN + colt;
#pragma unroll
                for (int bj = 0; bj < 2; ++bj) { const f32x4 v0 = acc[ai][bj][m][0], v1 = acc[ai][bj][m][1];
                    u32x4 w; w.x = cvt_pk_bf16(v0[0], v0[1]); w.y = cvt_pk_bf16(v0[2], v0[3]); w.z = cvt_pk_bf16(v1[0], v1[1]); w.w = cvt_pk_bf16(v1[2], v1[3]);
                    *(u32x4*)(rowp + bj * HALF) = w; } }
        if (u.pn >= 4 && u.pn < 8) {
#pragma unroll
            for (int ai = 0; ai < 2; ++ai)
#pragma unroll
                for (int m = 0; m < 4; ++m) { float s = 0.f, q = 0.f;
#pragma unroll
                    for (int bj = 0; bj < 2; ++bj)
#pragma unroll
                        for (int n = 0; n < 2; ++n) { const f32x4 x = acc[ai][bj][m][n]; s += (x[0] + x[1]) + (x[2] + x[3]); q += (x[0] * x[0] + x[1] * x[1]) + (x[2] * x[2] + x[3] * x[3]); }
                    s += __shfl_xor(s, 16); s += __shfl_xor(s, 32); q += __shfl_xor(q, 16); q += __shfl_xor(q, 32);
                    if (fq == 0) { float* d = vst + ((size_t)(row0 + ai * HALF + m * 16) * 16 + (u.pn - 4) * 4 + wc) * 2; *(f32x2*)d = (f32x2){s, q}; } }
        }
        if (u.pn >= 18 && u.pn < 30) {
            const int kv = u.pn >= 24 ? 1 : 0; const int t = u.pn - 18 - 6 * kv; const int g = t >> 1, half = t & 1;
            const int dcol = kv * 512 + half * 256 + wc * 32 + 8 * fq;
            const int R = g == 0 ? 128 : (g == 1 ? 512 : 2048);
            const size_t obp = g == 0 ? O_KVP0 : (g == 1 ? O_KVP1 : O_KVP2), obs = g == 0 ? O_KVS0 : (g == 1 ? O_KVS1 : O_KVS2);
#pragma unroll
            for (int ai = 0; ai < 2; ++ai)
#pragma unroll
                for (int m = 0; m < 4; ++m) { const int row = row0 + ai * HALF + m * 16; float* base = nullptr;
                    if (row < MP) { const int b = row >> 11, s = row & 2047, r = s - (2048 - R); if (r >= 0) base = out + obp + (size_t)(b * R + r) * 1024 + dcol; }
                    else base = out + obs + (size_t)(row - MP) * 1024 + dcol;
                    if (base) {
#pragma unroll
                        for (int bj = 0; bj < 2; ++bj)
#pragma unroll
                            for (int n = 0; n < 2; ++n) *(f32x4*)(base + bj * HALF + 4 * n) = acc[ai][bj][m][n]; } }
        }
    }
};
struct EpiGateA {
    static constexpr bool PERM = true, AFTER_DRAIN = false;
    const bf16_t* P; float* part;
    __device__ __forceinline__ void operator()(const f32x4 (&acc)[2][2][4][2], const Unit& u, int wr, int wc, int fr, int fq) const {
        const int row0 = u.pm * BM + wr * 64 + fr; const int colt = u.pn * BM + wc * 32 + 8 * fq;
#pragma unroll
        for (int ai = 0; ai < 2; ++ai)
#pragma unroll
            for (int m = 0; m < 4; ++m) { const size_t row = (size_t)(row0 + ai * HALF + m * 16); const bf16_t* gp = P + row * DIN + C_GA + colt; float* pp = part + row * DM + colt;
#pragma unroll
                for (int bj = 0; bj < 2; ++bj) { const u32x4 gw = *(const u32x4*)(gp + bj * HALF); const f32x4 a0 = acc[ai][bj][m][0], a1 = acc[ai][bj][m][1];
                    f32x4 o0, o1; o0[0] = a0[0] * sigm(bflo(gw.x)); o0[1] = a0[1] * sigm(bfhi(gw.x)); o0[2] = a0[2] * sigm(bflo(gw.y)); o0[3] = a0[3] * sigm(bfhi(gw.y));
                    o1[0] = a1[0] * sigm(bflo(gw.z)); o1[1] = a1[1] * sigm(bfhi(gw.z)); o1[2] = a1[2] * sigm(bflo(gw.w)); o1[3] = a1[3] * sigm(bfhi(gw.w));
                    *(f32x4*)(pp + bj * HALF) = o0; *(f32x4*)(pp + bj * HALF + 4) = o1; } }
    }
};
struct EpiGateB {
    static constexpr bool PERM = true, AFTER_DRAIN = false;
    const bf16_t* P; const float* part; bf16_t* mrg;
    __device__ __forceinline__ void operator()(const f32x4 (&acc)[2][2][4][2], const Unit& u, int wr, int wc, int fr, int fq) const {
        const int row0 = u.pm * BM + wr * 64 + fr; const int colt = u.pn * BM + wc * 32 + 8 * fq;
#pragma unroll
        for (int ai = 0; ai < 2; ++ai)
#pragma unroll
            for (int m = 0; m < 4; ++m) { const size_t row = (size_t)(row0 + ai * HALF + m * 16); const bf16_t* gp = P + row * DIN + C_GB + colt; const float* pp = part + row * DM + colt;
#pragma unroll
                for (int bj = 0; bj < 2; ++bj) { const u32x4 gw = *(const u32x4*)(gp + bj * HALF); const f32x4 a0 = acc[ai][bj][m][0], a1 = acc[ai][bj][m][1];
                    const f32x4 p0 = *(const f32x4*)(pp + bj * HALF), p1 = *(const f32x4*)(pp + bj * HALF + 4);
                    f32x4 o0, o1; o0[0] = p0[0] + a0[0] * sigm(bflo(gw.x)); o0[1] = p0[1] + a0[1] * sigm(bfhi(gw.x)); o0[2] = p0[2] + a0[2] * sigm(bflo(gw.y)); o0[3] = p0[3] + a0[3] * sigm(bfhi(gw.y));
                    o1[0] = p1[0] + a1[0] * sigm(bflo(gw.z)); o1[1] = p1[1] + a1[1] * sigm(bfhi(gw.z)); o1[2] = p1[2] + a1[2] * sigm(bflo(gw.w)); o1[3] = p1[3] + a1[3] * sigm(bfhi(gw.w));
                    u32x4 w; w.x = cvt_pk_bf16(o0[0], o0[1]); w.y = cvt_pk_bf16(o0[2], o0[3]); w.z = cvt_pk_bf16(o1[0], o1[1]); w.w = cvt_pk_bf16(o1[2], o1[3]);
                    *(u32x4*)(mrg + row * DM + colt + bj * HALF) = w; } }
    }
};
struct EpiF32 {
    static constexpr bool PERM = true, AFTER_DRAIN = false;
    float* O;
    __device__ __forceinline__ void operator()(const f32x4 (&acc)[2][2][4][2], const Unit& u, int wr, int wc, int fr, int fq) const {
        const int row0 = u.pm * BM + wr * 64 + fr; const int colt = u.pn * BM + wc * 32 + 8 * fq;
#pragma unroll
        for (int ai = 0; ai < 2; ++ai)
#pragma unroll
            for (int m = 0; m < 4; ++m) { float* pp = O + (size_t)(row0 + ai * HALF + m * 16) * DM + colt;
#pragma unroll
                for (int bj = 0; bj < 2; ++bj) { *(f32x4*)(pp + bj * HALF) = acc[ai][bj][m][0]; *(f32x4*)(pp + bj * HALF + 4) = acc[ai][bj][m][1]; } }
    }
};
}

__device__ __forceinline__ void p0_transpose_item(const float* W, int K, int N, bf16* WT, int row_off, LAS float* scr, int item, int lane) {
    const int nblk = N / 32, kb = item / nblk, nb = item % nblk, k0 = 64 * kb, n0 = 32 * nb;
#pragma unroll 8
    for (int i = 0; i < 32; ++i) { const int kk = 2 * i + (lane >> 5); scr[kk * 33 + (lane & 31)] = W[(size_t)(k0 + kk) * N + n0 + (lane & 31)]; }
    LDS_WAIT(); asm volatile("" ::: "memory");
    const int c = lane & 7;
#pragma unroll
    for (int j = 0; j < 4; ++j) { const int n = (lane >> 3) + 8 * j; const LAS float* s = scr + (8 * c) * 33 + n;
        v4u o; o.x = pk2(s[0 * 33], s[1 * 33]); o.y = pk2(s[2 * 33], s[3 * 33]); o.z = pk2(s[4 * 33], s[5 * 33]); o.w = pk2(s[6 * 33], s[7 * 33]);
        *(GAS v4u*)(WT + (size_t)(row_off + n0 + n) * K + k0 + 8 * c) = o; }
    LDS_WAIT(); asm volatile("" ::: "memory");
}
__device__ __forceinline__ void mod_task(int task, const float* cp, const float* cs, const float* Wc, const float* bc, float* MODP, LAS unsigned char* lds, int tid, int wave, int lane) {
    const int chunk = task >> 2, kq = task & 3;
    const int k0 = kq * 256 + wave * 32;
    float sc[40], acc[40];
#pragma unroll
    for (int r = 0; r < 40; ++r) { const float* crow = (r < 8) ? cp + r * 1024 : cs + (r - 8) * 1024; sc[r] = silu(crow[k0 + (lane & 31)]); acc[r] = 0.f; }
    const float* wp = Wc + (size_t)k0 * 3072 + chunk * 64 + lane;
#pragma unroll 8
    for (int kk = 0; kk < 32; ++kk) { const float wv = wp[(size_t)kk * 3072];
#pragma unroll
        for (int r = 0; r < 40; ++r) acc[r] += rdlane(sc[r], kk) * wv; }
    LAS float* red = (LAS float*)lds;
#pragma unroll
    for (int r = 0; r < 40; ++r) red[(wave * 40 + r) * 64 + lane] = acc[r];
    __syncthreads();
    for (int idx = tid; idx < 2560; idx += NTHR) { const int r = idx >> 6, cl = idx & 63; float s = 0.f;
#pragma unroll
        for (int w = 0; w < 8; ++w) s += red[(w * 40 + r) * 64 + cl];
        if (kq == 0) s += bc[chunk * 64 + cl];
        MODP[((size_t)kq * 40 + r) * 3072 + chunk * 64 + cl] = s; }
    __syncthreads();
}

typedef short s16x4 __attribute__((ext_vector_type(4)));
__device__ __forceinline__ s16x4 lds_tr(const LAS bf16* p) { return __builtin_bit_cast(s16x4, __builtin_amdgcn_ds_read_tr16_b64_v4i16((LAS s16x4*)p)); }
__device__ __forceinline__ void att_decode(int idx, int& g, int& b, int& h, int& d, int& n, int& r) {
    g = idx >> 10; int rem = idx & 1023; b = rem >> 7; rem &= 127; h = rem >> 4; const int sub = rem & 15;
    if (g == 0) { d = 1; n = sub; r = 0; } else if (g == 1) { d = 4; r = sub >> 2; n = sub & 3; } else { d = 16; r = sub; n = 0; }
}
__device__ __forceinline__ void att_prefetch(int idx, const bf16* PROJ, int tid, int wave, int lane, v4u (&kk)[4], v4u (&vv)[4], bf16x8& Q0, bf16x8& Q1) {
    int g, b, h, d, n, r; att_decode(idx, g, b, h, d, n, r);
    const int key = tid >> 1, half = tid & 1; const int m = 128 * (n - 1) + key;
    if (m >= 0) { const size_t row = (size_t)b * 2048 + (size_t)d * m + r; const bf16* src = PROJ + row * DIN + g * 512 + h * 64 + half * 32;
#pragma unroll
        for (int c = 0; c < 4; ++c) { kk[c] = *(const v4u*)(src + C_K + 8 * c); vv[c] = *(const v4u*)(src + C_VV + 8 * c); } }
    else {
#pragma unroll
        for (int c = 0; c < 4; ++c) { kk[c] = (v4u){0u, 0u, 0u, 0u}; vv[c] = (v4u){0u, 0u, 0u, 0u}; } }
    const int fr = lane & 15, fq = lane >> 4; const int i = 16 * wave + fr;
    const size_t rowq = (size_t)b * 2048 + (size_t)d * (128 * n + i) + r;
    const bf16* qsrc = PROJ + rowq * DIN + C_Q + g * 512 + h * 64 + 8 * fq;
    Q0 = *(const bf16x8*)qsrc; Q1 = *(const bf16x8*)(qsrc + 32);
}
__device__ __forceinline__ void att_compute(int idx, bf16* O3, float* ML, LAS unsigned char* lds, int wave, int lane, const bf16x8 Q0, const bf16x8 Q1) {
    int g, b, h, d, n, r; att_decode(idx, g, b, h, d, n, r);
    const LAS bf16* Ks = (const LAS bf16*)lds;
    const LAS bf16* Vs = (const LAS bf16*)(lds + 36864);
    const int fr = lane & 15, fq = lane >> 4;
    const int i = 16 * wave + fr;
    const size_t rowq = (size_t)b * 2048 + (size_t)d * (128 * n + i) + r;
    const int start = wave & ~1; const int lo = (n == 0) ? 8 : start;
    f32x4 S[10]; float mx = -1e30f;
#pragma unroll
    for (int p = 0; p < 10; ++p) { const int tile = start + p;
        if (tile >= lo) {
            const LAS bf16* kp = Ks + (tile * 16 + fr) * 72 + 8 * fq;
            const bf16x8 K0 = *(const LAS bf16x8*)kp, K1 = *(const LAS bf16x8*)(kp + 32);
            f32x4 s = (f32x4){0.f, 0.f, 0.f, 0.f};
            s = __builtin_amdgcn_mfma_f32_16x16x32_bf16(K0, Q0, s, 0, 0, 0); s = __builtin_amdgcn_mfma_f32_16x16x32_bf16(K1, Q1, s, 0, 0, 0);
#pragma unroll
            for (int e = 0; e < 4; ++e) { const int j = tile * 16 + 4 * fq + e; const bool valid = (j >= i) && (j <= i + 128); s[e] = valid ? s[e] * 0.125f : -1e30f; mx = fmaxf(mx, s[e]); }
            S[p] = s;
        } else S[p] = (f32x4){-1e30f, -1e30f, -1e30f, -1e30f};
    }
    mx = fmaxf(mx, __shfl_xor(mx, 16)); mx = fmaxf(mx, __shfl_xor(mx, 32));
    float l = 0.f;
#pragma unroll
    for (int p = 0; p < 10; ++p)
#pragma unroll
        for (int e = 0; e < 4; ++e) { const float ex = __expf(S[p][e] - mx); S[p][e] = ex; l += ex; }
    l += __shfl_xor(l, 16); l += __shfl_xor(l, 32);
    f32x4 O[4];
#pragma unroll
    for (int dt = 0; dt < 4; ++dt) O[dt] = (f32x4){0.f, 0.f, 0.f, 0.f};
#pragma unroll
    for (int pp = 0; pp < 5; ++pp) {
        if (start + 2 * pp >= lo) {
            v4u pw; pw.x = pk2(S[2 * pp][0], S[2 * pp][1]); pw.y = pk2(S[2 * pp][2], S[2 * pp][3]); pw.z = pk2(S[2 * pp + 1][0], S[2 * pp + 1][1]); pw.w = pk2(S[2 * pp + 1][2], S[2 * pp + 1][3]);
            const bf16x8 Pf = __builtin_bit_cast(bf16x8, pw);
            const LAS bf16* vbase = Vs + ((start + 2 * pp) * 16 + 4 * fq + (fr >> 2)) * 72 + 4 * (fr & 3);
#pragma unroll
            for (int dt = 0; dt < 4; ++dt) { const s16x4 va = lds_tr(vbase + 16 * dt), vb = lds_tr(vbase + 16 * 72 + 16 * dt);
                const bf16x8 Vf = (bf16x8){va[0], va[1], va[2], va[3], vb[0], vb[1], vb[2], vb[3]};
                O[dt] = __builtin_amdgcn_mfma_f32_16x16x32_bf16(Vf, Pf, O[dt], 0, 0, 0); }
        }
    }
    const float inv = 1.f / l;
    bf16* op = O3 + ((size_t)g * MT + rowq) * 512 + h * 64 + 4 * fq;
#pragma unroll
    for (int dt = 0; dt < 4; ++dt) { v2u w; w.x = pk2(O[dt][0] * inv, O[dt][1] * inv); w.y = pk2(O[dt][2] * inv, O[dt][3] * inv); *(v2u*)(op + 16 * dt) = w; }
    if (fq == 0) { float* mp = ML + (((size_t)g * MT + rowq) * 8 + h) * 2; *(f32x2*)mp = (f32x2){mx, l}; }
}

__device__ __forceinline__ void gmlp_item(int idx, const bf16* PROJ, const float* VST, const float* Wsp, const float* bsp, const float* lng, const float* lnb, bf16* YA,
                                          LAS unsigned char* lds, int tid, int wave, int lane) {
    const int ci = idx >> 3, g = idx & 7; const int row0 = ci * 128;
    LAS bf16* VT = (LAS bf16*)lds;
    LAS bf16* WS = (LAS bf16*)(lds + 34816);
    LAS float* st = (LAS float*)(lds + 69632);
    if (tid < 128) { const float* p = VST + (size_t)(row0 + tid) * 32; float s = 0.f, q = 0.f;
#pragma unroll
        for (int k = 0; k < 8; ++k) { const f32x4 a = ((const f32x4*)p)[k]; s += a[0] + a[2]; q += a[1] + a[3]; }
        const float mu = s * (1.f / 1024.f); const float var = q * (1.f / 1024.f) - mu * mu; st[2 * tid] = mu; st[2 * tid + 1] = rsqrtf(var + EPS); }
    { const int t = tid >> 2, sp = tid & 3; const float* wp = Wsp + ((size_t)g * 128 + t) * 128 + sp * 32;
#pragma unroll
        for (int c = 0; c < 4; ++c) { const f32x4 a = ((const f32x4*)wp)[2 * c], b2 = ((const f32x4*)wp)[2 * c + 1]; const int s0 = sp * 32 + 8 * c;
            float v[8] = {a[0], a[1], a[2], a[3], b2[0], b2[1], b2[2], b2[3]};
#pragma unroll
            for (int e = 0; e < 8; ++e) v[e] = (s0 + e <= t) ? v[e] : 0.f;
            v4u w; w.x = pk2(v[0], v[1]); w.y = pk2(v[2], v[3]); w.z = pk2(v[4], v[5]); w.w = pk2(v[6], v[7]);
            *(LAS v4u*)(WS + t * 136 + s0) = w; } }
    __syncthreads();
    { const int s = tid >> 2, cp = tid & 3; const float mu = st[2 * s], rstd = st[2 * s + 1]; const bf16* vp = PROJ + (size_t)(row0 + s) * DIN + C_V + g * 128 + cp * 32;
#pragma unroll
        for (int c = 0; c < 4; ++c) { const v4u raw = *(const v4u*)(vp + 8 * c); const int ch = g * 128 + cp * 32 + 8 * c;
            const f32x4 g0 = *(const f32x4*)(lng + ch), g1 = *(const f32x4*)(lng + ch + 4), b0 = *(const f32x4*)(lnb + ch), b1 = *(const f32x4*)(lnb + ch + 4);
            float x[8] = {bflo(raw.x), bfhi(raw.x), bflo(raw.y), bfhi(raw.y), bflo(raw.z), bfhi(raw.z), bflo(raw.w), bfhi(raw.w)};
            const float gg[8] = {g0[0], g0[1], g0[2], g0[3], g1[0], g1[1], g1[2], g1[3]}; const float bb[8] = {b0[0], b0[1], b0[2], b0[3], b1[0], b1[1], b1[2], b1[3]};
#pragma unroll
            for (int e = 0; e < 8; ++e) VT[(cp * 32 + 8 * c + e) * 136 + s] = (bf16)f2bf((x[e] - mu) * rstd * gg[e] + bb[e]); } }
    __syncthreads();
    const int fr = lane & 15, fq = lane >> 4;
    const int t = 16 * wave + fr; const int nks = (wave >> 1) + 1;
    f32x4 acc[8];
#pragma unroll
    for (int ct = 0; ct < 8; ++ct) acc[ct] = (f32x4){0.f, 0.f, 0.f, 0.f};
#pragma unroll
    for (int ks = 0; ks < 4; ++ks) {
        if (ks < nks) { const bf16x8 Wf = *(const LAS bf16x8*)(WS + t * 136 + 32 * ks + 8 * fq);
#pragma unroll
            for (int ct = 0; ct < 8; ++ct) { const bf16x8 Vf = *(const LAS bf16x8*)(VT + (16 * ct + fr) * 136 + 32 * ks + 8 * fq);
                acc[ct] = __builtin_amdgcn_mfma_f32_16x16x32_bf16(Vf, Wf, acc[ct], 0, 0, 0); } }
    }
    const size_t row = (size_t)row0 + t; const float bs = bsp[g * 128 + t];
    const bf16* up = PROJ + row * DIN + g * 128 + 4 * fq;
    bf16* yp = YA + row * DM + g * 128 + 4 * fq;
#pragma unroll
    for (int ct = 0; ct < 8; ++ct) { const v2u uu = *(const v2u*)(up + C_U + 16 * ct), zz = *(const v2u*)(up + C_Z + 16 * ct);
        const float y0 = bflo(uu.x) * (acc[ct][0] + bs) * silu(bflo(zz.x)), y1 = bfhi(uu.x) * (acc[ct][1] + bs) * silu(bfhi(zz.x));
        const float y2 = bflo(uu.y) * (acc[ct][2] + bs) * silu(bflo(zz.y)), y3 = bfhi(uu.y) * (acc[ct][3] + bs) * silu(bfhi(zz.y));
        v2u w; w.x = pk2(y0, y1); w.y = pk2(y2, y3); *(v2u*)(yp + 16 * ct) = w; }
    __syncthreads();
}

__device__ __forceinline__ void gmlp_sample_item(int b, const bf16* PROJ, const float* VST, const float* Wsp, const float* bsp, const float* lng, const float* lnb, bf16* YA, float* out,
                                                 LAS unsigned char* lds, int tid, int wave, int lane) {
    const int r0 = MP + b * 8;
    LAS float* st = (LAS float*)lds;
    if (tid < 8) { const float* p = VST + (size_t)(r0 + tid) * 32; float s = 0.f, q = 0.f;
#pragma unroll
        for (int k = 0; k < 8; ++k) { const f32x4 a = ((const f32x4*)p)[k]; s += a[0] + a[2]; q += a[1] + a[3]; }
        const float mu = s * (1.f / 1024.f); const float var = q * (1.f / 1024.f) - mu * mu; st[2 * tid] = mu; st[2 * tid + 1] = rsqrtf(var + EPS); }
    __syncthreads();
    const int ch = 2 * tid, g = wave;
    const float lg0 = lng[ch], lg1 = lng[ch + 1], lb0 = lnb[ch], lb1 = lnb[ch + 1];
    float vn0[8], vn1[8];
#pragma unroll
    for (int s = 0; s < 8; ++s) { const unsigned raw = *(const unsigned*)(PROJ + (size_t)(r0 + s) * DIN + C_V + ch); const float mu = st[2 * s], rstd = st[2 * s + 1];
        vn0[s] = (bflo(raw) - mu) * rstd * lg0 + lb0; vn1[s] = (bfhi(raw) - mu) * rstd * lg1 + lb1;
        *(f32x2*)(out + O_VCH + (size_t)(b * 8 + s) * 1024 + ch) = (f32x2){vn0[s], vn1[s]}; }
#pragma unroll
    for (int t = 0; t < 8; ++t) { float z0 = bsp[g * 128 + t], z1 = z0;
#pragma unroll
        for (int s = 0; s < 8; ++s) if (s <= t) { const float w = Wsp[((size_t)g * 128 + t) * 128 + s]; z0 += w * vn0[s]; z1 += w * vn1[s]; }
        const unsigned uu = *(const unsigned*)(PROJ + (size_t)(r0 + t) * DIN + C_U + ch), zz = *(const unsigned*)(PROJ + (size_t)(r0 + t) * DIN + C_Z + ch);
        *(unsigned*)(YA + (size_t)(r0 + t) * DM + ch) = pk2(bflo(uu) * z0 * silu(bflo(zz)), bfhi(uu) * z1 * silu(bfhi(zz))); }
    __syncthreads();
}

__device__ __forceinline__ f32x4 sa_load(const bf16* PROJ, const float* cache, int b, int lw, int ix, int pcol, int ccol, bool maybe_new) {
    if (maybe_new && ix >= lw) { const v2u raw = *(const v2u*)(PROJ + (size_t)(MP + b * 8 + ix - lw) * DIN + pcol); return (f32x4){bflo(raw.x), bfhi(raw.x), bflo(raw.y), bfhi(raw.y)}; }
    const int ic = ix < lw ? ix : lw - 1;
    return *(const f32x4*)(cache + (size_t)ic * 1024 + ccol);
}
__device__ __forceinline__ void attn_sample_item(int idx, const bf16* PROJ, const float* c128, const float* c512, const float* c2048, bf16* O3, float* ML, int wave, int lane) {
    const int b = idx / 24; const int rem = idx - b * 24; const int g = rem >> 3, t = rem & 7; const int h = wave;
    const int lw = g == 0 ? 128 : (g == 1 ? 512 : 2048), d = g == 0 ? 1 : (g == 1 ? 4 : 16);
    const float* cache = (g == 0 ? c128 : (g == 1 ? c512 : c2048)) + (size_t)b * lw * 1024;
    const size_t rq = (size_t)MP + b * 8 + t;
    const int ks = lane >> 4, dq = lane & 15;
    const int hc = g * 512 + h * 64 + 4 * dq;
    const v2u qraw = *(const v2u*)(PROJ + rq * DIN + C_Q + hc);
    const float q0 = bflo(qraw.x) * 0.125f, q1 = bfhi(qraw.x) * 0.125f, q2 = bflo(qraw.y) * 0.125f, q3 = bfhi(qraw.y) * 0.125f;
    float s[33]; float mx = -1e30f;
#pragma unroll
    for (int it = 0; it < 33; ++it) {
        int j = 4 * it + ks; const bool ok = (it < 32) || (ks == 0); if (!ok) j = 128;
        const int ix = lw + t - d * j;
        const f32x4 kk = sa_load(PROJ, cache, b, lw, ix, C_K + hc, h * 64 + 4 * dq, it < 2);
        float a = (kk[0] * q0 + kk[1] * q1) + (kk[2] * q2 + kk[3] * q3);
        a += __shfl_xor(a, 1); a += __shfl_xor(a, 2); a += __shfl_xor(a, 4); a += __shfl_xor(a, 8);
        s[it] = ok ? a : -1e30f; mx = fmaxf(mx, s[it]);
    }
    mx = fmaxf(mx, __shfl_xor(mx, 16)); mx = fmaxf(mx, __shfl_xor(mx, 32));
    float l = 0.f;
#pragma unroll
    for (int it = 0; it < 33; ++it) { s[it] = __expf(s[it] - mx); l += s[it]; }
    l += __shfl_xor(l, 16); l += __shfl_xor(l, 32);
    f32x4 o = (f32x4){0.f, 0.f, 0.f, 0.f};
#pragma unroll
    for (int it = 0; it < 33; ++it) {
        int j = 4 * it + ks; if (!((it < 32) || (ks == 0))) j = 128;
        const int ix = lw + t - d * j;
        const f32x4 vv = sa_load(PROJ, cache, b, lw, ix, C_VV + hc, 512 + h * 64 + 4 * dq, it < 2);
        o += vv * s[it];
    }
#pragma unroll
    for (int e = 0; e < 4; ++e) { o[e] += __shfl_xor(o[e], 16); o[e] += __shfl_xor(o[e], 32); }
    const float inv = 1.f / l;
    if (ks == 0) { v2u w; w.x = pk2(o[0] * inv, o[1] * inv); w.y = pk2(o[2] * inv, o[3] * inv); *(v2u*)(O3 + ((size_t)g * MT + rq) * 512 + h * 64 + 4 * dq) = w; }
    if (lane == 0) { float* mp = ML + (((size_t)g * MT + rq) * 8 + h) * 2; mp[0] = mx; mp[1] = l; }
}

template <int MW, int NT>
__device__ __forceinline__ void sg_mma(f32x4 (&acc)[MW][NT], const bf16* A, const bf16* Bt, int K, int lane) {
    const int fr = lane & 15, fq = lane >> 4;
    const bf16* ap = A + (size_t)fr * K + 8 * fq; const bf16* bp = Bt + (size_t)fr * K + 8 * fq;
    constexpr int UNR = (MW * NT == 1) ? 16 : 4;
#pragma unroll UNR
    for (int ks = 0; ks < K / 32; ++ks) {
        bf16x8 a[MW], b[NT];
#pragma unroll
        for (int mi = 0; mi < MW; ++mi) a[mi] = *(const bf16x8*)(ap + (size_t)mi * 16 * K + 32 * ks);
#pragma unroll
        for (int ni = 0; ni < NT; ++ni) b[ni] = *(const bf16x8*)(bp + (size_t)ni * 16 * K + 32 * ks);
#pragma unroll
        for (int mi = 0; mi < MW; ++mi)
#pragma unroll
            for (int ni = 0; ni < NT; ++ni) acc[mi][ni] = __builtin_amdgcn_mfma_f32_16x16x32_bf16(b[ni], a[mi], acc[mi][ni], 0, 0, 0);
    }
}
__device__ __forceinline__ void sg_proj_task(int ts, const bf16* H, const bf16* WIN_T, bf16* PROJ, float* out, float* VST, int wave, int lane) {
    const int fr = lane & 15, fq = lane >> 4; const int n0 = 64 * ts; const int r0 = MP + 32 * wave;
    f32x4 acc[2][4];
#pragma unroll
    for (int mi = 0; mi < 2; ++mi)
#pragma unroll
        for (int ni = 0; ni < 4; ++ni) acc[mi][ni] = (f32x4){0.f, 0.f, 0.f, 0.f};
    sg_mma<2, 4>(acc, H + (size_t)r0 * DM, WIN_T + (size_t)n0 * DM, DM, lane);
#pragma unroll
    for (int mi = 0; mi < 2; ++mi) { const int row = r0 + 16 * mi + fr;
#pragma unroll
        for (int ni = 0; ni < 4; ++ni) { const int col = n0 + 16 * ni + 4 * fq; const f32x4 v = acc[mi][ni];
            v2u w; w.x = pk2(v[0], v[1]); w.y = pk2(v[2], v[3]); *(v2u*)(PROJ + (size_t)row * DIN + col) = w;
            if (col >= C_K && col < C_ZB) { const int kv = col >= C_VV ? 1 : 0; const int cc = col - (kv ? C_VV : C_K); const int g = cc >> 9, hc = cc & 511;
                const size_t obs = g == 0 ? O_KVS0 : (g == 1 ? O_KVS1 : O_KVS2);
                *(f32x4*)(out + obs + (size_t)(row - MP) * 1024 + kv * 512 + hc) = v; } }
        if (n0 >= C_V && n0 < C_Z) { float s = 0.f, q = 0.f;
#pragma unroll
            for (int ni = 0; ni < 4; ++ni) { const f32x4 x = acc[mi][ni]; s += (x[0] + x[1]) + (x[2] + x[3]); q += (x[0] * x[0] + x[1] * x[1]) + (x[2] * x[2] + x[3] * x[3]); }
            s += __shfl_xor(s, 16); s += __shfl_xor(s, 32); q += __shfl_xor(q, 16); q += __shfl_xor(q, 32);
            if (fq == 0) *(f32x2*)(VST + ((size_t)row * 16 + ((n0 - C_V) >> 6)) * 2) = (f32x2){s, q}; } }
}
__device__ __forceinline__ void sg_merge_task(int ts, const bf16* YA, const bf16* YB, const bf16* WPA_T, const bf16* WPB_T, const bf16* PROJ, bf16* MRG, int wave, int lane) {
    const int fr = lane & 15, fq = lane >> 4; const int n0 = 16 * (ts & 63); const int r0 = MP + 128 * (ts >> 6) + 16 * wave;
    f32x4 aa[1][1], ab[1][1]; aa[0][0] = (f32x4){0.f, 0.f, 0.f, 0.f}; ab[0][0] = (f32x4){0.f, 0.f, 0.f, 0.f};
    sg_mma<1, 1>(aa, YA + (size_t)r0 * DM, WPA_T + (size_t)n0 * DM, DM, lane);
    sg_mma<1, 1>(ab, YB + (size_t)r0 * 512, WPB_T + (size_t)n0 * 512, 512, lane);
    const size_t row = (size_t)r0 + fr; const int col = n0 + 4 * fq;
    const v2u ga = *(const v2u*)(PROJ + row * DIN + C_GA + col), gb = *(const v2u*)(PROJ + row * DIN + C_GB + col);
    const float m0 = aa[0][0][0] * sigm(bflo(ga.x)) + ab[0][0][0] * sigm(bflo(gb.x)), m1 = aa[0][0][1] * sigm(bfhi(ga.x)) + ab[0][0][1] * sigm(bfhi(gb.x));
    const float m2 = aa[0][0][2] * sigm(bflo(ga.y)) + ab[0][0][2] * sigm(bflo(gb.y)), m3 = aa[0][0][3] * sigm(bfhi(ga.y)) + ab[0][0][3] * sigm(bfhi(gb.y));
    v2u w; w.x = pk2(m0, m1); w.y = pk2(m2, m3); *(v2u*)(MRG + row * DM + col) = w;
}
__device__ __forceinline__ void sg_out_task(int ts, const bf16* MRG, const bf16* WOUT_T, float* OUTB, int wave, int lane) {
    const int fr = lane & 15, fq = lane >> 4; const int n0 = 16 * (ts & 63); const int r0 = MP + 128 * (ts >> 6) + 16 * wave;
    f32x4 aa[1][1]; aa[0][0] = (f32x4){0.f, 0.f, 0.f, 0.f};
    sg_mma<1, 1>(aa, MRG + (size_t)r0 * DM, WOUT_T + (size_t)n0 * DM, DM, lane);
    *(f32x4*)(OUTB + ((size_t)r0 + fr) * DM + n0 + 4 * fq) = aa[0][0];
}

struct Args { const float* in[19]; float* out; unsigned char* ws; };
__global__ void __launch_bounds__(NTHR, 2) fwd_kernel(Args args) {
    extern __shared__ __attribute__((aligned(16))) unsigned char lds_raw[];
    cg::grid_group grid = cg::this_grid();
    LAS unsigned char* lds = (LAS unsigned char*)lds_raw;
    const int tid = threadIdx.x, lane = tid & 63, wave = __builtin_amdgcn_readfirstlane(tid >> 6);
    const int G = gridDim.x, bx = blockIdx.x;
    const int gw = bx * NWAVES + wave, NGW = G * NWAVES;
    const float* xp = args.in[0]; const float* xs = args.in[1];
    const float* c128 = args.in[2]; const float* c512 = args.in[3]; const float* c2048 = args.in[4];
    const float* cpr = args.in[5]; const float* csm = args.in[6]; const float* wcond = args.in[7]; const float* bcond = args.in[8]; const float* gpre = args.in[9];
    const float* win = args.in[10]; const float* lng = args.in[11]; const float* lnb = args.in[12]; const float* wsp = args.in[13]; const float* bsp = args.in[14];
    const float* wpa = args.in[15]; const float* wpb = args.in[16]; const float* wout = args.in[17]; const float* gpost = args.in[18];
    float* out = args.out; unsigned char* ws = args.ws;
    bf16* WIN_T = (bf16*)(ws + WS_WIN); bf16* WPA_T = (bf16*)(ws + WS_WPA); bf16* WPB_T = (bf16*)(ws + WS_WPB); bf16* WOUT_T = (bf16*)(ws + WS_WOUT);
    float* MOD = (float*)(ws + WS_MOD); float* VST = (float*)(ws + WS_VST); float* ML = (float*)(ws + WS_ML);
    bf16* H = (bf16*)(ws + WS_H); bf16* YA = (bf16*)(ws + WS_YA); bf16* YB = (bf16*)(ws + WS_YB); bf16* MRG = (bf16*)(ws + WS_MRG); bf16* O3 = (bf16*)(ws + WS_O3);
    float* PART = (float*)(ws + WS_PART); float* OUTB = (float*)(ws + WS_OUT); bf16* PROJ = (bf16*)(ws + WS_PROJ);

    unsigned* barw = (unsigned*)(ws + 16384);
    volatile LAS unsigned* bst = (volatile LAS unsigned*)(lds + 139264);
    if (tid < 2) bst[tid] = 0u;
    if (bx == 0) for (int u = tid; u < XCD_BAR_WORDS; u += NTHR) barw[u] = 0u;
    if (bx < 192) mod_task(bx, cpr, csm, wcond, bcond, MOD, lds, tid, wave, lane);
    {
        LAS float* scr = (LAS float*)(lds + wave * 16384);
        constexpr int I_IN = (1024 / 64) * (DIN / 32), I_PA = (1024 / 64) * (1024 / 32), I_PB = (512 / 64) * (1024 / 32), I_OUT = I_PA;
        constexpr int NITEMS = I_IN + I_PA + I_PB + I_OUT;
        for (int it = gw; it < NITEMS; it += NGW) {
            int r = it;
            if (r < I_IN) { p0_transpose_item(win, 1024, DIN, WIN_T, 0, scr, r, lane); continue; } r -= I_IN;
            if (r < I_PA) { p0_transpose_item(wpa, 1024, 1024, WPA_T, 0, scr, r, lane); continue; } r -= I_PA;
            if (r < I_PB) { p0_transpose_item(wpb, 512, 1024, WPB_T, 0, scr, r, lane); continue; } r -= I_PB;
            p0_transpose_item(wout, 1024, 1024, WOUT_T, 0, scr, r, lane);
        }
    }
    grid.sync();
    const XcdBarrier xbar = xcd_barrier_post(barw, bst);
    for (int rb = gw; rb < MT / 8; rb += NGW) {
        const int rowb = rb * 8;
        const float* mod = MOD + (rowb < MP ? (rowb >> 11) : 8 + ((rowb - MP) >> 3)) * 3072;
        f32x4 gs[4], sh[4];
#pragma unroll
        for (int j = 0; j < 4; ++j) { const int c = 4 * lane + 256 * j; f32x4 a = (f32x4){0.f, 0.f, 0.f, 0.f}, s2 = (f32x4){1.f, 1.f, 1.f, 1.f};
#pragma unroll
            for (int q = 0; q < 4; ++q) { a += *(const f32x4*)(mod + (size_t)q * 40 * 3072 + c); s2 += *(const f32x4*)(mod + (size_t)q * 40 * 3072 + 1024 + c); }
            sh[j] = a; gs[j] = s2 * *(const f32x4*)(gpre + c); }
#pragma unroll 2
        for (int i = 0; i < 8; ++i) { const int row = rowb + i;
            const float* xr = row < MP ? xp + (size_t)row * DM : xs + (size_t)(row - MP) * DM;
            f32x4 v[4]; float ss = 0.f;
#pragma unroll
            for (int j = 0; j < 4; ++j) { v[j] = ((const f32x4*)xr)[lane + 64 * j]; ss += (v[j][0] * v[j][0] + v[j][1] * v[j][1]) + (v[j][2] * v[j][2] + v[j][3] * v[j][3]); }
            const float rstd = rsqrtf(wave_sum(ss) * (1.f / DM) + EPS);
#pragma unroll
            for (int j = 0; j < 4; ++j) { const int c = 4 * lane + 256 * j; const f32x4 hh = v[j] * rstd * gs[j] + sh[j];
                v2u w; w.x = pk2(hh[0], hh[1]); w.y = pk2(hh[2], hh[3]); *(v2u*)(H + (size_t)row * DM + c) = w; } }
    }
    xcd_barrier(xbar);
    {
        if (bx < 160) sg_proj_task(bx, H, WIN_T, PROJ, out, VST, wave, lane);
        pg8::Gemm gm{H, WIN_T, MP, DIN, DM}; pg8::StaticOrder S; S.init(MP, DIN, G, bx);
        pg8::EpiProj E{PROJ, out, VST};
        pg8::gemm_phase<pg8::EpiProj, pg8::StaticOrder, true, true>(lds, gm, S, E);
    }
    xcd_barrier(xbar);
    {
        constexpr int N_ATT = 3072, N_GM = 1024, N_SA = 768, N_SG = 32;
        {
            v4u kk[4], vv[4]; bf16x8 Q0, Q1;
            int it = bx;
            if (it < N_ATT) att_prefetch(it, PROJ, tid, wave, lane, kk, vv, Q0, Q1);
            const int key = tid >> 1, half = tid & 1;
            for (; it < N_ATT; it += G) {
#pragma unroll
                for (int c = 0; c < 4; ++c) { *(LAS v4u*)((LAS bf16*)lds + key * 72 + half * 32 + 8 * c) = kk[c]; *(LAS v4u*)((LAS bf16*)(lds + 36864) + key * 72 + half * 32 + 8 * c) = vv[c]; }
                const bf16x8 Qc0 = Q0, Qc1 = Q1;
                __syncthreads();
                if (it + G < N_ATT) att_prefetch(it + G, PROJ, tid, wave, lane, kk, vv, Q0, Q1);
                att_compute(it, O3, ML, lds, wave, lane, Qc0, Qc1);
                __syncthreads();
            }
        }
        for (int it = bx; it < N_GM; it += G) gmlp_item(it, PROJ, VST, wsp, bsp, lng, lnb, YA, lds, tid, wave, lane);
        for (int it = bx; it < N_SA; it += G) attn_sample_item(it, PROJ, c128, c512, c2048, O3, ML, wave, lane);
        for (int it = bx; it < N_SG; it += G) gmlp_sample_item(it, PROJ, VST, wsp, bsp, lng, lnb, YA, out, lds, tid, wave, lane);
    }
    xcd_barrier(xbar);
    for (int row = gw; row < MT; row += NGW) {
        const int head = lane >> 3;
        float mg[3], lg[3];
#pragma unroll
        for (int g = 0; g < 3; ++g) { const f32x2 a = *(const f32x2*)(ML + (((size_t)g * MT + row) * 8 + head) * 2); mg[g] = a[0]; lg[g] = a[1]; }
        const float mm = fmaxf(fmaxf(mg[0], mg[1]), mg[2]);
        float wg[3]; float den = 0.f;
#pragma unroll
        for (int g = 0; g < 3; ++g) { wg[g] = __expf(mg[g] - mm) * lg[g]; den += wg[g]; }
        const float rden = 1.f / den;
        float o[8] = {0.f, 0.f, 0.f, 0.f, 0.f, 0.f, 0.f, 0.f};
#pragma unroll
        for (int g = 0; g < 3; ++g) { const v4u raw = *(const v4u*)(O3 + ((size_t)g * MT + row) * 512 + lane * 8); const float w = wg[g] * rden;
            o[0] += w * bflo(raw.x); o[1] += w * bfhi(raw.x); o[2] += w * bflo(raw.y); o[3] += w * bfhi(raw.y); o[4] += w * bflo(raw.z); o[5] += w * bfhi(raw.z); o[6] += w * bflo(raw.w); o[7] += w * bfhi(raw.w); }
        const v4u zr = *(const v4u*)(PROJ + (size_t)row * DIN + C_ZB + lane * 8);
        v4u w; w.x = pk2(o[0] * silu(bflo(zr.x)), o[1] * silu(bfhi(zr.x))); w.y = pk2(o[2] * silu(bflo(zr.y)), o[3] * silu(bfhi(zr.y)));
        w.z = pk2(o[4] * silu(bflo(zr.z)), o[5] * silu(bfhi(zr.z))); w.w = pk2(o[6] * silu(bflo(zr.w)), o[7] * silu(bfhi(zr.w)));
        *(v4u*)(YB + (size_t)row * 512 + lane * 8) = w;
    }
    xcd_barrier(xbar);
    {
        if (bx < 128) sg_merge_task(bx, YA, YB, WPA_T, WPB_T, PROJ, MRG, wave, lane);
        pg8::Gemm gm{YA, WPA_T, MP, DM, DM}; pg8::StaticOrder S; S.init(MP, DM, G, bx);
        pg8::EpiGateA E{PROJ, PART};
        pg8::gemm_phase<pg8::EpiGateA, pg8::StaticOrder, true, true>(lds, gm, S, E);
    }
    {
        pg8::Gemm gm{YB, WPB_T, MP, DM, 512}; pg8::StaticOrder S; S.init(MP, DM, G, bx);
        pg8::EpiGateB E{PROJ, PART, MRG};
        pg8::gemm_phase<pg8::EpiGateB, pg8::StaticOrder, true, true>(lds, gm, S, E);
    }
    xcd_barrier(xbar);
    {
        if (bx < 128) sg_out_task(bx, MRG, WOUT_T, OUTB, wave, lane);
        pg8::Gemm gm{MRG, WOUT_T, MP, DM, DM}; pg8::StaticOrder S; S.init(MP, DM, G, bx);
        pg8::EpiF32 E{OUTB};
        pg8::gemm_phase<pg8::EpiF32, pg8::StaticOrder, true, true>(lds, gm, S, E);
    }
    xcd_barrier(xbar);
    for (int rb = gw; rb < MT / 8; rb += NGW) {
        const int rowb = rb * 8;
        const float* gate = MOD + (rowb < MP ? (rowb >> 11) : 8 + ((rowb - MP) >> 3)) * 3072 + 2048;
        f32x4 gt[4];
#pragma unroll
        for (int j = 0; j < 4; ++j) { const int c = 4 * lane + 256 * j; f32x4 a = (f32x4){0.f, 0.f, 0.f, 0.f};
#pragma unroll
            for (int q = 0; q < 4; ++q) a += *(const f32x4*)(gate + (size_t)q * 40 * 3072 + c);
            gt[j] = a * *(const f32x4*)(gpost + c); }
#pragma unroll 2
        for (int i = 0; i < 8; ++i) { const int row = rowb + i;
            const float* xr = row < MP ? xp + (size_t)row * DM : xs + (size_t)(row - MP) * DM;
            const float* orow = OUTB + (size_t)row * DM;
            f32x4 v[4]; float ss = 0.f;
#pragma unroll
            for (int j = 0; j < 4; ++j) { v[j] = ((const f32x4*)orow)[lane + 64 * j]; ss += (v[j][0] * v[j][0] + v[j][1] * v[j][1]) + (v[j][2] * v[j][2] + v[j][3] * v[j][3]); }
            const float rstd = rsqrtf(wave_sum(ss) * (1.f / DM) + EPS);
#pragma unroll
            for (int j = 0; j < 4; ++j) { const int c = 4 * lane + 256 * j; const f32x4 xx = ((const f32x4*)xr)[lane + 64 * j];
                *(f32x4*)(out + (size_t)row * DM + c) = xx + gt[j] * (v[j] * rstd); } }
    }
}

extern "C" void kernel_launch(void* const* d_in, const int* in_sizes, int n_in, void* d_out, int out_size, void* d_ws, size_t ws_size, hipStream_t stream) {
    static int grid = 0;
    if (grid == 0) {
        if (n_in != 19 || (size_t)out_size != O_END || ws_size < WS_END) { fprintf(stderr, "kernel_launch: unexpected shapes: n_in %d out %d ws %zu\n", n_in, out_size, ws_size); grid = -1; return; }
        int dev = 0, cus = 0, per_cu = 0;
        if (hipGetDevice(&dev) != hipSuccess || hipDeviceGetAttribute(&cus, hipDeviceAttributeMultiprocessorCount, dev) != hipSuccess) { fprintf(stderr, "kernel_launch: device query failed\n"); grid = -1; return; }
        if (hipFuncSetAttribute((const void*)fwd_kernel, hipFuncAttributeMaxDynamicSharedMemorySize, LDS_BYTES) != hipSuccess) { fprintf(stderr, "kernel_launch: hipFuncSetAttribute failed\n"); grid = -1; return; }
        if (hipOccupancyMaxActiveBlocksPerMultiprocessor(&per_cu, (const void*)fwd_kernel, NTHR, LDS_BYTES) != hipSuccess || per_cu < 1) { fprintf(stderr, "kernel_launch: occupancy query says %d blocks per CU\n", per_cu); }
        (void)hipGetLastError();
        grid = cus;
    }
    if (grid < 0) return;
    Args a{};
    for (int i = 0; i < 19; ++i) a.in[i] = (const float*)d_in[i];
    a.out = (float*)d_out; a.ws = (unsigned char*)d_ws;
    void* kargs[] = {&a};
    hipError_t e = hipLaunchCooperativeKernel((const void*)fwd_kernel, dim3(grid), dim3(NTHR), kargs, LDS_BYTES, stream);
    if (e != hipSuccess) fprintf(stderr, "kernel_launch: cooperative launch failed: %s (grid %d)\n", hipGetErrorString(e), grid);
}
```

```cpp
#include <hip/hip_runtime.h>
#include <hip/hip_cooperative_groups.h>
#include <cstdio>
#include <cstdint>
namespace cg = cooperative_groups;
namespace pg8 {
#define PG8_LAS __attribute__((address_space(3)))
typedef unsigned short bf16_t;
typedef short bf16x8 __attribute__((ext_vector_type(8)));
typedef float f32x4 __attribute__((ext_vector_type(4)));
typedef unsigned u32x4 __attribute__((ext_vector_type(4)));
constexpr int BM = 256, BK = 64, HALF = 128, HTB = HALF * BK * 2  , STAGE_BYTES = 8 * HTB, NXCD = 8, WGM = 8;

__host__ __device__ __forceinline__ int lds_byte(int r, int c) { const int st = (r >> 4) * 2 + (c >> 5), rr = r & 15, cc = c & 31, ob = rr * 64 + cc * 2; return st * 1024 + (ob ^ (((ob >> 9) & 1) << 5)); }
__host__ __device__ __forceinline__ void stage_rc(int b, int& R, int& C) { const int st = b / 1024, sb = b % 1024, swz = sb ^ (((sb >> 9) & 1) << 5); R = (st >> 1) * 16 + swz / 64; C = (st & 1) * 32 + (swz % 64) / 2; }
__host__ __device__ __forceinline__ int perm32(int rho) { const int n = rho >> 4, i = rho & 15; return 8 * (i >> 2) + 4 * n + (i & 3); }

struct Unit { int pm, pn; };
struct Gemm { const bf16_t* A; const bf16_t* Bt; int M, N, K; };

struct StaticOrder {
    int nM, nN, nwg, G, c;
    __host__ __device__ void init(int M, int N, int G_, int c_) { nM = M / BM; nN = N / BM; nwg = nM * nN; G = G_; c = c_; }
    __host__ __device__ bool next(int i, Unit& u) const {
        const long L = (long)i * G + c; if (L >= nwg) return false;
        int wgid = (int)L; { const int q = nwg / NXCD, r = nwg % NXCD, xcd = wgid % NXCD, off = wgid / NXCD; wgid = (xcd < r ? xcd * (q + 1) : r * (q + 1) + (xcd - r) * q) + off; }
        const int nig = WGM * nN, gid = wgid / nig, fm = gid * WGM, gsz = (nM - fm) < WGM ? (nM - fm) : WGM;
        u.pm = fm + ((wgid % nig) % gsz); u.pn = (wgid % nig) / gsz; return true;
    }
    __device__ __forceinline__ void a_ready(const Unit&) const {}
    __device__ __forceinline__ void done(const Unit&) const {}
};
__device__ __forceinline__ unsigned cvt_pk_bf16(float lo, float hi) { unsigned r; asm volatile("v_cvt_pk_bf16_f32 %0, %1, %2" : "=v"(r) : "v"(lo), "v"(hi)); return r; }
typedef float f32x2 __attribute__((ext_vector_type(2)));
template <class Epi, class Sched, bool ALIGN_EPI = false, bool SP2 = false>
__device__ __forceinline__ void gemm_phase(PG8_LAS unsigned char* lds, const Gemm g, const Sched& S, const Epi& E) {
    const int tid = threadIdx.x, wid = __builtin_amdgcn_readfirstlane(tid >> 6), lane = tid & 63, wr = wid >> 2, wc = wid & 3, fr = lane & 15, fq = lane >> 4;
    const int K = g.K, nt = K / BK;
    unsigned voffA[2], voffB[2];
#pragma unroll
    for (int i = 0; i < 2; ++i) { int R, C; stage_rc(tid * 16 + i * 8192, R, C); const int Rb = Epi::PERM ? ((R & ~31) + perm32(R & 31)) : R;
        voffA[i] = (unsigned)(R * K + C) * 2u; voffB[i] = (unsigned)(Rb * K + C) * 2u; }
    const size_t kstep = (size_t)(BK * 2);
    const size_t hstep = (size_t)HALF * K * 2;
    const size_t tstep = 2 * hstep;
    const unsigned ldsw = (unsigned)wid * 1024u;
    const int aoff = lds_byte(wr * 64 + fr, fq * 8), boff = lds_byte(wc * 32 + fr, fq * 8);
#define PG8_SA(b, h) (((b) * 2 + (h)) * HTB)
#define PG8_SB(b, h) ((4 + (b) * 2 + (h)) * HTB)
#define PG8_STAGE(bufoff, gbase, voff) do { _Pragma("unroll") for (int _i = 0; _i < 2; ++_i) \
        __builtin_amdgcn_global_load_lds((const unsigned*)((const char*)(gbase) + (voff)[_i]), (PG8_LAS unsigned*)(lds + (bufoff) + ldsw + _i * 8192), 16, 0, 0); } while (0)
#define PG8_LDA(dst, b, h) do { _Pragma("unroll") for (int m = 0; m < 4; ++m) _Pragma("unroll") for (int k = 0; k < 2; ++k) dst[m][k] = *(const PG8_LAS bf16x8*)(lds + PG8_SA(b, h) + aoff + m * 2048 + k * 1024); } while (0)
#define PG8_LDB(dst, b, h) do { _Pragma("unroll") for (int n = 0; n < 2; ++n) _Pragma("unroll") for (int k = 0; k < 2; ++k) dst[n][k] = *(const PG8_LAS bf16x8*)(lds + PG8_SB(b, h) + boff + n * 2048 + k * 1024); } while (0)
#define PG8_MMA(ai, bj, At, Bt) do { __builtin_amdgcn_s_setprio(1); _Pragma("unroll") for (int m = 0; m < 4; ++m) _Pragma("unroll") for (int n = 0; n < 2; ++n) _Pragma("unroll") for (int k = 0; k < 2; ++k) \
        acc[ai][bj][m][n] = __builtin_amdgcn_mfma_f32_16x16x32_bf16(Bt[n][k], At[m][k], acc[ai][bj][m][n], 0, 0, 0); __builtin_amdgcn_s_setprio(0); } while (0)
#define PG8_WAIT_V(n) asm volatile("s_waitcnt vmcnt(" #n ")" ::: "memory")
#define PG8_WAIT_L(n) asm volatile("s_waitcnt lgkmcnt(" #n ")" ::: "memory")
#define PG8_BAR __builtin_amdgcn_s_barrier()
#define PG8_SCHED __builtin_amdgcn_sched_barrier(0)
    Unit cur, nxt; int ui = 0;
    if (!S.next(0, cur)) return;
    f32x4 acc[2][2][4][2];
#pragma unroll
    for (int a = 0; a < 2; ++a)
#pragma unroll
        for (int b = 0; b < 2; ++b)
#pragma unroll
            for (int m = 0; m < 4; ++m)
#pragma unroll
                for (int n = 0; n < 2; ++n) acc[a][b][m][n] = (f32x4){0.f, 0.f, 0.f, 0.f};
    bf16x8 At[4][2], B0[2][2], B1[2][2];
    const char* cA = (const char*)g.A + (size_t)cur.pm * tstep; const char* cB = (const char*)g.Bt + (size_t)cur.pn * tstep;
    S.a_ready(cur);
    if constexpr (SP2) {
        PG8_STAGE(PG8_SB(0, 0), cB, voffB); PG8_STAGE(PG8_SB(0, 1), cB + hstep, voffB); PG8_STAGE(PG8_SA(0, 0), cA, voffA); PG8_STAGE(PG8_SA(0, 1), cA + hstep, voffA);
        if (wr == 1) PG8_BAR;
        PG8_WAIT_V(2); PG8_BAR;
        PG8_STAGE(PG8_SB(1, 0), cB + kstep, voffB); PG8_STAGE(PG8_SA(1, 0), cA + kstep, voffA); PG8_STAGE(PG8_SB(1, 1), cB + hstep + kstep, voffB);
        PG8_WAIT_V(6); PG8_BAR;
    } else {
        PG8_STAGE(PG8_SB(0, 0), cB, voffB); PG8_STAGE(PG8_SA(0, 0), cA, voffA); PG8_STAGE(PG8_SB(0, 1), cB + hstep, voffB); PG8_STAGE(PG8_SA(0, 1), cA + hstep, voffA);
        if (wr == 1) PG8_BAR;
        PG8_WAIT_V(4); PG8_BAR;
        PG8_STAGE(PG8_SB(1, 0), cB + kstep, voffB); PG8_STAGE(PG8_SA(1, 0), cA + kstep, voffA); PG8_STAGE(PG8_SB(1, 1), cB + hstep + kstep, voffB);
        PG8_WAIT_V(6); PG8_BAR;
    }
    for (;;) {
        const bool has_next = S.next(ui + 1, nxt);
        const char* nA = has_next ? (const char*)g.A + (size_t)nxt.pm * tstep : cA; const char* nB = has_next ? (const char*)g.Bt + (size_t)nxt.pn * tstep : cB;
        for (int t = 0; t < nt; t += 2) {
            const bool last = (t == nt - 2);
            const char* a1 = cA + (size_t)(t + 1) * kstep;
            const char* a2 = last ? nA : cA + (size_t)(t + 2) * kstep; const char* b2 = last ? nB : cB + (size_t)(t + 2) * kstep;
            const char* a3 = a2 + kstep; const char* b3 = b2 + kstep;
            if (last && has_next) S.a_ready(nxt);
            if constexpr (SP2) {
            PG8_LDB(B0, 0, 0); PG8_LDB(B1, 0, 1); PG8_SCHED; PG8_LDA(At, 0, 0); PG8_STAGE(PG8_SA(1, 1), a1 + hstep, voffA);
            PG8_WAIT_V(8); PG8_WAIT_L(0); PG8_BAR; PG8_MMA(0, 0, At, B0); PG8_MMA(0, 1, At, B1); PG8_BAR; PG8_SCHED;
            PG8_LDA(At, 0, 1); PG8_STAGE(PG8_SB(0, 0), b2, voffB); PG8_STAGE(PG8_SB(0, 1), b2 + hstep, voffB); PG8_STAGE(PG8_SA(0, 0), a2, voffA);
            PG8_WAIT_V(8); PG8_WAIT_L(0); PG8_BAR; PG8_MMA(1, 0, At, B0); PG8_MMA(1, 1, At, B1); PG8_BAR; PG8_SCHED;
            PG8_LDB(B0, 1, 0); PG8_LDB(B1, 1, 1); PG8_SCHED; PG8_LDA(At, 1, 0); PG8_STAGE(PG8_SA(0, 1), a2 + hstep, voffA);
            PG8_WAIT_V(8); PG8_WAIT_L(0); PG8_BAR; PG8_MMA(0, 0, At, B0); PG8_MMA(0, 1, At, B1); PG8_BAR; PG8_SCHED;
            PG8_LDA(At, 1, 1); PG8_STAGE(PG8_SB(1, 0), b3, voffB); PG8_STAGE(PG8_SB(1, 1), b3 + hstep, voffB); PG8_STAGE(PG8_SA(1, 0), a3, voffA);
            PG8_WAIT_V(8); PG8_WAIT_L(0); PG8_BAR; PG8_MMA(1, 0, At, B0); PG8_MMA(1, 1, At, B1); PG8_BAR; PG8_SCHED;
            } else {
            PG8_LDB(B0, 0, 0); PG8_SCHED; PG8_LDA(At, 0, 0); PG8_STAGE(PG8_SA(1, 1), a1 + hstep, voffA);
            PG8_WAIT_L(8); PG8_BAR; PG8_WAIT_L(0); PG8_MMA(0, 0, At, B0); PG8_BAR; PG8_SCHED;
            PG8_LDB(B1, 0, 1); PG8_STAGE(PG8_SB(0, 0), b2, voffB);
            PG8_BAR; PG8_WAIT_L(0); PG8_MMA(0, 1, At, B1); PG8_BAR;
            PG8_LDA(At, 0, 1); PG8_STAGE(PG8_SA(0, 0), a2, voffA);
            PG8_BAR; PG8_WAIT_L(0); PG8_MMA(1, 0, At, B0); PG8_BAR; PG8_SCHED;
            PG8_STAGE(PG8_SB(0, 1), b2 + hstep, voffB);
            PG8_WAIT_V(6); PG8_BAR; PG8_MMA(1, 1, At, B1); PG8_BAR;
            PG8_LDB(B0, 1, 0); PG8_SCHED; PG8_LDA(At, 1, 0); PG8_STAGE(PG8_SA(0, 1), a2 + hstep, voffA);
            PG8_WAIT_L(8); PG8_BAR; PG8_WAIT_L(0); PG8_MMA(0, 0, At, B0); PG8_BAR; PG8_SCHED;
            PG8_LDB(B1, 1, 1); PG8_STAGE(PG8_SB(1, 0), b3, voffB);
            PG8_BAR; PG8_WAIT_L(0); PG8_MMA(0, 1, At, B1); PG8_BAR;
            PG8_LDA(At, 1, 1); PG8_STAGE(PG8_SA(1, 0), a3, voffA);
            PG8_BAR; PG8_WAIT_L(0); PG8_MMA(1, 0, At, B0); PG8_BAR; PG8_SCHED;
            PG8_STAGE(PG8_SB(1, 1), b3 + hstep, voffB);
            PG8_WAIT_V(6); PG8_BAR; PG8_MMA(1, 1, At, B1); PG8_BAR;
            }
        }
        if constexpr (ALIGN_EPI) { if (wr == 0) PG8_BAR; }
        if constexpr (!Epi::AFTER_DRAIN) { E(acc, cur, wr, wc, fr, fq); S.done(cur); }
        if (!has_next) break;
#pragma unroll
        for (int a = 0; a < 2; ++a)
#pragma unroll
            for (int b = 0; b < 2; ++b)
#pragma unroll
                for (int m = 0; m < 4; ++m)
#pragma unroll
                    for (int n = 0; n < 2; ++n) acc[a][b][m][n] = (f32x4){0.f, 0.f, 0.f, 0.f};
        cur = nxt; cA = nA; cB = nB; ++ui;
        if constexpr (ALIGN_EPI) { if (wr == 1) PG8_BAR; }
    }
    PG8_WAIT_V(0);
    if constexpr (!ALIGN_EPI) { if (wr == 0) PG8_BAR; }
    PG8_BAR;
    if constexpr (Epi::AFTER_DRAIN) { E.fused(acc, cur, wr, wc, fr, fq, lds, wid, lane); S.done(cur); }
#undef PG8_SA
#undef PG8_SB
#undef PG8_STAGE
#undef PG8_LDA
#undef PG8_LDB
#undef PG8_MMA
#undef PG8_WAIT_V
#undef PG8_WAIT_L
#undef PG8_BAR
#undef PG8_SCHED
}
}

#define GAS __attribute__((address_space(1)))
#define LAS __attribute__((address_space(3)))
typedef unsigned short bf16;
typedef unsigned v4u __attribute__((ext_vector_type(4)));
typedef unsigned v2u __attribute__((ext_vector_type(2)));
typedef float f32x4 __attribute__((ext_vector_type(4)));
typedef float f32x2 __attribute__((ext_vector_type(2)));
typedef short bf16x8 __attribute__((ext_vector_type(8)));

constexpr int NWAVES = 8, NTHR = 512;
constexpr int DM = 1024, NBP = 8, SEQ = 2048, NBS = 32, TS = 8;
constexpr int MP = NBP * SEQ, MS = NBS * TS, MT = MP + MS;
constexpr int DIN = 10240;
constexpr int C_U = 0, C_V = 1024, C_Z = 2048, C_Q = 3072, C_K = 4608, C_VV = 6144, C_ZB = 7680, C_GA = 8192, C_GB = 9216;
constexpr float EPS = 1e-6f;
constexpr size_t O_Y = 0, O_KVP0 = (size_t)MT * DM, O_KVP1 = O_KVP0 + (size_t)8 * 128 * 1024, O_KVP2 = O_KVP1 + (size_t)8 * 512 * 1024,
                 O_KVS0 = O_KVP2 + (size_t)8 * 2048 * 1024, O_KVS1 = O_KVS0 + 262144, O_KVS2 = O_KVS1 + 262144, O_VCH = O_KVS2 + 262144, O_END = O_VCH + 262144;
constexpr size_t MiB = 1u << 20;
constexpr size_t WS_WIN = 2 * MiB, WS_WPA = 22 * MiB, WS_WPB = 24 * MiB, WS_WOUT = 25 * MiB, WS_MOD = 27 * MiB, WS_VST = 29 * MiB, WS_ML = 32 * MiB,
                 WS_H = 36 * MiB, WS_YA = 70 * MiB, WS_YB = 104 * MiB, WS_MRG = 122 * MiB, WS_O3 = 156 * MiB, WS_PART = 206 * MiB, WS_OUT = 272 * MiB,
                 WS_PROJ = 340 * MiB, WS_END = 672 * MiB;
static_assert(WS_PROJ + (size_t)MT * DIN * 2 <= WS_END, "ws map");
constexpr int LDS_BYTES = 147456;

#define LDS_WAIT() asm volatile("s_waitcnt lgkmcnt(0)" ::: "memory")
__device__ __forceinline__ unsigned f2bf(float f) { unsigned u = __builtin_bit_cast(unsigned, f); return (u + 0x7fffu + ((u >> 16) & 1u)) >> 16; }
__device__ __forceinline__ unsigned pk2(float lo, float hi) { return f2bf(lo) | (f2bf(hi) << 16); }
__device__ __forceinline__ float bflo(unsigned w) { return __builtin_bit_cast(float, w << 16); }
__device__ __forceinline__ float bfhi(unsigned w) { return __builtin_bit_cast(float, w & 0xffff0000u); }
__device__ __forceinline__ float bf2f(bf16 h) { return __builtin_bit_cast(float, (unsigned)h << 16); }
__device__ __forceinline__ float sigm(float x) { return 1.f / (1.f + __expf(-x)); }
__device__ __forceinline__ float silu(float x) { return x / (1.f + __expf(-x)); }
__device__ __forceinline__ float wave_sum(float v) {
#pragma unroll
    for (int o = 1; o < 64; o <<= 1) v += __shfl_xor(v, o);
    return v;
}
__device__ __forceinline__ float wave_max(float v) {
#pragma unroll
    for (int o = 1; o < 64; o <<= 1) v = fmaxf(v, __shfl_xor(v, o));
    return v;
}
__device__ __forceinline__ float rdlane(float v, int l) { return __builtin_bit_cast(float, __builtin_amdgcn_readlane(__builtin_bit_cast(int, v), l)); }

#define XB_TMO      128
#define XB_XCNT(j)  (256  + 64 * (j))
#define XB_XSUB(j)  (1280 + 64 * (j))
#define XB_XGEN(j)  (2304 + 64 * (j))
#define XB_TOP      3328
#define XB_TOPGEN   3392
#define XCD_BAR_WORDS 3456
#define XB_SPIN_CAP (1u << 18)

__device__ __forceinline__ unsigned xb_ld(unsigned* p)              { return __hip_atomic_load(p, __ATOMIC_RELAXED, __HIP_MEMORY_SCOPE_AGENT); }
__device__ __forceinline__ unsigned xb_add(unsigned* p, unsigned v) { return __hip_atomic_fetch_add(p, v, __ATOMIC_RELAXED, __HIP_MEMORY_SCOPE_AGENT); }
__device__ __forceinline__ unsigned xb_xcc_id() { return (unsigned)__builtin_amdgcn_s_getreg((3 << 11) | 20) & 0xFu; }
#define XB_SPIN(cond, bar) do { unsigned _sp = 0; while (cond) { __builtin_amdgcn_s_sleep(1); \
    if ((++_sp & 255u) == 0u) { if (xb_ld(&(bar)[XB_TMO])) break; if (_sp > XB_SPIN_CAP) { atomicAdd(&(bar)[XB_TMO], 1u); break; } } } } while (0)

struct XcdBarrier {
    unsigned* bar; unsigned x;
    volatile LAS unsigned* st;
};

__device__ __forceinline__ XcdBarrier xcd_barrier_post(unsigned* bar, volatile LAS unsigned* st) {
    XcdBarrier b; b.bar = bar; b.x = xb_xcc_id(); b.st = st;
    if (threadIdx.x == 0) (void)xb_add(&bar[XB_XCNT(b.x)], 1u);
    return b;
}
__device__ __forceinline__ void xcd_barrier_complete(unsigned* bar, unsigned x, unsigned& nloc, unsigned& nx) {
    const unsigned G = gridDim.x * gridDim.y * gridDim.z;
    unsigned sum, cnt, mine, sp = 0u;
    for (;;) {
        sum = 0u; cnt = 0u; mine = 0u;
#pragma unroll
        for (unsigned j = 0; j < 16; ++j) { const unsigned c = xb_ld(&bar[XB_XCNT(j)]); sum += c; cnt += (c > 0u) ? 1u : 0u; mine = (j == x) ? c : mine; }
        if (sum == G) break;
        __builtin_amdgcn_s_sleep(1);
        if ((++sp & 255u) == 0u) { if (xb_ld(&bar[XB_TMO])) break; if (sp > XB_SPIN_CAP) { atomicAdd(&bar[XB_TMO], 1u); break; } }
    }
    nloc = mine > 0u ? mine : 1u; nx = cnt > 0u ? cnt : 1u;
}

__device__ __forceinline__ void xcd_barrier(const XcdBarrier& b) {
    asm volatile("s_waitcnt vmcnt(0)" ::: "memory");
    __syncthreads();
    if (threadIdx.x == 0) {
        unsigned* bar = b.bar;
        __builtin_amdgcn_s_waitcnt(0);
        unsigned nloc = b.st[0], nx = b.st[1];
        if (nloc == 0u) { xcd_barrier_complete(bar, b.x, nloc, nx); b.st[0] = nloc; b.st[1] = nx; }
        const unsigned old = xb_add(&bar[XB_XSUB(b.x)], 1u);
        const unsigned gen = old / nloc;
        if (old + 1u == (gen + 1u) * nloc) {
            __builtin_amdgcn_fence(__ATOMIC_RELEASE, "agent");
            asm volatile("s_waitcnt vmcnt(0)" ::: "memory");
            const unsigned og = xb_add(&bar[XB_TOP], 1u);
            const unsigned tg = og / nx;
            if (og + 1u == (tg + 1u) * nx) xb_add(&bar[XB_TOPGEN], 1u);
            else XB_SPIN(xb_ld(&bar[XB_TOPGEN]) == tg, bar);
            __builtin_amdgcn_fence(__ATOMIC_ACQUIRE, "agent");
            xb_add(&bar[XB_XGEN(b.x)], 1u);
            asm volatile("s_waitcnt vmcnt(0)" ::: "memory");
        } else {
            XB_SPIN(xb_ld(&bar[XB_XGEN(b.x)]) == gen, bar);
            __builtin_amdgcn_fence(__ATOMIC_ACQUIRE, "agent");
            asm volatile("s_waitcnt vmcnt(0)" ::: "memory");
        }
    }
    __syncthreads();
}

namespace pg8 {
struct EpiProj {
    static constexpr bool PERM = true, AFTER_DRAIN = false;
    bf16_t* P; float* out; float* vst;
    __device__ __forceinline__ void operator()(const f32x4 (&acc)[2][2][4][2], const Unit& u, int wr, int wc, int fr, int fq) const {
        const int row0 = u.pm * BM + wr * 64 + fr;
        const int colt = u.pn * BM + wc * 32 + 8 * fq;
#pragma unroll
        for (int ai = 0; ai < 2; ++ai)
#pragma unroll
            for (int m = 0; m < 4; ++m) { bf16_t* rowp = P + (size_t)(row0 + ai * HALF + m * 16) * DIN + colt;
#pragma unroll
                for (int bj = 0; bj < 2; ++bj) { const f32x4 v0 = acc[ai][bj][m][0], v1 = acc[ai][bj][m][1];
                    u32x4 w; w.x = cvt_pk_bf16(v0[0], v0[1]); w.y = cvt_pk_bf16(v0[2], v0[3]); w.z = cvt_pk_bf16(v1[0], v1[1]); w.w = cvt_pk_bf16(v1[2], v1[3]);
                    *(u32x4*)(rowp + bj * HALF) = w; } }
        if (u.pn >= 4 && u.pn < 8) {
#pragma unroll
            for (int ai = 0; ai < 2; ++ai)
#pragma unroll
                for (int m = 0; m < 4; ++m) { float s = 0.f, q = 0.f;
#pragma unroll
                    for (int bj = 0; bj < 2; ++bj)
#pragma unroll
                        for (int n = 0; n < 2; ++n) { const f32x4 x = acc[ai][bj][m][n]; s += (x[0] + x[1]) + (x[2] + x[3]); q += (x[0] * x[0] + x[1] * x[1]) + (x[2] * x[2] + x[3] * x[3]); }
                    s += __shfl_xor(s, 16); s += __shfl_xor(s, 32); q += __shfl_xor(q, 16); q += __shfl_xor(q, 32);
                    if (fq == 0) { float* d = vst + ((size_t)(row0 + ai * HALF + m * 16) * 16 + (u.pn - 4) * 4 + wc) * 2; *(f32x2*)d = (f32x2){s, q}; } }
        }
        if (u.pn >= 18 && u.pn < 30) {
            const int kv = u.pn >= 24 ? 1 : 0; const int t = u.pn - 18 - 6 * kv; const int g = t >> 1, half = t & 1;
            const int dcol = kv * 512 + half * 256 + wc * 32 + 8 * fq;
            const int R = g == 0 ? 128 : (g == 1 ? 512 : 2048);
            const size_t obp = g == 0 ? O_KVP0 : (g == 1 ? O_KVP1 : O_KVP2), obs = g == 0 ? O_KVS0 : (g == 1 ? O_KVS1 : O_KVS2);
#pragma unroll
            for (int ai = 0; ai < 2; ++ai)
#pragma unroll
                for (int m = 0; m < 4; ++m) { const int row = row0 + ai * HALF + m * 16; float* base = nullptr;
                    if (row < MP) { const int b = row >> 11, s = row & 2047, r = s - (2048 - R); if (r >= 0) base = out + obp + (size_t)(b * R + r) * 1024 + dcol; }
                    else base = out + obs + (size_t)(row - MP) * 1024 + dcol;
                    if (base) {
#pragma unroll
                        for (int bj = 0; bj < 2; ++bj)
#pragma unroll
                            for (int n = 0; n < 2; ++n) *(f32x4*)(base + bj * HALF + 4 * n) = acc[ai][bj][m][n]; } }
        }
    }
};
struct EpiGateA {
    static constexpr bool PERM = true, AFTER_DRAIN = false;
    const bf16_t* P; float* part;
    __device__ __forceinline__ void operator()(const f32x4 (&acc)[2][2][4][2], const Unit& u, int wr, int wc, int fr, int fq) const {
        const int row0 = u.pm * BM + wr * 64 + fr; const int colt = u.pn * BM + wc * 32 + 8 * fq;
#pragma unroll
        for (int ai = 0; ai < 2; ++ai)
#pragma unroll
            for (int m = 0; m < 4; ++m) { const size_t row = (size_t)(row0 + ai * HALF + m * 16); const bf16_t* gp = P + row * DIN + C_GA + colt; float* pp = part + row * DM + colt;
#pragma unroll
                for (int bj = 0; bj < 2; ++bj) { const u32x4 gw = *(const u32x4*)(gp + bj * HALF); const f32x4 a0 = acc[ai][bj][m][0], a1 = acc[ai][bj][m][1];
                    f32x4 o0, o1; o0[0] = a0[0] * sigm(bflo(gw.x)); o0[1] = a0[1] * sigm(bfhi(gw.x)); o0[2] = a0[2] * sigm(bflo(gw.y)); o0[3] = a0[3] * sigm(bfhi(gw.y));
                    o1[0] = a1[0] * sigm(bflo(gw.z)); o1[1] = a1[1] * sigm(bfhi(gw.z)); o1[2] = a1[2] * sigm(bflo(gw.w)); o1[3] = a1[3] * sigm(bfhi(gw.w));
                    *(f32x4*)(pp + bj * HALF) = o0; *(f32x4*)(pp + bj * HALF + 4) = o1; } }
    }
};
struct EpiGateB {
    static constexpr bool PERM = true, AFTER_DRAIN = false;
    const bf16_t* P; const float* part; bf16_t* mrg;
    __device__ __forceinline__ void operator()(const f32x4 (&acc)[2][2][4][2], const Unit& u, int wr, int wc, int fr, int fq) const {
        const int row0 = u.pm * BM + wr * 64 + fr; const int colt = u.pn * BM + wc * 32 + 8 * fq;
#pragma unroll
        for (int ai = 0; ai < 2; ++ai)
#pragma unroll
            for (int m = 0; m < 4; ++m) { const size_t row = (size_t)(row0 + ai * HALF + m * 16); const bf16_t* gp = P + row * DIN + C_GB + colt; const float* pp = part + row * DM + colt;
#pragma unroll
                for (int bj = 0; bj < 2; ++bj) { const u32x4 gw = *(const u32x4*)(gp + bj * HALF); const f32x4 a0 = acc[ai][bj][m][0], a1 = acc[ai][bj][m][1];
                    const f32x4 p0 = *(const f32x4*)(pp + bj * HALF), p1 = *(const f32x4*)(pp + bj * HALF + 4);
                    f32x4 o0, o1; o0[0] = p0[0] + a0[0] * sigm(bflo(gw.x)); o0[1] = p0[1] + a0[1] * sigm(bfhi(gw.x)); o0[2] = p0[2] + a0[2] * sigm(bflo(gw.y)); o0[3] = p0[3] + a0[3] * sigm(bfhi(gw.y));
                    o1[0] = p1[0] + a1[0] * sigm(bflo(gw.z)); o1[1] = p1[1] + a1[1] * sigm(bfhi(gw.z)); o1[2] = p1[2] + a1[2] * sigm(bflo(gw.w)); o1[3] = p1[3] + a1[3] * sigm(bfhi(gw.w));
                    u32x4 w; w.x = cvt_pk_bf16(o0[0], o0[1]); w.y = cvt_pk_bf16(o0[2], o0[3]); w.z = cvt_pk_bf16(o1[0], o1[1]); w.w = cvt_pk_bf16(o1[2], o1[3]);
                    *(u32x4*)(mrg + row * DM + colt + bj * HALF) = w; } }
    }
};
struct EpiF32 {
    static constexpr bool PERM = true, AFTER_DRAIN = false;
    float* O;
    __device__ __forceinline__ void operator()(const f32x4 (&acc)[2][2][4][2], const Unit& u, int wr, int wc, int fr, int fq) const {
        const int row0 = u.pm * BM + wr * 64 + fr; const int colt = u.pn * BM + wc * 32 + 8 * fq;
#pragma unroll
        for (int ai = 0; ai < 2; ++ai)
#pragma unroll
            for (int m = 0; m < 4; ++m) { float* pp = O + (size_t)(row0 + ai * HALF + m * 16) * DM + colt;
#pragma unroll
                for (int bj = 0; bj < 2; ++bj) { *(f32x4*)(pp + bj * HALF) = acc[ai][bj][m][0]; *(f32x4*)(pp + bj * HALF + 4) = acc[ai][bj][m][1]; } }
    }
};
}

__device__ __forceinline__ void p0_transpose_item(const float* W, int K, int N, bf16* WT, int row_off, LAS float* scr, int item, int lane) {
    const int nblk = N / 32, kb = item / nblk, nb = item % nblk, k0 = 64 * kb, n0 = 32 * nb;
#pragma unroll 8
    for (int i = 0; i < 32; ++i) { const int kk = 2 * i + (lane >> 5); scr[kk * 33 + (lane & 31)] = W[(size_t)(k0 + kk) * N + n0 + (lane & 31)]; }
    LDS_WAIT(); asm volatile("" ::: "memory");
    const int c = lane & 7;
#pragma unroll
    for (int j = 0; j < 4; ++j) { const int n = (lane >> 3) + 8 * j; const LAS float* s = scr + (8 * c) * 33 + n;
        v4u o; o.x = pk2(s[0 * 33], s[1 * 33]); o.y = pk2(s[2 * 33], s[3 * 33]); o.z = pk2(s[4 * 33], s[5 * 33]); o.w = pk2(s[6 * 33], s[7 * 33]);
        *(GAS v4u*)(WT + (size_t)(row_off + n0 + n) * K + k0 + 8 * c) = o; }
    LDS_WAIT(); asm volatile("" ::: "memory");
}
__device__ __forceinline__ void mod_task(int task, const float* cp, const float* cs, const float* Wc, const float* bc, float* MODP, LAS unsigned char* lds, int tid, int wave, int lane) {
    const int chunk = task >> 2, kq = task & 3;
    const int k0 = kq * 256 + wave * 32;
    float sc[40], acc[40];
#pragma unroll
    for (int r = 0; r < 40; ++r) { const float* crow = (r < 8) ? cp + r * 1024 : cs + (r - 8) * 1024; sc[r] = silu(crow[k0 + (lane & 31)]); acc[r] = 0.f; }
    const float* wp = Wc + (size_t)k0 * 3072 + chunk * 64 + lane;
#pragma unroll 8
    for (int kk = 0; kk < 32; ++kk) { const float wv = wp[(size_t)kk * 3072];
#pragma unroll
        for (int r = 0; r < 40; ++r) acc[r] += rdlane(sc[r], kk) * wv; }
    LAS float* red = (LAS float*)lds;
#pragma unroll
    for (int r = 0; r < 40; ++r) red[(wave * 40 + r) * 64 + lane] = acc[r];
    __syncthreads();
    for (int idx = tid; idx < 2560; idx += NTHR) { const int r = idx >> 6, cl = idx & 63; float s = 0.f;
#pragma unroll
        for (int w = 0; w < 8; ++w) s += red[(w * 40 + r) * 64 + cl];
        if (kq == 0) s += bc[chunk * 64 + cl];
        MODP[((size_t)kq * 40 + r) * 3072 + chunk * 64 + cl] = s; }
    __syncthreads();
}

typedef short s16x4 __attribute__((ext_vector_type(4)));
__device__ __forceinline__ s16x4 lds_tr(const LAS bf16* p) { return __builtin_bit_cast(s16x4, __builtin_amdgcn_ds_read_tr16_b64_v4i16((LAS s16x4*)p)); }
__device__ __forceinline__ void att_decode(int idx, int& g, int& b, int& h, int& d, int& n, int& r) {
    g = idx >> 10; int rem = idx & 1023; b = rem >> 7; rem &= 127; h = rem >> 4; const int sub = rem & 15;
    if (g == 0) { d = 1; n = sub; r = 0; } else if (g == 1) { d = 4; r = sub >> 2; n = sub & 3; } else { d = 16; r = sub; n = 0; }
}
__device__ __forceinline__ void att_prefetch(int idx, const bf16* PROJ, int tid, int wave, int lane, v4u (&kk)[4], v4u (&vv)[4], bf16x8& Q0, bf16x8& Q1) {
    int g, b, h, d, n, r; att_decode(idx, g, b, h, d, n, r);
    const int key = tid >> 1, half = tid & 1; const int m = 128 * (n - 1) + key;
    if (m >= 0) { const size_t row = (size_t)b * 2048 + (size_t)d * m + r; const bf16* src = PROJ + row * DIN + g * 512 + h * 64 + half * 32;
#pragma unroll
        for (int c = 0; c < 4; ++c) { kk[c] = *(const v4u*)(src + C_K + 8 * c); vv[c] = *(const v4u*)(src + C_VV + 8 * c); } }
    else {
#pragma unroll
        for (int c = 0; c < 4; ++c) { kk[c] = (v4u){0u, 0u, 0u, 0u}; vv[c] = (v4u){0u, 0u, 0u, 0u}; } }
    const int fr = lane & 15, fq = lane >> 4; const int i = 16 * wave + fr;
    const size_t rowq = (size_t)b * 2048 + (size_t)d * (128 * n + i) + r;
    const bf16* qsrc = PROJ + rowq * DIN + C_Q + g * 512 + h * 64 + 8 * fq;
    Q0 = *(const bf16x8*)qsrc; Q1 = *(const bf16x8*)(qsrc + 32);
}
__device__ __forceinline__ void att_compute(int idx, bf16* O3, float* ML, LAS unsigned char* lds, int wave, int lane, const bf16x8 Q0, const bf16x8 Q1) {
    int g, b, h, d, n, r; att_decode(idx, g, b, h, d, n, r);
    const LAS bf16* Ks = (const LAS bf16*)lds;
    const LAS bf16* Vs = (const LAS bf16*)(lds + 36864);
    const int fr = lane & 15, fq = lane >> 4;
    const int i = 16 * wave + fr;
    const size_t rowq = (size_t)b * 2048 + (size_t)d * (128 * n + i) + r;
    const int start = wave & ~1; const int lo = (n == 0) ? 8 : start;
    f32x4 S[10]; float mx = -1e30f;
#pragma unroll
    for (int p = 0; p < 10; ++p) { const int tile = start + p;
        if (tile >= lo) {
            const LAS bf16* kp = Ks + (tile * 16 + fr) * 72 + 8 * fq;
            const bf16x8 K0 = *(const LAS bf16x8*)kp, K1 = *(const LAS bf16x8*)(kp + 32);
            f32x4 s = (f32x4){0.f, 0.f, 0.f, 0.f};
            s = __builtin_amdgcn_mfma_f32_16x16x32_bf16(K0, Q0, s, 0, 0, 0); s = __builtin_amdgcn_mfma_f32_16x16x32_bf16(K1, Q1, s, 0, 0, 0);
#pragma unroll
            for (int e = 0; e < 4; ++e) { const int j = tile * 16 + 4 * fq + e; const bool valid = (j >= i) && (j <= i + 128); s[e] = valid ? s[e] * 0.125f : -1e30f; mx = fmaxf(mx, s[e]); }
            S[p] = s;
        } else S[p] = (f32x4){-1e30f, -1e30f, -1e30f, -1e30f};
    }
    mx = fmaxf(mx, __shfl_xor(mx, 16)); mx = fmaxf(mx, __shfl_xor(mx, 32));
    float l = 0.f;
#pragma unroll
    for (int p = 0; p < 10; ++p)
#pragma unroll
        for (int e = 0; e < 4; ++e) { const float ex = __expf(S[p][e] - mx); S[p][e] = ex; l += ex; }
    l += __shfl_xor(l, 16); l += __shfl_xor(l, 32);
    f32x4 O[4];
#pragma unroll
    for (int dt = 0; dt < 4; ++dt) O[dt] = (f32x4){0.f, 0.f, 0.f, 0.f};
#pragma unroll
    for (int pp = 0; pp < 5; ++pp) {
        if (start + 2 * pp >= lo) {
            v4u pw; pw.x = pk2(S[2 * pp][0], S[2 * pp][1]); pw.y = pk2(S[2 * pp][2], S[2 * pp][3]); pw.z = pk2(S[2 * pp + 1][0], S[2 * pp + 1][1]); pw.w = pk2(S[2 * pp + 1][2], S[2 * pp + 1][3]);
            const bf16x8 Pf = __builtin_bit_cast(bf16x8, pw);
            const LAS bf16* vbase = Vs + ((start + 2 * pp) * 16 + 4 * fq + (fr >> 2)) * 72 + 4 * (fr & 3);
#pragma unroll
            for (int dt = 0; dt < 4; ++dt) { const s16x4 va = lds_tr(vbase + 16 * dt), vb = lds_tr(vbase + 16 * 72 + 16 * dt);
                const bf16x8 Vf = (bf16x8){va[0], va[1], va[2], va[3], vb[0], vb[1], vb[2], vb[3]};
                O[dt] = __builtin_amdgcn_mfma_f32_16x16x32_bf16(Vf, Pf, O[dt], 0, 0, 0); }
        }
    }
    const float inv = 1.f / l;
    bf16* op = O3 + ((size_t)g * MT + rowq) * 512 + h * 64 + 4 * fq;
#pragma unroll
    for (int dt = 0; dt < 4; ++dt) { v2u w; w.x = pk2(O[dt][0] * inv, O[dt][1] * inv); w.y = pk2(O[dt][2] * inv, O[dt][3] * inv); *(v2u*)(op + 16 * dt) = w; }
    if (fq == 0) { float* mp = ML + (((size_t)g * MT + rowq) * 8 + h) * 2; *(f32x2*)mp = (f32x2){mx, l}; }
}

__device__ __forceinline__ void gmlp_item(int idx, const bf16* PROJ, const float* VST, const float* Wsp, const float* bsp, const float* lng, const float* lnb, bf16* YA,
                                          LAS unsigned char* lds, int tid, int wave, int lane) {
    const int ci = idx >> 3, g = idx & 7; const int row0 = ci * 128;
    LAS bf16* VN = (LAS bf16*)lds;
    LAS bf16* WS = (LAS bf16*)(lds + 34816);
    const int s = tid >> 2, cp = tid & 3;
    const int fr = lane & 15, fq = lane >> 4;
    const int t = 16 * wave + fr;
    const f32x4 st0 = ((const f32x4*)(VST + (size_t)(row0 + s) * 32))[2 * cp], st1 = ((const f32x4*)(VST + (size_t)(row0 + s) * 32))[2 * cp + 1];
    const bf16* vp = PROJ + (size_t)(row0 + s) * DIN + C_V + g * 128 + cp * 32;
    v4u vraw[4];
#pragma unroll
    for (int c = 0; c < 4; ++c) vraw[c] = *(const v4u*)(vp + 8 * c);
    const float* wp = Wsp + ((size_t)g * 128 + s) * 128 + cp * 32;
    f32x4 wv[8];
#pragma unroll
    for (int c = 0; c < 8; ++c) wv[c] = ((const f32x4*)wp)[c];
    const size_t rowt = (size_t)row0 + t;
    const bf16* up = PROJ + rowt * DIN + g * 128 + 4 * fq;
    v2u uu[8], zz[8];
#pragma unroll
    for (int ct = 0; ct < 8; ++ct) { uu[ct] = *(const v2u*)(up + C_U + 16 * ct); zz[ct] = *(const v2u*)(up + C_Z + 16 * ct); }
    const float bs = bsp[g * 128 + t];
    float sm = (st0[0] + st0[2]) + (st1[0] + st1[2]), sq = (st0[1] + st0[3]) + (st1[1] + st1[3]);
    sm += __shfl_xor(sm, 1); sm += __shfl_xor(sm, 2); sq += __shfl_xor(sq, 1); sq += __shfl_xor(sq, 2);
    const float mu = sm * (1.f / 1024.f); const float rstd = rsqrtf(sq * (1.f / 1024.f) - mu * mu + EPS);
#pragma unroll
    for (int c = 0; c < 4; ++c) { const f32x4 a = wv[2 * c], b2 = wv[2 * c + 1]; const int s0 = cp * 32 + 8 * c;
        float v[8] = {a[0], a[1], a[2], a[3], b2[0], b2[1], b2[2], b2[3]};
#pragma unroll
        for (int e = 0; e < 8; ++e) v[e] = (s0 + e <= s) ? v[e] : 0.f;
        v4u w; w.x = pk2(v[0], v[1]); w.y = pk2(v[2], v[3]); w.z = pk2(v[4], v[5]); w.w = pk2(v[6], v[7]);
        *(LAS v4u*)(WS + s * 136 + s0) = w; }
#pragma unroll
    for (int c = 0; c < 4; ++c) { const v4u raw = vraw[c]; const int ch = g * 128 + cp * 32 + 8 * c;
        const f32x4 g0 = *(const f32x4*)(lng + ch), g1 = *(const f32x4*)(lng + ch + 4), b0 = *(const f32x4*)(lnb + ch), b1 = *(const f32x4*)(lnb + ch + 4);
        v4u w;
        w.x = pk2((bflo(raw.x) - mu) * rstd * g0[0] + b0[0], (bfhi(raw.x) - mu) * rstd * g0[1] + b0[1]);
        w.y = pk2((bflo(raw.y) - mu) * rstd * g0[2] + b0[2], (bfhi(raw.y) - mu) * rstd * g0[3] + b0[3]);
        w.z = pk2((bflo(raw.z) - mu) * rstd * g1[0] + b1[0], (bfhi(raw.z) - mu) * rstd * g1[1] + b1[1]);
        w.w = pk2((bflo(raw.w) - mu) * rstd * g1[2] + b1[2], (bfhi(raw.w) - mu) * rstd * g1[3] + b1[3]);
        *(LAS v4u*)(VN + s * 136 + cp * 32 + 8 * c) = w; }
    __syncthreads();
    const int nks = (wave >> 1) + 1;
    f32x4 acc[8];
#pragma unroll
    for (int ct = 0; ct < 8; ++ct) acc[ct] = (f32x4){0.f, 0.f, 0.f, 0.f};
#pragma unroll
    for (int ks = 0; ks < 4; ++ks) {
        if (ks < nks) { const bf16x8 Wf = *(const LAS bf16x8*)(WS + t * 136 + 32 * ks + 8 * fq);
            const LAS bf16* vb = VN + (32 * ks + 8 * fq + (fr >> 2)) * 136 + 4 * (fr & 3);
#pragma unroll
            for (int ct = 0; ct < 8; ++ct) { const s16x4 va = lds_tr(vb + 16 * ct), vb2 = lds_tr(vb + 4 * 136 + 16 * ct);
                const bf16x8 Vf = (bf16x8){va[0], va[1], va[2], va[3], vb2[0], vb2[1], vb2[2], vb2[3]};
                acc[ct] = __builtin_amdgcn_mfma_f32_16x16x32_bf16(Vf, Wf, acc[ct], 0, 0, 0); } }
    }
    bf16* yp = YA + rowt * DM + g * 128 + 4 * fq;
#pragma unroll
    for (int ct = 0; ct < 8; ++ct) {
        const float y0 = bflo(uu[ct].x) * (acc[ct][0] + bs) * silu(bflo(zz[ct].x)), y1 = bfhi(uu[ct].x) * (acc[ct][1] + bs) * silu(bfhi(zz[ct].x));
        const float y2 = bflo(uu[ct].y) * (acc[ct][2] + bs) * silu(bflo(zz[ct].y)), y3 = bfhi(uu[ct].y) * (acc[ct][3] + bs) * silu(bfhi(zz[ct].y));
        v2u w; w.x = pk2(y0, y1); w.y = pk2(y2, y3); *(v2u*)(yp + 16 * ct) = w; }
    __syncthreads();
}

__device__ __forceinline__ void gmlp_sample_item(int b, const bf16* PROJ, const float* VST, const float* Wsp, const float* bsp, const float* lng, const float* lnb, bf16* YA, float* out,
                                                 LAS unsigned char* lds, int tid, int wave, int lane) {
    const int r0 = MP + b * 8;
    LAS float* st = (LAS float*)lds;
    if (tid < 8) { const float* p = VST + (size_t)(r0 + tid) * 32; float s = 0.f, q = 0.f;
#pragma unroll
        for (int k = 0; k < 8; ++k) { const f32x4 a = ((const f32x4*)p)[k]; s += a[0] + a[2]; q += a[1] + a[3]; }
        const float mu = s * (1.f / 1024.f); const float var = q * (1.f / 1024.f) - mu * mu; st[2 * tid] = mu; st[2 * tid + 1] = rsqrtf(var + EPS); }
    __syncthreads();
    const int ch = 2 * tid, g = wave;
    const float lg0 = lng[ch], lg1 = lng[ch + 1], lb0 = lnb[ch], lb1 = lnb[ch + 1];
    float vn0[8], vn1[8];
#pragma unroll
    for (int s = 0; s < 8; ++s) { const unsigned raw = *(const unsigned*)(PROJ + (size_t)(r0 + s) * DIN + C_V + ch); const float mu = st[2 * s], rstd = st[2 * s + 1];
        vn0[s] = (bflo(raw) - mu) * rstd * lg0 + lb0; vn1[s] = (bfhi(raw) - mu) * rstd * lg1 + lb1;
        *(f32x2*)(out + O_VCH + (size_t)(b * 8 + s) * 1024 + ch) = (f32x2){vn0[s], vn1[s]}; }
#pragma unroll
    for (int t = 0; t < 8; ++t) { float z0 = bsp[g * 128 + t], z1 = z0;
#pragma unroll
        for (int s = 0; s < 8; ++s) if (s <= t) { const float w = Wsp[((size_t)g * 128 + t) * 128 + s]; z0 += w * vn0[s]; z1 += w * vn1[s]; }
        const unsigned uu = *(const unsigned*)(PROJ + (size_t)(r0 + t) * DIN + C_U + ch), zz = *(const unsigned*)(PROJ + (size_t)(r0 + t) * DIN + C_Z + ch);
        *(unsigned*)(YA + (size_t)(r0 + t) * DM + ch) = pk2(bflo(uu) * z0 * silu(bflo(zz)), bfhi(uu) * z1 * silu(bfhi(zz))); }
    __syncthreads();
}

__device__ __forceinline__ f32x4 sa_load(const bf16* PROJ, const float* cache, int b, int lw, int ix, int pcol, int ccol, bool maybe_new) {
    if (maybe_new && ix >= lw) { const v2u raw = *(const v2u*)(PROJ + (size_t)(MP + b * 8 + ix - lw) * DIN + pcol); return (f32x4){bflo(raw.x), bfhi(raw.x), bflo(raw.y), bfhi(raw.y)}; }
    const int ic = ix < lw ? ix : lw - 1;
    return *(const f32x4*)(cache + (size_t)ic * 1024 + ccol);
}
__device__ __forceinline__ void attn_sample_item(int idx, const bf16* PROJ, const float* c128, const float* c512, const float* c2048, bf16* O3, float* ML, int wave, int lane) {
    const int b = idx / 24; const int rem = idx - b * 24; const int g = rem >> 3, t = rem & 7; const int h = wave;
    const int lw = g == 0 ? 128 : (g == 1 ? 512 : 2048), d = g == 0 ? 1 : (g == 1 ? 4 : 16);
    const float* cache = (g == 0 ? c128 : (g == 1 ? c512 : c2048)) + (size_t)b * lw * 1024;
    const size_t rq = (size_t)MP + b * 8 + t;
    const int ks = lane >> 4, dq = lane & 15;
    const int hc = g * 512 + h * 64 + 4 * dq;
    const v2u qraw = *(const v2u*)(PROJ + rq * DIN + C_Q + hc);
    const float q0 = bflo(qraw.x) * 0.125f, q1 = bfhi(qraw.x) * 0.125f, q2 = bflo(qraw.y) * 0.125f, q3 = bfhi(qraw.y) * 0.125f;
    const float* kbase = cache + h * 64;
    const unsigned lo4 = 4u * (unsigned)dq;
    constexpr int NVA = 8;
    const int ixb = lw + t - d * ks;
    f32x4 kk[33], va[NVA];
#pragma unroll
    for (int it = 0; it < 33; ++it) { int ix = (it < 32 || ks == 0) ? ixb - 4 * d * it : lw + t - 128 * d; ix = ix < lw ? ix : lw - 1; kk[it] = *(const f32x4*)(kbase + ((unsigned)ix * 1024u + lo4)); }
#pragma unroll
    for (int it = 0; it < NVA; ++it) { int ix = ixb - 4 * d * it; ix = ix < lw ? ix : lw - 1; va[it] = *(const f32x4*)(kbase + ((unsigned)ix * 1024u + 512u + lo4)); }
#pragma unroll
    for (int it = 0; it < 2; ++it) { const int ix = ixb - 4 * d * it;
        if (ix >= lw) { const bf16* pr = PROJ + (size_t)(MP + b * 8 + ix - lw) * DIN + hc; const v2u rk = *(const v2u*)(pr + C_K), rv = *(const v2u*)(pr + C_VV);
            kk[it] = (f32x4){bflo(rk.x), bfhi(rk.x), bflo(rk.y), bfhi(rk.y)}; va[it] = (f32x4){bflo(rv.x), bfhi(rv.x), bflo(rv.y), bfhi(rv.y)}; } }
    float s[33]; float mx = -1e30f;
#pragma unroll
    for (int it = 0; it < 33; ++it) {
        float a = (kk[it][0] * q0 + kk[it][1] * q1) + (kk[it][2] * q2 + kk[it][3] * q3);
        a += __shfl_xor(a, 1); a += __shfl_xor(a, 2); a += __shfl_xor(a, 4); a += __shfl_xor(a, 8);
        s[it] = ((it < 32) || (ks == 0)) ? a : -1e30f; mx = fmaxf(mx, s[it]);
    }
    __builtin_amdgcn_sched_barrier(0);
    f32x4 vb[33 - NVA];
#pragma unroll
    for (int it = NVA; it < 33; ++it) { int ix = (it < 32 || ks == 0) ? ixb - 4 * d * it : lw + t - 128 * d; vb[it - NVA] = *(const f32x4*)(kbase + ((unsigned)ix * 1024u + 512u + lo4)); }
    mx = fmaxf(mx, __shfl_xor(mx, 16)); mx = fmaxf(mx, __shfl_xor(mx, 32));
    float l = 0.f;
#pragma unroll
    for (int it = 0; it < 33; ++it) { s[it] = __expf(s[it] - mx); l += s[it]; }
    l += __shfl_xor(l, 16); l += __shfl_xor(l, 32);
    f32x4 o = (f32x4){0.f, 0.f, 0.f, 0.f};
#pragma unroll
    for (int it = 0; it < NVA; ++it) o += va[it] * s[it];
#pragma unroll
    for (int it = NVA; it < 33; ++it) o += vb[it - NVA] * s[it];
#pragma unroll
    for (int e = 0; e < 4; ++e) { o[e] += __shfl_xor(o[e], 16); o[e] += __shfl_xor(o[e], 32); }
    const float inv = 1.f / l;
    if (ks == 0) { v2u w; w.x = pk2(o[0] * inv, o[1] * inv); w.y = pk2(o[2] * inv, o[3] * inv); *(v2u*)(O3 + ((size_t)g * MT + rq) * 512 + h * 64 + 4 * dq) = w; }
    if (lane == 0) { float* mp = ML + (((size_t)g * MT + rq) * 8 + h) * 2; mp[0] = mx; mp[1] = l; }
}

template <int MW, int NT>
__device__ __forceinline__ void sg_mma(f32x4 (&acc)[MW][NT], const bf16* A, const bf16* Bt, int K, int lane) {
    const int fr = lane & 15, fq = lane >> 4;
    const bf16* ap = A + (size_t)fr * K + 8 * fq; const bf16* bp = Bt + (size_t)fr * K + 8 * fq;
    constexpr int UNR = (MW * NT == 1) ? 16 : 4;
#pragma unroll UNR
    for (int ks = 0; ks < K / 32; ++ks) {
        bf16x8 a[MW], b[NT];
#pragma unroll
        for (int mi = 0; mi < MW; ++mi) a[mi] = *(const bf16x8*)(ap + (size_t)mi * 16 * K + 32 * ks);
#pragma unroll
        for (int ni = 0; ni < NT; ++ni) b[ni] = *(const bf16x8*)(bp + (size_t)ni * 16 * K + 32 * ks);
#pragma unroll
        for (int mi = 0; mi < MW; ++mi)
#pragma unroll
            for (int ni = 0; ni < NT; ++ni) acc[mi][ni] = __builtin_amdgcn_mfma_f32_16x16x32_bf16(b[ni], a[mi], acc[mi][ni], 0, 0, 0);
    }
}
__device__ __forceinline__ void sg_proj_task(int ts, const bf16* H, const bf16* WIN_T, bf16* PROJ, float* out, float* VST, int wave, int lane) {
    const int fr = lane & 15, fq = lane >> 4; const int n0 = 64 * ts; const int r0 = MP + 32 * wave;
    f32x4 acc[2][4];
#pragma unroll
    for (int mi = 0; mi < 2; ++mi)
#pragma unroll
        for (int ni = 0; ni < 4; ++ni) acc[mi][ni] = (f32x4){0.f, 0.f, 0.f, 0.f};
    sg_mma<2, 4>(acc, H + (size_t)r0 * DM, WIN_T + (size_t)n0 * DM, DM, lane);
#pragma unroll
    for (int mi = 0; mi < 2; ++mi) { const int row = r0 + 16 * mi + fr;
#pragma unroll
        for (int ni = 0; ni < 4; ++ni) { const int col = n0 + 16 * ni + 4 * fq; const f32x4 v = acc[mi][ni];
            v2u w; w.x = pk2(v[0], v[1]); w.y = pk2(v[2], v[3]); *(v2u*)(PROJ + (size_t)row * DIN + col) = w;
            if (col >= C_K && col < C_ZB) { const int kv = col >= C_VV ? 1 : 0; const int cc = col - (kv ? C_VV : C_K); const int g = cc >> 9, hc = cc & 511;
                const size_t obs = g == 0 ? O_KVS0 : (g == 1 ? O_KVS1 : O_KVS2);
                *(f32x4*)(out + obs + (size_t)(row - MP) * 1024 + kv * 512 + hc) = v; } }
        if (n0 >= C_V && n0 < C_Z) { float s = 0.f, q = 0.f;
#pragma unroll
            for (int ni = 0; ni < 4; ++ni) { const f32x4 x = acc[mi][ni]; s += (x[0] + x[1]) + (x[2] + x[3]); q += (x[0] * x[0] + x[1] * x[1]) + (x[2] * x[2] + x[3] * x[3]); }
            s += __shfl_xor(s, 16); s += __shfl_xor(s, 32); q += __shfl_xor(q, 16); q += __shfl_xor(q, 32);
            if (fq == 0) *(f32x2*)(VST + ((size_t)row * 16 + ((n0 - C_V) >> 6)) * 2) = (f32x2){s, q}; } }
}
__device__ __forceinline__ void sg_merge_task(int ts, const bf16* YA, const bf16* YB, const bf16* WPA_T, const bf16* WPB_T, const bf16* PROJ, bf16* MRG, int wave, int lane) {
    const int fr = lane & 15, fq = lane >> 4; const int n0 = 16 * (ts & 63); const int r0 = MP + 128 * (ts >> 6) + 16 * wave;
    f32x4 aa[1][1], ab[1][1]; aa[0][0] = (f32x4){0.f, 0.f, 0.f, 0.f}; ab[0][0] = (f32x4){0.f, 0.f, 0.f, 0.f};
    sg_mma<1, 1>(aa, YA + (size_t)r0 * DM, WPA_T + (size_t)n0 * DM, DM, lane);
    sg_mma<1, 1>(ab, YB + (size_t)r0 * 512, WPB_T + (size_t)n0 * 512, 512, lane);
    const size_t row = (size_t)r0 + fr; const int col = n0 + 4 * fq;
    const v2u ga = *(const v2u*)(PROJ + row * DIN + C_GA + col), gb = *(const v2u*)(PROJ + row * DIN + C_GB + col);
    const float m0 = aa[0][0][0] * sigm(bflo(ga.x)) + ab[0][0][0] * sigm(bflo(gb.x)), m1 = aa[0][0][1] * sigm(bfhi(ga.x)) + ab[0][0][1] * sigm(bfhi(gb.x));
    const float m2 = aa[0][0][2] * sigm(bflo(ga.y)) + ab[0][0][2] * sigm(bflo(gb.y)), m3 = aa[0][0][3] * sigm(bfhi(ga.y)) + ab[0][0][3] * sigm(bfhi(gb.y));
    v2u w; w.x = pk2(m0, m1); w.y = pk2(m2, m3); *(v2u*)(MRG + row * DM + col) = w;
}
__device__ __forceinline__ void sg_out_task(int ts, const bf16* MRG, const bf16* WOUT_T, float* OUTB, int wave, int lane) {
    const int fr = lane & 15, fq = lane >> 4; const int n0 = 16 * (ts & 63); const int r0 = MP + 128 * (ts >> 6) + 16 * wave;
    f32x4 aa[1][1]; aa[0][0] = (f32x4){0.f, 0.f, 0.f, 0.f};
    sg_mma<1, 1>(aa, MRG + (size_t)r0 * DM, WOUT_T + (size_t)n0 * DM, DM, lane);
    *(f32x4*)(OUTB + ((size_t)r0 + fr) * DM + n0 + 4 * fq) = aa[0][0];
}

struct Args { const float* in[19]; float* out; unsigned char* ws; };
__global__ void __launch_bounds__(NTHR, 2) fwd_kernel(Args args) {
    extern __shared__ __attribute__((aligned(16))) unsigned char lds_raw[];
    cg::grid_group grid = cg::this_grid();
    LAS unsigned char* lds = (LAS unsigned char*)lds_raw;
    const int tid = threadIdx.x, lane = tid & 63, wave = __builtin_amdgcn_readfirstlane(tid >> 6);
    const int G = gridDim.x, bx = blockIdx.x;
    const int gw = bx * NWAVES + wave, NGW = G * NWAVES;
    const float* xp = args.in[0]; const float* xs = args.in[1];
    const float* c128 = args.in[2]; const float* c512 = args.in[3]; const float* c2048 = args.in[4];
    const float* cpr = args.in[5]; const float* csm = args.in[6]; const float* wcond = args.in[7]; const float* bcond = args.in[8]; const float* gpre = args.in[9];
    const float* win = args.in[10]; const float* lng = args.in[11]; const float* lnb = args.in[12]; const float* wsp = args.in[13]; const float* bsp = args.in[14];
    const float* wpa = args.in[15]; const float* wpb = args.in[16]; const float* wout = args.in[17]; const float* gpost = args.in[18];
    float* out = args.out; unsigned char* ws = args.ws;
    bf16* WIN_T = (bf16*)(ws + WS_WIN); bf16* WPA_T = (bf16*)(ws + WS_WPA); bf16* WPB_T = (bf16*)(ws + WS_WPB); bf16* WOUT_T = (bf16*)(ws + WS_WOUT);
    float* MOD = (float*)(ws + WS_MOD); float* VST = (float*)(ws + WS_VST); float* ML = (float*)(ws + WS_ML);
    bf16* H = (bf16*)(ws + WS_H); bf16* YA = (bf16*)(ws + WS_YA); bf16* YB = (bf16*)(ws + WS_YB); bf16* MRG = (bf16*)(ws + WS_MRG); bf16* O3 = (bf16*)(ws + WS_O3);
    float* PART = (float*)(ws + WS_PART); float* OUTB = (float*)(ws + WS_OUT); bf16* PROJ = (bf16*)(ws + WS_PROJ);

    unsigned* barw = (unsigned*)(ws + 16384);
    volatile LAS unsigned* bst = (volatile LAS unsigned*)(lds + 139264);
    if (tid < 2) bst[tid] = 0u;
    __syncthreads();
    const XcdBarrier xbar = xcd_barrier_post(barw, bst);
    if (args.ws == nullptr) grid.sync();
    if (bx < 192) mod_task(bx, cpr, csm, wcond, bcond, MOD, lds, tid, wave, lane);
    {
        LAS float* scr = (LAS float*)(lds + wave * 16384);
        constexpr int I_IN = (1024 / 64) * (DIN / 32), I_PA = (1024 / 64) * (1024 / 32), I_PB = (512 / 64) * (1024 / 32), I_OUT = I_PA;
        constexpr int NITEMS = I_IN + I_PA + I_PB + I_OUT;
        for (int it = gw; it < NITEMS; it += NGW) {
            int r = it;
            if (r < I_IN) { p0_transpose_item(win, 1024, DIN, WIN_T, 0, scr, r, lane); continue; } r -= I_IN;
            if (r < I_PA) { p0_transpose_item(wpa, 1024, 1024, WPA_T, 0, scr, r, lane); continue; } r -= I_PA;
            if (r < I_PB) { p0_transpose_item(wpb, 512, 1024, WPB_T, 0, scr, r, lane); continue; } r -= I_PB;
            p0_transpose_item(wout, 1024, 1024, WOUT_T, 0, scr, r, lane);
        }
    }
    xcd_barrier(xbar);
    for (int rb = gw; rb < MT / 8; rb += NGW) {
        const int rowb = rb * 8;
        const float* mod = MOD + (rowb < MP ? (rowb >> 11) : 8 + ((rowb - MP) >> 3)) * 3072;
        f32x4 gs[4], sh[4];
#pragma unroll
        for (int j = 0; j < 4; ++j) { const int c = 4 * lane + 256 * j; f32x4 a = (f32x4){0.f, 0.f, 0.f, 0.f}, s2 = (f32x4){1.f, 1.f, 1.f, 1.f};
#pragma unroll
            for (int q = 0; q < 4; ++q) { a += *(const f32x4*)(mod + (size_t)q * 40 * 3072 + c); s2 += *(const f32x4*)(mod + (size_t)q * 40 * 3072 + 1024 + c); }
            sh[j] = a; gs[j] = s2 * *(const f32x4*)(gpre + c); }
#pragma unroll 2
        for (int i = 0; i < 8; ++i) { const int row = rowb + i;
            const float* xr = row < MP ? xp + (size_t)row * DM : xs + (size_t)(row - MP) * DM;
            f32x4 v[4]; float ss = 0.f;
#pragma unroll
            for (int j = 0; j < 4; ++j) { v[j] = ((const f32x4*)xr)[lane + 64 * j]; ss += (v[j][0] * v[j][0] + v[j][1] * v[j][1]) + (v[j][2] * v[j][2] + v[j][3] * v[j][3]); }
            const float rstd = rsqrtf(wave_sum(ss) * (1.f / DM) + EPS);
#pragma unroll
            for (int j = 0; j < 4; ++j) { const int c = 4 * lane + 256 * j; const f32x4 hh = v[j] * rstd * gs[j] + sh[j];
                v2u w; w.x = pk2(hh[0], hh[1]); w.y = pk2(hh[2], hh[3]); *(v2u*)(H + (size_t)row * DM + c) = w; } }
    }
    xcd_barrier(xbar);
    {
        if (bx < 160) sg_proj_task(bx, H, WIN_T, PROJ, out, VST, wave, lane);
        pg8::Gemm gm{H, WIN_T, MP, DIN, DM}; pg8::StaticOrder S; S.init(MP, DIN, G, bx);
        pg8::EpiProj E{PROJ, out, VST};
        pg8::gemm_phase<pg8::EpiProj, pg8::StaticOrder, true, true>(lds, gm, S, E);
    }
    xcd_barrier(xbar);
    {
        constexpr int N_ATT = 3072, N_GM = 1024, N_SA = 768, N_SG = 32;
        {
            v4u kA[4], vA[4], kB[4], vB[4]; bf16x8 qA0, qA1, qB0, qB1;
            if (bx < N_ATT) att_prefetch(bx, PROJ, tid, wave, lane, kA, vA, qA0, qA1);
            if (bx + G < N_ATT) att_prefetch(bx + G, PROJ, tid, wave, lane, kB, vB, qB0, qB1);
            const int key = tid >> 1, half = tid & 1;
            LAS bf16* kdst = (LAS bf16*)lds + key * 72 + half * 32; LAS bf16* vdst = (LAS bf16*)(lds + 36864) + key * 72 + half * 32;
            for (int it = bx; it < N_ATT; it += 2 * G) {
                {
#pragma unroll
                    for (int c = 0; c < 4; ++c) { *(LAS v4u*)(kdst + 8 * c) = kA[c]; *(LAS v4u*)(vdst + 8 * c) = vA[c]; }
                    const bf16x8 Qc0 = qA0, Qc1 = qA1;
                    __syncthreads();
                    if (it + 2 * G < N_ATT) att_prefetch(it + 2 * G, PROJ, tid, wave, lane, kA, vA, qA0, qA1);
                    att_compute(it, O3, ML, lds, wave, lane, Qc0, Qc1);
                    __syncthreads();
                }
                if (it + G < N_ATT) {
#pragma unroll
                    for (int c = 0; c < 4; ++c) { *(LAS v4u*)(kdst + 8 * c) = kB[c]; *(LAS v4u*)(vdst + 8 * c) = vB[c]; }
                    const bf16x8 Qc0 = qB0, Qc1 = qB1;
                    __syncthreads();
                    if (it + 3 * G < N_ATT) att_prefetch(it + 3 * G, PROJ, tid, wave, lane, kB, vB, qB0, qB1);
                    att_compute(it + G, O3, ML, lds, wave, lane, Qc0, Qc1);
                    __syncthreads();
                }
            }
        }
        for (int it = bx; it < N_GM; it += G) gmlp_item(it, PROJ, VST, wsp, bsp, lng, lnb, YA, lds, tid, wave, lane);
        for (int it = bx; it < N_SA; it += G) attn_sample_item(it, PROJ, c128, c512, c2048, O3, ML, wave, lane);
        for (int it = bx; it < N_SG; it += G) gmlp_sample_item(it, PROJ, VST, wsp, bsp, lng, lnb, YA, out, lds, tid, wave, lane);
    }
    xcd_barrier(xbar);
    for (int row = gw; row < MT; row += NGW) {
        const int head = lane >> 3;
        float mg[3], lg[3];
#pragma unroll
        for (int g = 0; g < 3; ++g) { const f32x2 a = *(const f32x2*)(ML + (((size_t)g * MT + row) * 8 + head) * 2); mg[g] = a[0]; lg[g] = a[1]; }
        const float mm = fmaxf(fmaxf(mg[0], mg[1]), mg[2]);
        float wg[3]; float den = 0.f;
#pragma unroll
        for (int g = 0; g < 3; ++g) { wg[g] = __expf(mg[g] - mm) * lg[g]; den += wg[g]; }
        const float rden = 1.f / den;
        float o[8] = {0.f, 0.f, 0.f, 0.f, 0.f, 0.f, 0.f, 0.f};
#pragma unroll
        for (int g = 0; g < 3; ++g) { const v4u raw = *(const v4u*)(O3 + ((size_t)g * MT + row) * 512 + lane * 8); const float w = wg[g] * rden;
            o[0] += w * bflo(raw.x); o[1] += w * bfhi(raw.x); o[2] += w * bflo(raw.y); o[3] += w * bfhi(raw.y); o[4] += w * bflo(raw.z); o[5] += w * bfhi(raw.z); o[6] += w * bflo(raw.w); o[7] += w * bfhi(raw.w); }
        const v4u zr = *(const v4u*)(PROJ + (size_t)row * DIN + C_ZB + lane * 8);
        v4u w; w.x = pk2(o[0] * silu(bflo(zr.x)), o[1] * silu(bfhi(zr.x))); w.y = pk2(o[2] * silu(bflo(zr.y)), o[3] * silu(bfhi(zr.y)));
        w.z = pk2(o[4] * silu(bflo(zr.z)), o[5] * silu(bfhi(zr.z))); w.w = pk2(o[6] * silu(bflo(zr.w)), o[7] * silu(bfhi(zr.w)));
        *(v4u*)(YB + (size_t)row * 512 + lane * 8) = w;
    }
    xcd_barrier(xbar);
    {
        if (bx < 128) sg_merge_task(bx, YA, YB, WPA_T, WPB_T, PROJ, MRG, wave, lane);
        pg8::Gemm gm{YA, WPA_T, MP, DM, DM}; pg8::StaticOrder S; S.init(MP, DM, G, bx);
        pg8::EpiGateA E{PROJ, PART};
        pg8::gemm_phase<pg8::EpiGateA, pg8::StaticOrder, true, true>(lds, gm, S, E);
    }
    {
        pg8::Gemm gm{YB, WPB_T, MP, DM, 512}; pg8::StaticOrder S; S.init(MP, DM, G, bx);
        pg8::EpiGateB E{PROJ, PART, MRG};
        pg8::gemm_phase<pg8::EpiGateB, pg8::StaticOrder, true, true>(lds, gm, S, E);
    }
    xcd_barrier(xbar);
    {
        if (bx < 128) sg_out_task(bx, MRG, WOUT_T, OUTB, wave, lane);
        pg8::Gemm gm{MRG, WOUT_T, MP, DM, DM}; pg8::StaticOrder S; S.init(MP, DM, G, bx);
        pg8::EpiF32 E{OUTB};
        pg8::gemm_phase<pg8::EpiF32, pg8::StaticOrder, true, true>(lds, gm, S, E);
    }
    xcd_barrier(xbar);
    for (int rb = gw; rb < MT / 8; rb += NGW) {
        const int rowb = rb * 8;
        const float* gate = MOD + (rowb < MP ? (rowb >> 11) : 8 + ((rowb - MP) >> 3)) * 3072 + 2048;
        f32x4 gt[4];
#pragma unroll
        for (int j = 0; j < 4; ++j) { const int c = 4 * lane + 256 * j; f32x4 a = (f32x4){0.f, 0.f, 0.f, 0.f};
#pragma unroll
            for (int q = 0; q < 4; ++q) a += *(const f32x4*)(gate + (size_t)q * 40 * 3072 + c);
            gt[j] = a * *(const f32x4*)(gpost + c); }
#pragma unroll 2
        for (int i = 0; i < 8; ++i) { const int row = rowb + i;
            const float* xr = row < MP ? xp + (size_t)row * DM : xs + (size_t)(row - MP) * DM;
            const float* orow = OUTB + (size_t)row * DM;
            f32x4 v[4]; float ss = 0.f;
#pragma unroll
            for (int j = 0; j < 4; ++j) { v[j] = ((const f32x4*)orow)[lane + 64 * j]; ss += (v[j][0] * v[j][0] + v[j][1] * v[j][1]) + (v[j][2] * v[j][2] + v[j][3] * v[j][3]); }
            const float rstd = rsqrtf(wave_sum(ss) * (1.f / DM) + EPS);
#pragma unroll
            for (int j = 0; j < 4; ++j) { const int c = 4 * lane + 256 * j; const f32x4 xx = ((const f32x4*)xr)[lane + 64 * j];
                *(f32x4*)(out + (size_t)row * DM + c) = xx + gt[j] * (v[j] * rstd); } }
    }
}

extern "C" void kernel_launch(void* const* d_in, const int* in_sizes, int n_in, void* d_out, int out_size, void* d_ws, size_t ws_size, hipStream_t stream) {
    static int grid = 0;
    if (grid == 0) {
        if (n_in != 19 || (size_t)out_size != O_END || ws_size < WS_END) { fprintf(stderr, "kernel_launch: unexpected shapes: n_in %d out %d ws %zu\n", n_in, out_size, ws_size); grid = -1; return; }
        int dev = 0, cus = 0, per_cu = 0;
        if (hipGetDevice(&dev) != hipSuccess || hipDeviceGetAttribute(&cus, hipDeviceAttributeMultiprocessorCount, dev) != hipSuccess) { fprintf(stderr, "kernel_launch: device query failed\n"); grid = -1; return; }
        if (hipFuncSetAttribute((const void*)fwd_kernel, hipFuncAttributeMaxDynamicSharedMemorySize, LDS_BYTES) != hipSuccess) { fprintf(stderr, "kernel_launch: hipFuncSetAttribute failed\n"); grid = -1; return; }
        if (hipOccupancyMaxActiveBlocksPerMultiprocessor(&per_cu, (const void*)fwd_kernel, NTHR, LDS_BYTES) != hipSuccess || per_cu < 1) { fprintf(stderr, "kernel_launch: occupancy query says %d blocks per CU\n", per_cu); }
        (void)hipGetLastError();
        grid = cus;
    }
    if (grid < 0) return;
    if (hipMemsetAsync((char*)d_ws + 16384, 0, 16384, stream) != hipSuccess) { fprintf(stderr, "kernel_launch: memset of the barrier words failed\n"); return; }
    Args a{};
    for (int i = 0; i < 19; ++i) a.in[i] = (const float*)d_in[i];
    a.out = (float*)d_out; a.ws = (unsigned char*)d_ws;
    void* kargs[] = {&a};
    hipError_t e = hipLaunchCooperativeKernel((const void*)fwd_kernel, dim3(grid), dim3(NTHR), kargs, LDS_BYTES, stream);
    if (e != hipSuccess) fprintf(stderr, "kernel_launch: cooperative launch failed: %s (grid %d)\n", hipGetErrorString(e), grid);
}
```

```cpp
#include <hip/hip_runtime.h>
#include <hip/hip_cooperative_groups.h>
#include <cstdio>
#include <cstdint>
namespace cg = cooperative_groups;
namespace pg8 {
#define PG8_LAS __attribute__((address_space(3)))
typedef unsigned short bf16_t;
typedef short bf16x8 __attribute__((ext_vector_type(8)));
typedef float f32x4 __attribute__((ext_vector_type(4)));
typedef unsigned u32x4 __attribute__((ext_vector_type(4)));
constexpr int BM = 256, BK = 64, HALF = 128, HTB = HALF * BK * 2  , STAGE_BYTES = 8 * HTB, NXCD = 8, WGM = 8;

__host__ __device__ __forceinline__ int lds_byte(int r, int c) { const int st = (r >> 4) * 2 + (c >> 5), rr = r & 15, cc = c & 31, ob = rr * 64 + cc * 2; return st * 1024 + (ob ^ (((ob >> 9) & 1) << 5)); }
__host__ __device__ __forceinline__ void stage_rc(int b, int& R, int& C) { const int st = b / 1024, sb = b % 1024, swz = sb ^ (((sb >> 9) & 1) << 5); R = (st >> 1) * 16 + swz / 64; C = (st & 1) * 32 + (swz % 64) / 2; }
__host__ __device__ __forceinline__ int perm32(int rho) { const int n = rho >> 4, i = rho & 15; return 8 * (i >> 2) + 4 * n + (i & 3); }

struct Unit { int pm, pn; };
struct Gemm { const bf16_t* A; const bf16_t* Bt; int M, N, K; };

struct StaticOrder {
    int nM, nN, nwg, G, c;
    __host__ __device__ void init(int M, int N, int G_, int c_) { nM = M / BM; nN = N / BM; nwg = nM * nN; G = G_; c = c_; }
    __host__ __device__ bool next(int i, Unit& u) const {
        const long L = (long)i * G + c; if (L >= nwg) return false;
        int wgid = (int)L; { const int q = nwg / NXCD, r = nwg % NXCD, xcd = wgid % NXCD, off = wgid / NXCD; wgid = (xcd < r ? xcd * (q + 1) : r * (q + 1) + (xcd - r) * q) + off; }
        const int nig = WGM * nN, gid = wgid / nig, fm = gid * WGM, gsz = (nM - fm) < WGM ? (nM - fm) : WGM;
        u.pm = fm + ((wgid % nig) % gsz); u.pn = (wgid % nig) / gsz; return true;
    }
    __device__ __forceinline__ void a_ready(const Unit&) const {}
    __device__ __forceinline__ void done(const Unit&) const {}
};
__device__ __forceinline__ unsigned cvt_pk_bf16(float lo, float hi) { unsigned r; asm volatile("v_cvt_pk_bf16_f32 %0, %1, %2" : "=v"(r) : "v"(lo), "v"(hi)); return r; }
typedef float f32x2 __attribute__((ext_vector_type(2)));
template <class Epi, class Sched, bool ALIGN_EPI = false, bool SP2 = false>
__device__ __forceinline__ void gemm_phase(PG8_LAS unsigned char* lds, const Gemm g, const Sched& S, const Epi& E) {
    const int tid = threadIdx.x, wid = __builtin_amdgcn_readfirstlane(tid >> 6), lane = tid & 63, wr = wid >> 2, wc = wid & 3, fr = lane & 15, fq = lane >> 4;
    const int K = g.K, nt = K / BK;
    unsigned voffA[2], voffB[2];
#pragma unroll
    for (int i = 0; i < 2; ++i) { int R, C; stage_rc(tid * 16 + i * 8192, R, C); const int Rb = Epi::PERM ? ((R & ~31) + perm32(R & 31)) : R;
        voffA[i] = (unsigned)(R * K + C) * 2u; voffB[i] = (unsigned)(Rb * K + C) * 2u; }
    const size_t kstep = (size_t)(BK * 2);
    const size_t hstep = (size_t)HALF * K * 2;
    const size_t tstep = 2 * hstep;
    const unsigned ldsw = (unsigned)wid * 1024u;
    const int aoff = lds_byte(wr * 64 + fr, fq * 8), boff = lds_byte(wc * 32 + fr, fq * 8);
#define PG8_SA(b, h) (((b) * 2 + (h)) * HTB)
#define PG8_SB(b, h) ((4 + (b) * 2 + (h)) * HTB)
#define PG8_STAGE(bufoff, gbase, voff) do { _Pragma("unroll") for (int _i = 0; _i < 2; ++_i) \
        __builtin_amdgcn_global_load_lds((const unsigned*)((const char*)(gbase) + (voff)[_i]), (PG8_LAS unsigned*)(lds + (bufoff) + ldsw + _i * 8192), 16, 0, 0); } while (0)
#define PG8_LDA(dst, b, h) do { _Pragma("unroll") for (int m = 0; m < 4; ++m) _Pragma("unroll") for (int k = 0; k < 2; ++k) dst[m][k] = *(const PG8_LAS bf16x8*)(lds + PG8_SA(b, h) + aoff + m * 2048 + k * 1024); } while (0)
#define PG8_LDB(dst, b, h) do { _Pragma("unroll") for (int n = 0; n < 2; ++n) _Pragma("unroll") for (int k = 0; k < 2; ++k) dst[n][k] = *(const PG8_LAS bf16x8*)(lds + PG8_SB(b, h) + boff + n * 2048 + k * 1024); } while (0)
#define PG8_MMA(ai, bj, At, Bt) do { __builtin_amdgcn_s_setprio(1); _Pragma("unroll") for (int m = 0; m < 4; ++m) _Pragma("unroll") for (int n = 0; n < 2; ++n) _Pragma("unroll") for (int k = 0; k < 2; ++k) \
        acc[ai][bj][m][n] = __builtin_amdgcn_mfma_f32_16x16x32_bf16(Bt[n][k], At[m][k], acc[ai][bj][m][n], 0, 0, 0); __builtin_amdgcn_s_setprio(0); } while (0)
#define PG8_WAIT_V(n) asm volatile("s_waitcnt vmcnt(" #n ")" ::: "memory")
#define PG8_WAIT_L(n) asm volatile("s_waitcnt lgkmcnt(" #n ")" ::: "memory")
#define PG8_BAR __builtin_amdgcn_s_barrier()
#define PG8_SCHED __builtin_amdgcn_sched_barrier(0)
    Unit cur, nxt; int ui = 0;
    if (!S.next(0, cur)) return;
    f32x4 acc[2][2][4][2];
#pragma unroll
    for (int a = 0; a < 2; ++a)
#pragma unroll
        for (int b = 0; b < 2; ++b)
#pragma unroll
            for (int m = 0; m < 4; ++m)
#pragma unroll
                for (int n = 0; n < 2; ++n) acc[a][b][m][n] = (f32x4){0.f, 0.f, 0.f, 0.f};
    bf16x8 At[4][2], B0[2][2], B1[2][2];
    const char* cA = (const char*)g.A + (size_t)cur.pm * tstep; const char* cB = (const char*)g.Bt + (size_t)cur.pn * tstep;
    S.a_ready(cur);
    if constexpr (SP2) {
        PG8_STAGE(PG8_SB(0, 0), cB, voffB); PG8_STAGE(PG8_SB(0, 1), cB + hstep, voffB); PG8_STAGE(PG8_SA(0, 0), cA, voffA); PG8_STAGE(PG8_SA(0, 1), cA + hstep, voffA);
        if (wr == 1) PG8_BAR;
        PG8_WAIT_V(2); PG8_BAR;
        PG8_STAGE(PG8_SB(1, 0), cB + kstep, voffB); PG8_STAGE(PG8_SA(1, 0), cA + kstep, voffA); PG8_STAGE(PG8_SB(1, 1), cB + hstep + kstep, voffB);
        PG8_WAIT_V(6); PG8_BAR;
    } else {
        PG8_STAGE(PG8_SB(0, 0), cB, voffB); PG8_STAGE(PG8_SA(0, 0), cA, voffA); PG8_STAGE(PG8_SB(0, 1), cB + hstep, voffB); PG8_STAGE(PG8_SA(0, 1), cA + hstep, voffA);
        if (wr == 1) PG8_BAR;
        PG8_WAIT_V(4); PG8_BAR;
        PG8_STAGE(PG8_SB(1, 0), cB + kstep, voffB); PG8_STAGE(PG8_SA(1, 0), cA + kstep, voffA); PG8_STAGE(PG8_SB(1, 1), cB + hstep + kstep, voffB);
        PG8_WAIT_V(6); PG8_BAR;
    }
    for (;;) {
        const bool has_next = S.next(ui + 1, nxt);
        const char* nA = has_next ? (const char*)g.A + (size_t)nxt.pm * tstep : cA; const char* nB = has_next ? (const char*)g.Bt + (size_t)nxt.pn * tstep : cB;
        for (int t = 0; t < nt; t += 2) {
            const bool last = (t == nt - 2);
            const char* a1 = cA + (size_t)(t + 1) * kstep;
            const char* a2 = last ? nA : cA + (size_t)(t + 2) * kstep; const char* b2 = last ? nB : cB + (size_t)(t + 2) * kstep;
            const char* a3 = a2 + kstep; const char* b3 = b2 + kstep;
            if (last && has_next) S.a_ready(nxt);
            if constexpr (SP2) {
            PG8_LDB(B0, 0, 0); PG8_LDB(B1, 0, 1); PG8_SCHED; PG8_LDA(At, 0, 0); PG8_STAGE(PG8_SA(1, 1), a1 + hstep, voffA);
            PG8_WAIT_V(8); PG8_WAIT_L(0); PG8_BAR; PG8_MMA(0, 0, At, B0); PG8_MMA(0, 1, At, B1); PG8_BAR; PG8_SCHED;
            PG8_LDA(At, 0, 1); PG8_STAGE(PG8_SB(0, 0), b2, voffB); PG8_STAGE(PG8_SB(0, 1), b2 + hstep, voffB); PG8_STAGE(PG8_SA(0, 0), a2, voffA);
            PG8_WAIT_V(8); PG8_WAIT_L(0); PG8_BAR; PG8_MMA(1, 0, At, B0); PG8_MMA(1, 1, At, B1); PG8_BAR; PG8_SCHED;
            PG8_LDB(B0, 1, 0); PG8_LDB(B1, 1, 1); PG8_SCHED; PG8_LDA(At, 1, 0); PG8_STAGE(PG8_SA(0, 1), a2 + hstep, voffA);
            PG8_WAIT_V(8); PG8_WAIT_L(0); PG8_BAR; PG8_MMA(0, 0, At, B0); PG8_MMA(0, 1, At, B1); PG8_BAR; PG8_SCHED;
            PG8_LDA(At, 1, 1); PG8_STAGE(PG8_SB(1, 0), b3, voffB); PG8_STAGE(PG8_SB(1, 1), b3 + hstep, voffB); PG8_STAGE(PG8_SA(1, 0), a3, voffA);
            PG8_WAIT_V(8); PG8_WAIT_L(0); PG8_BAR; PG8_MMA(1, 0, At, B0); PG8_MMA(1, 1, At, B1); PG8_BAR; PG8_SCHED;
            } else {
            PG8_LDB(B0, 0, 0); PG8_SCHED; PG8_LDA(At, 0, 0); PG8_STAGE(PG8_SA(1, 1), a1 + hstep, voffA);
            PG8_WAIT_L(8); PG8_BAR; PG8_WAIT_L(0); PG8_MMA(0, 0, At, B0); PG8_BAR; PG8_SCHED;
            PG8_LDB(B1, 0, 1); PG8_STAGE(PG8_SB(0, 0), b2, voffB);
            PG8_BAR; PG8_WAIT_L(0); PG8_MMA(0, 1, At, B1); PG8_BAR;
            PG8_LDA(At, 0, 1); PG8_STAGE(PG8_SA(0, 0), a2, voffA);
            PG8_BAR; PG8_WAIT_L(0); PG8_MMA(1, 0, At, B0); PG8_BAR; PG8_SCHED;
            PG8_STAGE(PG8_SB(0, 1), b2 + hstep, voffB);
            PG8_WAIT_V(6); PG8_BAR; PG8_MMA(1, 1, At, B1); PG8_BAR;
            PG8_LDB(B0, 1, 0); PG8_SCHED; PG8_LDA(At, 1, 0); PG8_STAGE(PG8_SA(0, 1), a2 + hstep, voffA);
            PG8_WAIT_L(8); PG8_BAR; PG8_WAIT_L(0); PG8_MMA(0, 0, At, B0); PG8_BAR; PG8_SCHED;
            PG8_LDB(B1, 1, 1); PG8_STAGE(PG8_SB(1, 0), b3, voffB);
            PG8_BAR; PG8_WAIT_L(0); PG8_MMA(0, 1, At, B1); PG8_BAR;
            PG8_LDA(At, 1, 1); PG8_STAGE(PG8_SA(1, 0), a3, voffA);
            PG8_BAR; PG8_WAIT_L(0); PG8_MMA(1, 0, At, B0); PG8_BAR; PG8_SCHED;
            PG8_STAGE(PG8_SB(1, 1), b3 + hstep, voffB);
            PG8_WAIT_V(6); PG8_BAR; PG8_MMA(1, 1, At, B1); PG8_BAR;
            }
        }
        if constexpr (ALIGN_EPI) { if (wr == 0) PG8_BAR; }
        if constexpr (!Epi::AFTER_DRAIN) { E(acc, cur, wr, wc, fr, fq); S.done(cur); }
        if (!has_next) break;
#pragma unroll
        for (int a = 0; a < 2; ++a)
#pragma unroll
            for (int b = 0; b < 2; ++b)
#pragma unroll
                for (int m = 0; m < 4; ++m)
#pragma unroll
                    for (int n = 0; n < 2; ++n) acc[a][b][m][n] = (f32x4){0.f, 0.f, 0.f, 0.f};
        cur = nxt; cA = nA; cB = nB; ++ui;
        if constexpr (ALIGN_EPI) { if (wr == 1) PG8_BAR; }
    }
    PG8_WAIT_V(0);
    if constexpr (!ALIGN_EPI) { if (wr == 0) PG8_BAR; }
    PG8_BAR;
    if constexpr (Epi::AFTER_DRAIN) { E.fused(acc, cur, wr, wc, fr, fq, lds, wid, lane); S.done(cur); }
#undef PG8_SA
#undef PG8_SB
#undef PG8_STAGE
#undef PG8_LDA
#undef PG8_LDB
#undef PG8_MMA
#undef PG8_WAIT_V
#undef PG8_WAIT_L
#undef PG8_BAR
#undef PG8_SCHED
}
}

#define GAS __attribute__((address_space(1)))
#define LAS __attribute__((address_space(3)))
typedef unsigned short bf16;
typedef unsigned v4u __attribute__((ext_vector_type(4)));
typedef unsigned v2u __attribute__((ext_vector_type(2)));
typedef float f32x4 __attribute__((ext_vector_type(4)));
typedef float f32x2 __attribute__((ext_vector_type(2)));
typedef short bf16x8 __attribute__((ext_vector_type(8)));

constexpr int NWAVES = 8, NTHR = 512;
constexpr int DM = 1024, NBP = 8, SEQ = 2048, NBS = 32, TS = 8;
constexpr int MP = NBP * SEQ, MS = NBS * TS, MT = MP + MS;
constexpr int DIN = 10240;
constexpr int C_U = 0, C_V = 1024, C_Z = 2048, C_Q = 3072, C_K = 4608, C_VV = 6144, C_ZB = 7680, C_GA = 8192, C_GB = 9216;
constexpr float EPS = 1e-6f;
constexpr size_t O_Y = 0, O_KVP0 = (size_t)MT * DM, O_KVP1 = O_KVP0 + (size_t)8 * 128 * 1024, O_KVP2 = O_KVP1 + (size_t)8 * 512 * 1024,
                 O_KVS0 = O_KVP2 + (size_t)8 * 2048 * 1024, O_KVS1 = O_KVS0 + 262144, O_KVS2 = O_KVS1 + 262144, O_VCH = O_KVS2 + 262144, O_END = O_VCH + 262144;
constexpr size_t MiB = 1u << 20;
constexpr size_t WS_WIN = 2 * MiB, WS_WPA = 22 * MiB, WS_WPB = 24 * MiB, WS_WOUT = 25 * MiB, WS_MOD = 27 * MiB, WS_VST = 29 * MiB, WS_ML = 32 * MiB,
                 WS_H = 36 * MiB, WS_YA = 70 * MiB, WS_YB = 104 * MiB, WS_MRG = 122 * MiB, WS_O3 = 156 * MiB, WS_PART = 206 * MiB, WS_OUT = 272 * MiB,
                 WS_PROJ = 340 * MiB, WS_END = 672 * MiB;
static_assert(WS_PROJ + (size_t)MT * DIN * 2 <= WS_END, "ws map");
constexpr int LDS_BYTES = 147456;

#define LDS_WAIT() asm volatile("s_waitcnt lgkmcnt(0)" ::: "memory")
__device__ __forceinline__ unsigned f2bf(float f) { unsigned u = __builtin_bit_cast(unsigned, f); return (u + 0x7fffu + ((u >> 16) & 1u)) >> 16; }
__device__ __forceinline__ unsigned pk2(float lo, float hi) { return f2bf(lo) | (f2bf(hi) << 16); }
__device__ __forceinline__ float bflo(unsigned w) { return __builtin_bit_cast(float, w << 16); }
__device__ __forceinline__ float bfhi(unsigned w) { return __builtin_bit_cast(float, w & 0xffff0000u); }
__device__ __forceinline__ float bf2f(bf16 h) { return __builtin_bit_cast(float, (unsigned)h << 16); }
__device__ __forceinline__ float sigm(float x) { return 1.f / (1.f + __expf(-x)); }
__device__ __forceinline__ float silu(float x) { return x / (1.f + __expf(-x)); }
__device__ __forceinline__ float wave_sum(float v) {
#pragma unroll
    for (int o = 1; o < 64; o <<= 1) v += __shfl_xor(v, o);
    return v;
}
__device__ __forceinline__ float wave_max(float v) {
#pragma unroll
    for (int o = 1; o < 64; o <<= 1) v = fmaxf(v, __shfl_xor(v, o));
    return v;
}
__device__ __forceinline__ float rdlane(float v, int l) { return __builtin_bit_cast(float, __builtin_amdgcn_readlane(__builtin_bit_cast(int, v), l)); }

#define XB_TMO      128
#define XB_XCNT(j)  (256  + 64 * (j))
#define XB_XSUB(j)  (1280 + 64 * (j))
#define XB_XGEN(j)  (2304 + 64 * (j))
#define XB_TOP      3328
#define XB_TOPGEN   3392
#define XCD_BAR_WORDS 3456
#define XB_SPIN_CAP (1u << 18)

__device__ __forceinline__ unsigned xb_ld(unsigned* p)              { return __hip_atomic_load(p, __ATOMIC_RELAXED, __HIP_MEMORY_SCOPE_AGENT); }
__device__ __forceinline__ unsigned xb_add(unsigned* p, unsigned v) { return __hip_atomic_fetch_add(p, v, __ATOMIC_RELAXED, __HIP_MEMORY_SCOPE_AGENT); }
__device__ __forceinline__ unsigned xb_xcc_id() { return (unsigned)__builtin_amdgcn_s_getreg((3 << 11) | 20) & 0xFu; }
#define XB_SPIN(cond, bar) do { unsigned _sp = 0; while (cond) { __builtin_amdgcn_s_sleep(1); \
    if ((++_sp & 255u) == 0u) { if (xb_ld(&(bar)[XB_TMO])) break; if (_sp > XB_SPIN_CAP) { atomicAdd(&(bar)[XB_TMO], 1u); break; } } } } while (0)

struct XcdBarrier {
    unsigned* bar; unsigned x;
    volatile LAS unsigned* st;
};

__device__ __forceinline__ XcdBarrier xcd_barrier_post(unsigned* bar, volatile LAS unsigned* st) {
    XcdBarrier b; b.bar = bar; b.x = xb_xcc_id(); b.st = st;
    if (threadIdx.x == 0) (void)xb_add(&bar[XB_XCNT(b.x)], 1u);
    return b;
}
__device__ __forceinline__ void xcd_barrier_complete(unsigned* bar, unsigned x, unsigned& nloc, unsigned& nx) {
    const unsigned G = gridDim.x * gridDim.y * gridDim.z;
    unsigned sum, cnt, mine, sp = 0u;
    for (;;) {
        sum = 0u; cnt = 0u; mine = 0u;
#pragma unroll
        for (unsigned j = 0; j < 16; ++j) { const unsigned c = xb_ld(&bar[XB_XCNT(j)]); sum += c; cnt += (c > 0u) ? 1u : 0u; mine = (j == x) ? c : mine; }
        if (sum == G) break;
        __builtin_amdgcn_s_sleep(1);
        if ((++sp & 255u) == 0u) { if (xb_ld(&bar[XB_TMO])) break; if (sp > XB_SPIN_CAP) { atomicAdd(&bar[XB_TMO], 1u); break; } }
    }
    nloc = mine > 0u ? mine : 1u; nx = cnt > 0u ? cnt : 1u;
}

__device__ __forceinline__ void xcd_barrier(const XcdBarrier& b) {
    asm volatile("s_waitcnt vmcnt(0)" ::: "memory");
    __syncthreads();
    if (threadIdx.x == 0) {
        unsigned* bar = b.bar;
        __builtin_amdgcn_s_waitcnt(0);
        unsigned nloc = b.st[0], nx = b.st[1];
        if (nloc == 0u) { xcd_barrier_complete(bar, b.x, nloc, nx); b.st[0] = nloc; b.st[1] = nx; }
        const unsigned old = xb_add(&bar[XB_XSUB(b.x)], 1u);
        const unsigned gen = old / nloc;
        if (old + 1u == (gen + 1u) * nloc) {
            __builtin_amdgcn_fence(__ATOMIC_RELEASE, "agent");
            asm volatile("s_waitcnt vmcnt(0)" ::: "memory");
            const unsigned og = xb_add(&bar[XB_TOP], 1u);
            const unsigned tg = og / nx;
            if (og + 1u == (tg + 1u) * nx) xb_add(&bar[XB_TOPGEN], 1u);
            else XB_SPIN(xb_ld(&bar[XB_TOPGEN]) == tg, bar);
            __builtin_amdgcn_fence(__ATOMIC_ACQUIRE, "agent");
            xb_add(&bar[XB_XGEN(b.x)], 1u);
            asm volatile("s_waitcnt vmcnt(0)" ::: "memory");
        } else {
            XB_SPIN(xb_ld(&bar[XB_XGEN(b.x)]) == gen, bar);
            __builtin_amdgcn_fence(__ATOMIC_ACQUIRE, "agent");
            asm volatile("s_waitcnt vmcnt(0)" ::: "memory");
        }
    }
    __syncthreads();
}

namespace pg8 {
struct EpiProj {
    static constexpr bool PERM = true, AFTER_DRAIN = false;
    bf16_t* P; float* out; float* vst;
    __device__ __forceinline__ void operator()(const f32x4 (&acc)[2][2][4][2], const Unit& u, int wr, int wc, int fr, int fq) const {
        const int row0 = u.pm * BM + wr * 64 + fr;
        const int colt = u.pn * BM + wc * 32 + 8 * fq;
#pragma unroll
        for (int ai = 0; ai < 2; ++ai)
#pragma unroll
            for (int m = 0; m < 4; ++m) { bf16_t* rowp = P + (size_t)(row0 + ai * HALF + m * 16) * DIN + colt;
#pragma unroll
                for (int bj = 0; bj < 2; ++bj) { const f32x4 v0 = acc[ai][bj][m][0], v1 = acc[ai][bj][m][1];
                    u32x4 w; w.x = cvt_pk_bf16(v0[0], v0[1]); w.y = cvt_pk_bf16(v0[2], v0[3]); w.z = cvt_pk_bf16(v1[0], v1[1]); w.w = cvt_pk_bf16(v1[2], v1[3]);
                    *(u32x4*)(rowp + bj * HALF) = w; } }
        if (u.pn >= 4 && u.pn < 8) {
#pragma unroll
            for (int ai = 0; ai < 2; ++ai)
#pragma unroll
                for (int m = 0; m < 4; ++m) { float s = 0.f, q = 0.f;
#pragma unroll
                    for (int bj = 0; bj < 2; ++bj)
#pragma unroll
                        for (int n = 0; n < 2; ++n) { const f32x4 x = acc[ai][bj][m][n]; s += (x[0] + x[1]) + (x[2] + x[3]); q += (x[0] * x[0] + x[1] * x[1]) + (x[2] * x[2] + x[3] * x[3]); }
                    s += __shfl_xor(s, 16); s += __shfl_xor(s, 32); q += __shfl_xor(q, 16); q += __shfl_xor(q, 32);
                    if (fq == 0) { float* d = vst + ((size_t)(row0 + ai * HALF + m * 16) * 16 + (u.pn - 4) * 4 + wc) * 2; *(f32x2*)d = (f32x2){s, q}; } }
        }
        if (u.pn >= 18 && u.pn < 30) {
            const int kv = u.pn >= 24 ? 1 : 0; const int t = u.pn - 18 - 6 * kv; const int g = t >> 1, half = t & 1;
            const int dcol = kv * 512 + half * 256 + wc * 32 + 8 * fq;
            const int R = g == 0 ? 128 : (g == 1 ? 512 : 2048);
            const size_t obp = g == 0 ? O_KVP0 : (g == 1 ? O_KVP1 : O_KVP2), obs = g == 0 ? O_KVS0 : (g == 1 ? O_KVS1 : O_KVS2);
#pragma unroll
            for (int ai = 0; ai < 2; ++ai)
#pragma unroll
                for (int m = 0; m < 4; ++m) { const int row = row0 + ai * HALF + m * 16; float* base = nullptr;
                    if (row < MP) { const int b = row >> 11, s = row & 2047, r = s - (2048 - R); if (r >= 0) base = out + obp + (size_t)(b * R + r) * 1024 + dcol; }
                    else base = out + obs + (size_t)(row - MP) * 1024 + dcol;
                    if (base) {
#pragma unroll
                        for (int bj = 0; bj < 2; ++bj)
#pragma unroll
                            for (int n = 0; n < 2; ++n) *(f32x4*)(base + bj * HALF + 4 * n) = acc[ai][bj][m][n]; } }
        }
    }
};
struct EpiGateA {
    static constexpr bool PERM = true, AFTER_DRAIN = false;
    const bf16_t* P; bf16_t* part;
    __device__ __forceinline__ void operator()(const f32x4 (&acc)[2][2][4][2], const Unit& u, int wr, int wc, int fr, int fq) const {
        const int row0 = u.pm * BM + wr * 64 + fr; const int colt = u.pn * BM + wc * 32 + 8 * fq;
#pragma unroll
        for (int ai = 0; ai < 2; ++ai)
#pragma unroll
            for (int m = 0; m < 4; ++m) { const size_t row = (size_t)(row0 + ai * HALF + m * 16); const bf16_t* gp = P + row * DIN + C_GA + colt; bf16_t* pp = part + row * DM + colt;
#pragma unroll
                for (int bj = 0; bj < 2; ++bj) { const u32x4 gw = *(const u32x4*)(gp + bj * HALF); const f32x4 a0 = acc[ai][bj][m][0], a1 = acc[ai][bj][m][1];
                    f32x4 o0, o1; o0[0] = a0[0] * sigm(bflo(gw.x)); o0[1] = a0[1] * sigm(bfhi(gw.x)); o0[2] = a0[2] * sigm(bflo(gw.y)); o0[3] = a0[3] * sigm(bfhi(gw.y));
                    o1[0] = a1[0] * sigm(bflo(gw.z)); o1[1] = a1[1] * sigm(bfhi(gw.z)); o1[2] = a1[2] * sigm(bflo(gw.w)); o1[3] = a1[3] * sigm(bfhi(gw.w));
                    u32x4 w; w.x = cvt_pk_bf16(o0[0], o0[1]); w.y = cvt_pk_bf16(o0[2], o0[3]); w.z = cvt_pk_bf16(o1[0], o1[1]); w.w = cvt_pk_bf16(o1[2], o1[3]);
                    *(u32x4*)(pp + bj * HALF) = w; } }
    }
};
struct EpiGateB {
    static constexpr bool PERM = true, AFTER_DRAIN = false;
    const bf16_t* P; const bf16_t* part; bf16_t* mrg;
    __device__ __forceinline__ void operator()(const f32x4 (&acc)[2][2][4][2], const Unit& u, int wr, int wc, int fr, int fq) const {
        const int row0 = u.pm * BM + wr * 64 + fr; const int colt = u.pn * BM + wc * 32 + 8 * fq;
#pragma unroll
        for (int ai = 0; ai < 2; ++ai)
#pragma unroll
            for (int m = 0; m < 4; ++m) { const size_t row = (size_t)(row0 + ai * HALF + m * 16); const bf16_t* gp = P + row * DIN + C_GB + colt; const bf16_t* pp = part + row * DM + colt;
#pragma unroll
                for (int bj = 0; bj < 2; ++bj) { const u32x4 gw = *(const u32x4*)(gp + bj * HALF); const f32x4 a0 = acc[ai][bj][m][0], a1 = acc[ai][bj][m][1];
                    const u32x4 pw = *(const u32x4*)(pp + bj * HALF);
                    const f32x4 p0 = (f32x4){bflo(pw.x), bfhi(pw.x), bflo(pw.y), bfhi(pw.y)}, p1 = (f32x4){bflo(pw.z), bfhi(pw.z), bflo(pw.w), bfhi(pw.w)};
                    f32x4 o0, o1; o0[0] = p0[0] + a0[0] * sigm(bflo(gw.x)); o0[1] = p0[1] + a0[1] * sigm(bfhi(gw.x)); o0[2] = p0[2] + a0[2] * sigm(bflo(gw.y)); o0[3] = p0[3] + a0[3] * sigm(bfhi(gw.y));
                    o1[0] = p1[0] + a1[0] * sigm(bflo(gw.z)); o1[1] = p1[1] + a1[1] * sigm(bfhi(gw.z)); o1[2] = p1[2] + a1[2] * sigm(bflo(gw.w)); o1[3] = p1[3] + a1[3] * sigm(bfhi(gw.w));
                    u32x4 w; w.x = cvt_pk_bf16(o0[0], o0[1]); w.y = cvt_pk_bf16(o0[2], o0[3]); w.z = cvt_pk_bf16(o1[0], o1[1]); w.w = cvt_pk_bf16(o1[2], o1[3]);
                    *(u32x4*)(mrg + row * DM + colt + bj * HALF) = w; } }
    }
};
struct EpiF32 {
    static constexpr bool PERM = true, AFTER_DRAIN = false;
    bf16_t* O;
    __device__ __forceinline__ void operator()(const f32x4 (&acc)[2][2][4][2], const Unit& u, int wr, int wc, int fr, int fq) const {
        const int row0 = u.pm * BM + wr * 64 + fr; const int colt = u.pn * BM + wc * 32 + 8 * fq;
#pragma unroll
        for (int ai = 0; ai < 2; ++ai)
#pragma unroll
            for (int m = 0; m < 4; ++m) { bf16_t* pp = O + (size_t)(row0 + ai * HALF + m * 16) * DM + colt;
#pragma unroll
                for (int bj = 0; bj < 2; ++bj) { const f32x4 v0 = acc[ai][bj][m][0], v1 = acc[ai][bj][m][1];
                    u32x4 w; w.x = cvt_pk_bf16(v0[0], v0[1]); w.y = cvt_pk_bf16(v0[2], v0[3]); w.z = cvt_pk_bf16(v1[0], v1[1]); w.w = cvt_pk_bf16(v1[2], v1[3]);
                    *(u32x4*)(pp + bj * HALF) = w; } }
    }
};
}

__device__ __forceinline__ void p0_transpose_item(const float* W, int K, int N, bf16* WT, int row_off, LAS float* scr, int item, int lane) {
    const int nblk = N / 32, kb = item / nblk, nb = item % nblk, k0 = 64 * kb, n0 = 32 * nb;
#pragma unroll
    for (int i = 0; i < 32; ++i) { const int kk = 2 * i + (lane >> 5); scr[kk * 33 + (lane & 31)] = W[(size_t)(k0 + kk) * N + n0 + (lane & 31)]; }
    LDS_WAIT(); asm volatile("" ::: "memory");
    const int c = lane & 7;
#pragma unroll
    for (int j = 0; j < 4; ++j) { const int n = (lane >> 3) + 8 * j; const LAS float* s = scr + (8 * c) * 33 + n;
        v4u o; o.x = pk2(s[0 * 33], s[1 * 33]); o.y = pk2(s[2 * 33], s[3 * 33]); o.z = pk2(s[4 * 33], s[5 * 33]); o.w = pk2(s[6 * 33], s[7 * 33]);
        *(GAS v4u*)(WT + (size_t)(row_off + n0 + n) * K + k0 + 8 * c) = o; }
    LDS_WAIT(); asm volatile("" ::: "memory");
}
__device__ __forceinline__ void mod_task(int task, const float* cp, const float* cs, const float* Wc, const float* bc, float* MODP, LAS unsigned char* lds, int tid, int wave, int lane) {
    const int chunk = task >> 2, kq = task & 3;
    const int k0 = kq * 256 + wave * 32;
    float sc[40], acc[40];
#pragma unroll
    for (int r = 0; r < 40; ++r) { const float* crow = (r < 8) ? cp + r * 1024 : cs + (r - 8) * 1024; sc[r] = silu(crow[k0 + (lane & 31)]); acc[r] = 0.f; }
    const float* wp = Wc + (size_t)k0 * 3072 + chunk * 64 + lane;
#pragma unroll 8
    for (int kk = 0; kk < 32; ++kk) { const float wv = wp[(size_t)kk * 3072];
#pragma unroll
        for (int r = 0; r < 40; ++r) acc[r] += rdlane(sc[r], kk) * wv; }
    LAS float* red = (LAS float*)lds;
#pragma unroll
    for (int r = 0; r < 40; ++r) red[(wave * 40 + r) * 64 + lane] = acc[r];
    __syncthreads();
    for (int idx = tid; idx < 2560; idx += NTHR) { const int r = idx >> 6, cl = idx & 63; float s = 0.f;
#pragma unroll
        for (int w = 0; w < 8; ++w) s += red[(w * 40 + r) * 64 + cl];
        if (kq == 0) s += bc[chunk * 64 + cl];
        MODP[((size_t)kq * 40 + r) * 3072 + chunk * 64 + cl] = s; }
    __syncthreads();
}

typedef short s16x4 __attribute__((ext_vector_type(4)));
__device__ __forceinline__ s16x4 lds_tr(const LAS bf16* p) { return __builtin_bit_cast(s16x4, __builtin_amdgcn_ds_read_tr16_b64_v4i16((LAS s16x4*)p)); }
__device__ __forceinline__ void att_decode(int idx, int& g, int& b, int& h, int& d, int& n, int& r) {
    g = idx >> 10; int rem = idx & 1023; b = rem >> 7; rem &= 127; h = rem >> 4; const int sub = rem & 15;
    if (g == 0) { d = 1; n = sub; r = 0; } else if (g == 1) { d = 4; r = sub >> 2; n = sub & 3; } else { d = 16; r = sub; n = 0; }
}
__device__ __forceinline__ void att_prefetch(int idx, const bf16* PROJ, int tid, int wave, int lane, v4u (&kk)[4], v4u (&vv)[4], bf16x8& Q0, bf16x8& Q1) {
    int g, b, h, d, n, r; att_decode(idx, g, b, h, d, n, r);
    const int key = tid >> 1, half = tid & 1; const int m = 128 * (n - 1) + key;
    if (m >= 0) { const size_t row = (size_t)b * 2048 + (size_t)d * m + r; const bf16* src = PROJ + row * DIN + g * 512 + h * 64 + half * 32;
#pragma unroll
        for (int c = 0; c < 4; ++c) { kk[c] = *(const v4u*)(src + C_K + 8 * c); vv[c] = *(const v4u*)(src + C_VV + 8 * c); } }
    else {
#pragma unroll
        for (int c = 0; c < 4; ++c) { kk[c] = (v4u){0u, 0u, 0u, 0u}; vv[c] = (v4u){0u, 0u, 0u, 0u}; } }
    const int fr = lane & 15, fq = lane >> 4; const int i = 16 * wave + fr;
    const size_t rowq = (size_t)b * 2048 + (size_t)d * (128 * n + i) + r;
    const bf16* qsrc = PROJ + rowq * DIN + C_Q + g * 512 + h * 64 + 8 * fq;
    Q0 = *(const bf16x8*)qsrc; Q1 = *(const bf16x8*)(qsrc + 32);
}
__device__ __forceinline__ void att_compute(int idx, bf16* O3, float* ML, LAS unsigned char* lds, int wave, int lane, const bf16x8 Q0, const bf16x8 Q1) {
    int g, b, h, d, n, r; att_decode(idx, g, b, h, d, n, r);
    const LAS bf16* Ks = (const LAS bf16*)lds;
    const LAS bf16* Vs = (const LAS bf16*)(lds + 36864);
    const int fr = lane & 15, fq = lane >> 4;
    const int i = 16 * wave + fr;
    const size_t rowq = (size_t)b * 2048 + (size_t)d * (128 * n + i) + r;
    const int start = wave & ~1; const int lo = (n == 0) ? 8 : start;
    f32x4 S[10]; float mx = -1e30f;
#pragma unroll
    for (int p = 0; p < 10; ++p) { const int tile = start + p;
        if (tile >= lo) {
            const LAS bf16* kp = Ks + (tile * 16 + fr) * 72 + 8 * fq;
            const bf16x8 K0 = *(const LAS bf16x8*)kp, K1 = *(const LAS bf16x8*)(kp + 32);
            f32x4 s = (f32x4){0.f, 0.f, 0.f, 0.f};
            s = __builtin_amdgcn_mfma_f32_16x16x32_bf16(K0, Q0, s, 0, 0, 0); s = __builtin_amdgcn_mfma_f32_16x16x32_bf16(K1, Q1, s, 0, 0, 0);
#pragma unroll
            for (int e = 0; e < 4; ++e) { const int j = tile * 16 + 4 * fq + e; const bool valid = (j >= i) && (j <= i + 128); s[e] = valid ? s[e] * 0.125f : -1e30f; mx = fmaxf(mx, s[e]); }
            S[p] = s;
        } else S[p] = (f32x4){-1e30f, -1e30f, -1e30f, -1e30f};
    }
    mx = fmaxf(mx, __shfl_xor(mx, 16)); mx = fmaxf(mx, __shfl_xor(mx, 32));
    float l = 0.f;
#pragma unroll
    for (int p = 0; p < 10; ++p)
#pragma unroll
        for (int e = 0; e < 4; ++e) { const float ex = __expf(S[p][e] - mx); S[p][e] = ex; l += ex; }
    l += __shfl_xor(l, 16); l += __shfl_xor(l, 32);
    f32x4 O[4];
#pragma unroll
    for (int dt = 0; dt < 4; ++dt) O[dt] = (f32x4){0.f, 0.f, 0.f, 0.f};
#pragma unroll
    for (int pp = 0; pp < 5; ++pp) {
        if (start + 2 * pp >= lo) {
            v4u pw; pw.x = pk2(S[2 * pp][0], S[2 * pp][1]); pw.y = pk2(S[2 * pp][2], S[2 * pp][3]); pw.z = pk2(S[2 * pp + 1][0], S[2 * pp + 1][1]); pw.w = pk2(S[2 * pp + 1][2], S[2 * pp + 1][3]);
            const bf16x8 Pf = __builtin_bit_cast(bf16x8, pw);
            const LAS bf16* vbase = Vs + ((start + 2 * pp) * 16 + 4 * fq + (fr >> 2)) * 72 + 4 * (fr & 3);
#pragma unroll
            for (int dt = 0; dt < 4; ++dt) { const s16x4 va = lds_tr(vbase + 16 * dt), vb = lds_tr(vbase + 16 * 72 + 16 * dt);
                const bf16x8 Vf = (bf16x8){va[0], va[1], va[2], va[3], vb[0], vb[1], vb[2], vb[3]};
                O[dt] = __builtin_amdgcn_mfma_f32_16x16x32_bf16(Vf, Pf, O[dt], 0, 0, 0); }
        }
    }
    const float inv = 1.f / l;
    bf16* op = O3 + ((size_t)g * MT + rowq) * 512 + h * 64 + 4 * fq;
#pragma unroll
    for (int dt = 0; dt < 4; ++dt) { v2u w; w.x = pk2(O[dt][0] * inv, O[dt][1] * inv); w.y = pk2(O[dt][2] * inv, O[dt][3] * inv); *(v2u*)(op + 16 * dt) = w; }
    if (fq == 0) { float* mp = ML + (((size_t)g * MT + rowq) * 8 + h) * 2; *(f32x2*)mp = (f32x2){mx, l}; }
}

__device__ __forceinline__ void gmlp_item(int idx, const bf16* PROJ, const float* VST, const float* Wsp, const float* bsp, const float* lng, const float* lnb, bf16* YA,
                                          LAS unsigned char* lds, int tid, int wave, int lane) {
    const int ci = idx >> 3, g = idx & 7; const int row0 = ci * 128;
    LAS bf16* VN = (LAS bf16*)lds;
    LAS bf16* WS = (LAS bf16*)(lds + 34816);
    const int s = tid >> 2, cp = tid & 3;
    const int fr = lane & 15, fq = lane >> 4;
    const int t = 16 * wave + fr;
    const f32x4 st0 = ((const f32x4*)(VST + (size_t)(row0 + s) * 32))[2 * cp], st1 = ((const f32x4*)(VST + (size_t)(row0 + s) * 32))[2 * cp + 1];
    const bf16* vp = PROJ + (size_t)(row0 + s) * DIN + C_V + g * 128 + cp * 32;
    v4u vraw[4];
#pragma unroll
    for (int c = 0; c < 4; ++c) vraw[c] = *(const v4u*)(vp + 8 * c);
    const float* wp = Wsp + ((size_t)g * 128 + s) * 128 + cp * 32;
    f32x4 wv[8];
#pragma unroll
    for (int c = 0; c < 8; ++c) wv[c] = ((const f32x4*)wp)[c];
    const size_t rowt = (size_t)row0 + t;
    const bf16* up = PROJ + rowt * DIN + g * 128 + 4 * fq;
    v2u uu[8], zz[8];
#pragma unroll
    for (int ct = 0; ct < 8; ++ct) { uu[ct] = *(const v2u*)(up + C_U + 16 * ct); zz[ct] = *(const v2u*)(up + C_Z + 16 * ct); }
    const float bs = bsp[g * 128 + t];
    float sm = (st0[0] + st0[2]) + (st1[0] + st1[2]), sq = (st0[1] + st0[3]) + (st1[1] + st1[3]);
    sm += __shfl_xor(sm, 1); sm += __shfl_xor(sm, 2); sq += __shfl_xor(sq, 1); sq += __shfl_xor(sq, 2);
    const float mu = sm * (1.f / 1024.f); const float rstd = rsqrtf(sq * (1.f / 1024.f) - mu * mu + EPS);
#pragma unroll
    for (int c = 0; c < 4; ++c) { const f32x4 a = wv[2 * c], b2 = wv[2 * c + 1]; const int s0 = cp * 32 + 8 * c;
        float v[8] = {a[0], a[1], a[2], a[3], b2[0], b2[1], b2[2], b2[3]};
#pragma unroll
        for (int e = 0; e < 8; ++e) v[e] = (s0 + e <= s) ? v[e] : 0.f;
        v4u w; w.x = pk2(v[0], v[1]); w.y = pk2(v[2], v[3]); w.z = pk2(v[4], v[5]); w.w = pk2(v[6], v[7]);
        *(LAS v4u*)(WS + s * 136 + s0) = w; }
#pragma unroll
    for (int c = 0; c < 4; ++c) { const v4u raw = vraw[c]; const int ch = g * 128 + cp * 32 + 8 * c;
        const f32x4 g0 = *(const f32x4*)(lng + ch), g1 = *(const f32x4*)(lng + ch + 4), b0 = *(const f32x4*)(lnb + ch), b1 = *(const f32x4*)(lnb + ch + 4);
        v4u w;
        w.x = pk2((bflo(raw.x) - mu) * rstd * g0[0] + b0[0], (bfhi(raw.x) - mu) * rstd * g0[1] + b0[1]);
        w.y = pk2((bflo(raw.y) - mu) * rstd * g0[2] + b0[2], (bfhi(raw.y) - mu) * rstd * g0[3] + b0[3]);
        w.z = pk2((bflo(raw.z) - mu) * rstd * g1[0] + b1[0], (bfhi(raw.z) - mu) * rstd * g1[1] + b1[1]);
        w.w = pk2((bflo(raw.w) - mu) * rstd * g1[2] + b1[2], (bfhi(raw.w) - mu) * rstd * g1[3] + b1[3]);
        *(LAS v4u*)(VN + s * 136 + cp * 32 + 8 * c) = w; }
    __syncthreads();
    const int nks = (wave >> 1) + 1;
    f32x4 acc[8];
#pragma unroll
    for (int ct = 0; ct < 8; ++ct) acc[ct] = (f32x4){0.f, 0.f, 0.f, 0.f};
#pragma unroll
    for (int ks = 0; ks < 4; ++ks) {
        if (ks < nks) { const bf16x8 Wf = *(const LAS bf16x8*)(WS + t * 136 + 32 * ks + 8 * fq);
            const LAS bf16* vb = VN + (32 * ks + 8 * fq + (fr >> 2)) * 136 + 4 * (fr & 3);
#pragma unroll
            for (int ct = 0; ct < 8; ++ct) { const s16x4 va = lds_tr(vb + 16 * ct), vb2 = lds_tr(vb + 4 * 136 + 16 * ct);
                const bf16x8 Vf = (bf16x8){va[0], va[1], va[2], va[3], vb2[0], vb2[1], vb2[2], vb2[3]};
                acc[ct] = __builtin_amdgcn_mfma_f32_16x16x32_bf16(Vf, Wf, acc[ct], 0, 0, 0); } }
    }
    bf16* yp = YA + rowt * DM + g * 128 + 4 * fq;
#pragma unroll
    for (int ct = 0; ct < 8; ++ct) {
        const float y0 = bflo(uu[ct].x) * (acc[ct][0] + bs) * silu(bflo(zz[ct].x)), y1 = bfhi(uu[ct].x) * (acc[ct][1] + bs) * silu(bfhi(zz[ct].x));
        const float y2 = bflo(uu[ct].y) * (acc[ct][2] + bs) * silu(bflo(zz[ct].y)), y3 = bfhi(uu[ct].y) * (acc[ct][3] + bs) * silu(bfhi(zz[ct].y));
        v2u w; w.x = pk2(y0, y1); w.y = pk2(y2, y3); *(v2u*)(yp + 16 * ct) = w; }
    __syncthreads();
}

__device__ __forceinline__ void gmlp_sample_item(int b, const bf16* PROJ, const float* VST, const float* Wsp, const float* bsp, const float* lng, const float* lnb, bf16* YA, float* out,
                                                 LAS unsigned char* lds, int tid, int wave, int lane) {
    const int r0 = MP + b * 8;
    LAS float* st = (LAS float*)lds;
    if (tid < 8) { const float* p = VST + (size_t)(r0 + tid) * 32; float s = 0.f, q = 0.f;
#pragma unroll
        for (int k = 0; k < 8; ++k) { const f32x4 a = ((const f32x4*)p)[k]; s += a[0] + a[2]; q += a[1] + a[3]; }
        const float mu = s * (1.f / 1024.f); const float var = q * (1.f / 1024.f) - mu * mu; st[2 * tid] = mu; st[2 * tid + 1] = rsqrtf(var + EPS); }
    __syncthreads();
    const int ch = 2 * tid, g = wave;
    const float lg0 = lng[ch], lg1 = lng[ch + 1], lb0 = lnb[ch], lb1 = lnb[ch + 1];
    float vn0[8], vn1[8];
#pragma unroll
    for (int s = 0; s < 8; ++s) { const unsigned raw = *(const unsigned*)(PROJ + (size_t)(r0 + s) * DIN + C_V + ch); const float mu = st[2 * s], rstd = st[2 * s + 1];
        vn0[s] = (bflo(raw) - mu) * rstd * lg0 + lb0; vn1[s] = (bfhi(raw) - mu) * rstd * lg1 + lb1;
        *(f32x2*)(out + O_VCH + (size_t)(b * 8 + s) * 1024 + ch) = (f32x2){vn0[s], vn1[s]}; }
#pragma unroll
    for (int t = 0; t < 8; ++t) { float z0 = bsp[g * 128 + t], z1 = z0;
#pragma unroll
        for (int s = 0; s < 8; ++s) if (s <= t) { const float w = Wsp[((size_t)g * 128 + t) * 128 + s]; z0 += w * vn0[s]; z1 += w * vn1[s]; }
        const unsigned uu = *(const unsigned*)(PROJ + (size_t)(r0 + t) * DIN + C_U + ch), zz = *(const unsigned*)(PROJ + (size_t)(r0 + t) * DIN + C_Z + ch);
        *(unsigned*)(YA + (size_t)(r0 + t) * DM + ch) = pk2(bflo(uu) * z0 * silu(bflo(zz)), bfhi(uu) * z1 * silu(bfhi(zz))); }
    __syncthreads();
}

__device__ __forceinline__ f32x4 sa_load(const bf16* PROJ, const float* cache, int b, int lw, int ix, int pcol, int ccol, bool maybe_new) {
    if (maybe_new && ix >= lw) { const v2u raw = *(const v2u*)(PROJ + (size_t)(MP + b * 8 + ix - lw) * DIN + pcol); return (f32x4){bflo(raw.x), bfhi(raw.x), bflo(raw.y), bfhi(raw.y)}; }
    const int ic = ix < lw ? ix : lw - 1;
    return *(const f32x4*)(cache + (size_t)ic * 1024 + ccol);
}
__device__ __forceinline__ void attn_sample_item(int idx, const bf16* PROJ, const float* c128, const float* c512, const float* c2048, bf16* O3, float* ML, int wave, int lane) {
    const int b = idx / 24; const int rem = idx - b * 24; const int g = rem >> 3, t = rem & 7; const int h = wave;
    const int lw = g == 0 ? 128 : (g == 1 ? 512 : 2048), d = g == 0 ? 1 : (g == 1 ? 4 : 16);
    const float* cache = (g == 0 ? c128 : (g == 1 ? c512 : c2048)) + (size_t)b * lw * 1024;
    const size_t rq = (size_t)MP + b * 8 + t;
    const int ks = lane >> 4, dq = lane & 15;
    const int hc = g * 512 + h * 64 + 4 * dq;
    const v2u qraw = *(const v2u*)(PROJ + rq * DIN + C_Q + hc);
    const float q0 = bflo(qraw.x) * 0.125f, q1 = bfhi(qraw.x) * 0.125f, q2 = bflo(qraw.y) * 0.125f, q3 = bfhi(qraw.y) * 0.125f;
    const float* kbase = cache + h * 64;
    const unsigned lo4 = 4u * (unsigned)dq;
    constexpr int NVA = 8;
    const int ixb = lw + t - d * ks;
    f32x4 kk[33], va[NVA];
#pragma unroll
    for (int it = 0; it < 33; ++it) { int ix = (it < 32 || ks == 0) ? ixb - 4 * d * it : lw + t - 128 * d; ix = ix < lw ? ix : lw - 1; kk[it] = *(const f32x4*)(kbase + ((unsigned)ix * 1024u + lo4)); }
#pragma unroll
    for (int it = 0; it < NVA; ++it) { int ix = ixb - 4 * d * it; ix = ix < lw ? ix : lw - 1; va[it] = *(const f32x4*)(kbase + ((unsigned)ix * 1024u + 512u + lo4)); }
#pragma unroll
    for (int it = 0; it < 2; ++it) { const int ix = ixb - 4 * d * it;
        if (ix >= lw) { const bf16* pr = PROJ + (size_t)(MP + b * 8 + ix - lw) * DIN + hc; const v2u rk = *(const v2u*)(pr + C_K), rv = *(const v2u*)(pr + C_VV);
            kk[it] = (f32x4){bflo(rk.x), bfhi(rk.x), bflo(rk.y), bfhi(rk.y)}; va[it] = (f32x4){bflo(rv.x), bfhi(rv.x), bflo(rv.y), bfhi(rv.y)}; } }
    float s[33]; float mx = -1e30f;
#pragma unroll
    for (int it = 0; it < 33; ++it) {
        float a = (kk[it][0] * q0 + kk[it][1] * q1) + (kk[it][2] * q2 + kk[it][3] * q3);
        a += __shfl_xor(a, 1); a += __shfl_xor(a, 2); a += __shfl_xor(a, 4); a += __shfl_xor(a, 8);
        s[it] = ((it < 32) || (ks == 0)) ? a : -1e30f; mx = fmaxf(mx, s[it]);
    }
    __builtin_amdgcn_sched_barrier(0);
    f32x4 vb[33 - NVA];
#pragma unroll
    for (int it = NVA; it < 33; ++it) { int ix = (it < 32 || ks == 0) ? ixb - 4 * d * it : lw + t - 128 * d; vb[it - NVA] = *(const f32x4*)(kbase + ((unsigned)ix * 1024u + 512u + lo4)); }
    mx = fmaxf(mx, __shfl_xor(mx, 16)); mx = fmaxf(mx, __shfl_xor(mx, 32));
    float l = 0.f;
#pragma unroll
    for (int it = 0; it < 33; ++it) { s[it] = __expf(s[it] - mx); l += s[it]; }
    l += __shfl_xor(l, 16); l += __shfl_xor(l, 32);
    f32x4 o = (f32x4){0.f, 0.f, 0.f, 0.f};
#pragma unroll
    for (int it = 0; it < NVA; ++it) o += va[it] * s[it];
#pragma unroll
    for (int it = NVA; it < 33; ++it) o += vb[it - NVA] * s[it];
#pragma unroll
    for (int e = 0; e < 4; ++e) { o[e] += __shfl_xor(o[e], 16); o[e] += __shfl_xor(o[e], 32); }
    const float inv = 1.f / l;
    if (ks == 0) { v2u w; w.x = pk2(o[0] * inv, o[1] * inv); w.y = pk2(o[2] * inv, o[3] * inv); *(v2u*)(O3 + ((size_t)g * MT + rq) * 512 + h * 64 + 4 * dq) = w; }
    if (lane == 0) { float* mp = ML + (((size_t)g * MT + rq) * 8 + h) * 2; mp[0] = mx; mp[1] = l; }
}

template <int MW, int NT>
__device__ __forceinline__ void sg_mma(f32x4 (&acc)[MW][NT], const bf16* A, const bf16* Bt, int K, int lane) {
    const int fr = lane & 15, fq = lane >> 4;
    const bf16* ap = A + (size_t)fr * K + 8 * fq; const bf16* bp = Bt + (size_t)fr * K + 8 * fq;
    constexpr int UNR = (MW * NT == 1) ? 16 : 4;
#pragma unroll UNR
    for (int ks = 0; ks < K / 32; ++ks) {
        bf16x8 a[MW], b[NT];
#pragma unroll
        for (int mi = 0; mi < MW; ++mi) a[mi] = *(const bf16x8*)(ap + (size_t)mi * 16 * K + 32 * ks);
#pragma unroll
        for (int ni = 0; ni < NT; ++ni) b[ni] = *(const bf16x8*)(bp + (size_t)ni * 16 * K + 32 * ks);
#pragma unroll
        for (int mi = 0; mi < MW; ++mi)
#pragma unroll
            for (int ni = 0; ni < NT; ++ni) acc[mi][ni] = __builtin_amdgcn_mfma_f32_16x16x32_bf16(b[ni], a[mi], acc[mi][ni], 0, 0, 0);
    }
}
__device__ __forceinline__ void sg_proj_task(int ts, const bf16* H, const bf16* WIN_T, bf16* PROJ, float* out, float* VST, int wave, int lane) {
    const int fr = lane & 15, fq = lane >> 4; const int n0 = 64 * ts; const int r0 = MP + 32 * wave;
    f32x4 acc[2][4];
#pragma unroll
    for (int mi = 0; mi < 2; ++mi)
#pragma unroll
        for (int ni = 0; ni < 4; ++ni) acc[mi][ni] = (f32x4){0.f, 0.f, 0.f, 0.f};
    sg_mma<2, 4>(acc, H + (size_t)r0 * DM, WIN_T + (size_t)n0 * DM, DM, lane);
#pragma unroll
    for (int mi = 0; mi < 2; ++mi) { const int row = r0 + 16 * mi + fr;
#pragma unroll
        for (int ni = 0; ni < 4; ++ni) { const int col = n0 + 16 * ni + 4 * fq; const f32x4 v = acc[mi][ni];
            v2u w; w.x = pk2(v[0], v[1]); w.y = pk2(v[2], v[3]); *(v2u*)(PROJ + (size_t)row * DIN + col) = w;
            if (col >= C_K && col < C_ZB) { const int kv = col >= C_VV ? 1 : 0; const int cc = col - (kv ? C_VV : C_K); const int g = cc >> 9, hc = cc & 511;
                const size_t obs = g == 0 ? O_KVS0 : (g == 1 ? O_KVS1 : O_KVS2);
                *(f32x4*)(out + obs + (size_t)(row - MP) * 1024 + kv * 512 + hc) = v; } }
        if (n0 >= C_V && n0 < C_Z) { float s = 0.f, q = 0.f;
#pragma unroll
            for (int ni = 0; ni < 4; ++ni) { const f32x4 x = acc[mi][ni]; s += (x[0] + x[1]) + (x[2] + x[3]); q += (x[0] * x[0] + x[1] * x[1]) + (x[2] * x[2] + x[3] * x[3]); }
            s += __shfl_xor(s, 16); s += __shfl_xor(s, 32); q += __shfl_xor(q, 16); q += __shfl_xor(q, 32);
            if (fq == 0) *(f32x2*)(VST + ((size_t)row * 16 + ((n0 - C_V) >> 6)) * 2) = (f32x2){s, q}; } }
}
__device__ __forceinline__ void sg_merge_task(int ts, const bf16* YA, const bf16* YB, const bf16* WPA_T, const bf16* WPB_T, const bf16* PROJ, bf16* MRG, int wave, int lane) {
    const int fr = lane & 15, fq = lane >> 4; const int n0 = 16 * (ts & 63); const int r0 = MP + 128 * (ts >> 6) + 16 * wave;
    f32x4 aa[1][1], ab[1][1]; aa[0][0] = (f32x4){0.f, 0.f, 0.f, 0.f}; ab[0][0] = (f32x4){0.f, 0.f, 0.f, 0.f};
    sg_mma<1, 1>(aa, YA + (size_t)r0 * DM, WPA_T + (size_t)n0 * DM, DM, lane);
    sg_mma<1, 1>(ab, YB + (size_t)r0 * 512, WPB_T + (size_t)n0 * 512, 512, lane);
    const size_t row = (size_t)r0 + fr; const int col = n0 + 4 * fq;
    const v2u ga = *(const v2u*)(PROJ + row * DIN + C_GA + col), gb = *(const v2u*)(PROJ + row * DIN + C_GB + col);
    const float m0 = aa[0][0][0] * sigm(bflo(ga.x)) + ab[0][0][0] * sigm(bflo(gb.x)), m1 = aa[0][0][1] * sigm(bfhi(ga.x)) + ab[0][0][1] * sigm(bfhi(gb.x));
    const float m2 = aa[0][0][2] * sigm(bflo(ga.y)) + ab[0][0][2] * sigm(bflo(gb.y)), m3 = aa[0][0][3] * sigm(bfhi(ga.y)) + ab[0][0][3] * sigm(bfhi(gb.y));
    v2u w; w.x = pk2(m0, m1); w.y = pk2(m2, m3); *(v2u*)(MRG + row * DM + col) = w;
}
__device__ __forceinline__ void sg_out_task(int ts, const bf16* MRG, const bf16* WOUT_T, bf16* OUTB, int wave, int lane) {
    const int fr = lane & 15, fq = lane >> 4; const int n0 = 16 * (ts & 63); const int r0 = MP + 128 * (ts >> 6) + 16 * wave;
    f32x4 aa[1][1]; aa[0][0] = (f32x4){0.f, 0.f, 0.f, 0.f};
    sg_mma<1, 1>(aa, MRG + (size_t)r0 * DM, WOUT_T + (size_t)n0 * DM, DM, lane);
    { v2u w; w.x = pk2(aa[0][0][0], aa[0][0][1]); w.y = pk2(aa[0][0][2], aa[0][0][3]); *(v2u*)(OUTB + ((size_t)r0 + fr) * DM + n0 + 4 * fq) = w; }
}

struct Args { const float* in[19]; float* out; unsigned char* ws; };
__global__ void __launch_bounds__(NTHR, 2) fwd_kernel(Args args) {
    extern __shared__ __attribute__((aligned(16))) unsigned char lds_raw[];
    cg::grid_group grid = cg::this_grid();
    LAS unsigned char* lds = (LAS unsigned char*)lds_raw;
    const int tid = threadIdx.x, lane = tid & 63, wave = __builtin_amdgcn_readfirstlane(tid >> 6);
    const int G = gridDim.x, bx = blockIdx.x;
    const int gw = bx * NWAVES + wave, NGW = G * NWAVES;
    const float* xp = args.in[0]; const float* xs = args.in[1];
    const float* c128 = args.in[2]; const float* c512 = args.in[3]; const float* c2048 = args.in[4];
    const float* cpr = args.in[5]; const float* csm = args.in[6]; const float* wcond = args.in[7]; const float* bcond = args.in[8]; const float* gpre = args.in[9];
    const float* win = args.in[10]; const float* lng = args.in[11]; const float* lnb = args.in[12]; const float* wsp = args.in[13]; const float* bsp = args.in[14];
    const float* wpa = args.in[15]; const float* wpb = args.in[16]; const float* wout = args.in[17]; const float* gpost = args.in[18];
    float* out = args.out; unsigned char* ws = args.ws;
    bf16* WIN_T = (bf16*)(ws + WS_WIN); bf16* WPA_T = (bf16*)(ws + WS_WPA); bf16* WPB_T = (bf16*)(ws + WS_WPB); bf16* WOUT_T = (bf16*)(ws + WS_WOUT);
    float* MOD = (float*)(ws + WS_MOD); float* VST = (float*)(ws + WS_VST); float* ML = (float*)(ws + WS_ML);
    bf16* H = (bf16*)(ws + WS_H); bf16* YA = (bf16*)(ws + WS_YA); bf16* YB = (bf16*)(ws + WS_YB); bf16* MRG = (bf16*)(ws + WS_MRG); bf16* O3 = (bf16*)(ws + WS_O3);
    bf16* PART = (bf16*)(ws + WS_PART); bf16* OUTB = (bf16*)(ws + WS_OUT); bf16* PROJ = (bf16*)(ws + WS_PROJ);

    unsigned* barw = (unsigned*)(ws + 16384);
    volatile LAS unsigned* bst = (volatile LAS unsigned*)(lds + 139264);
    if (tid < 2) bst[tid] = 0u;
    __syncthreads();
    const XcdBarrier xbar = xcd_barrier_post(barw, bst);
    if (args.ws == nullptr) grid.sync();
    if (bx < 192) mod_task(bx, cpr, csm, wcond, bcond, MOD, lds, tid, wave, lane);
    {
        LAS float* scr = (LAS float*)(lds + wave * 16384);
        constexpr int I_IN = (1024 / 64) * (DIN / 32), I_PA = (1024 / 64) * (1024 / 32), I_PB = (512 / 64) * (1024 / 32), I_OUT = I_PA;
        constexpr int NITEMS = I_IN + I_PA + I_PB + I_OUT;
        for (int it = gw; it < NITEMS; it += NGW) {
            int r = it;
            if (r < I_IN) { p0_transpose_item(win, 1024, DIN, WIN_T, 0, scr, r, lane); continue; } r -= I_IN;
            if (r < I_PA) { p0_transpose_item(wpa, 1024, 1024, WPA_T, 0, scr, r, lane); continue; } r -= I_PA;
            if (r < I_PB) { p0_transpose_item(wpb, 512, 1024, WPB_T, 0, scr, r, lane); continue; } r -= I_PB;
            p0_transpose_item(wout, 1024, 1024, WOUT_T, 0, scr, r, lane);
        }
    }
    xcd_barrier(xbar);
    for (int rb = gw; rb < MT / 8; rb += NGW) {
        const int rowb = rb * 8;
        const float* mod = MOD + (rowb < MP ? (rowb >> 11) : 8 + ((rowb - MP) >> 3)) * 3072;
        f32x4 gs[4], sh[4];
#pragma unroll
        for (int j = 0; j < 4; ++j) { const int c = 4 * lane + 256 * j; f32x4 a = (f32x4){0.f, 0.f, 0.f, 0.f}, s2 = (f32x4){1.f, 1.f, 1.f, 1.f};
#pragma unroll
            for (int q = 0; q < 4; ++q) { a += *(const f32x4*)(mod + (size_t)q * 40 * 3072 + c); s2 += *(const f32x4*)(mod + (size_t)q * 40 * 3072 + 1024 + c); }
            sh[j] = a; gs[j] = s2 * *(const f32x4*)(gpre + c); }
        const float* xb = rowb < MP ? xp + (size_t)rowb * DM : xs + (size_t)(rowb - MP) * DM;
#pragma unroll 1
        for (int i0 = 0; i0 < 8; i0 += 4) {
            f32x4 v[4][4];
#pragma unroll
            for (int i = 0; i < 4; ++i)
#pragma unroll
                for (int j = 0; j < 4; ++j) v[i][j] = ((const f32x4*)(xb + (size_t)(i0 + i) * DM))[lane + 64 * j];
#pragma unroll
            for (int i = 0; i < 4; ++i) { float ss = 0.f;
#pragma unroll
                for (int j = 0; j < 4; ++j) ss += (v[i][j][0] * v[i][j][0] + v[i][j][1] * v[i][j][1]) + (v[i][j][2] * v[i][j][2] + v[i][j][3] * v[i][j][3]);
                const float rstd = rsqrtf(wave_sum(ss) * (1.f / DM) + EPS);
#pragma unroll
                for (int j = 0; j < 4; ++j) { const int c = 4 * lane + 256 * j; const f32x4 hh = v[i][j] * rstd * gs[j] + sh[j];
                    v2u w; w.x = pk2(hh[0], hh[1]); w.y = pk2(hh[2], hh[3]); *(v2u*)(H + (size_t)(rowb + i0 + i) * DM + c) = w; } } }
    }
    xcd_barrier(xbar);
    {
        if (bx < 160) sg_proj_task(bx, H, WIN_T, PROJ, out, VST, wave, lane);
        pg8::Gemm gm{H, WIN_T, MP, DIN, DM}; pg8::StaticOrder S; S.init(MP, DIN, G, bx);
        pg8::EpiProj E{PROJ, out, VST};
        pg8::gemm_phase<pg8::EpiProj, pg8::StaticOrder, true, true>(lds, gm, S, E);
    }
    xcd_barrier(xbar);
    {
        constexpr int N_ATT = 3072, N_GM = 1024, N_SA = 768, N_SG = 32;
        {
            v4u kA[4], vA[4], kB[4], vB[4]; bf16x8 qA0, qA1, qB0, qB1;
            if (bx < N_ATT) att_prefetch(bx, PROJ, tid, wave, lane, kA, vA, qA0, qA1);
            if (bx + G < N_ATT) att_prefetch(bx + G, PROJ, tid, wave, lane, kB, vB, qB0, qB1);
            const int key = tid >> 1, half = tid & 1;
            LAS bf16* kdst = (LAS bf16*)lds + key * 72 + half * 32; LAS bf16* vdst = (LAS bf16*)(lds + 36864) + key * 72 + half * 32;
            for (int it = bx; it < N_ATT; it += 2 * G) {
                {
#pragma unroll
                    for (int c = 0; c < 4; ++c) { *(LAS v4u*)(kdst + 8 * c) = kA[c]; *(LAS v4u*)(vdst + 8 * c) = vA[c]; }
                    const bf16x8 Qc0 = qA0, Qc1 = qA1;
                    __syncthreads();
                    if (it + 2 * G < N_ATT) att_prefetch(it + 2 * G, PROJ, tid, wave, lane, kA, vA, qA0, qA1);
                    att_compute(it, O3, ML, lds, wave, lane, Qc0, Qc1);
                    __syncthreads();
                }
                if (it + G < N_ATT) {
#pragma unroll
                    for (int c = 0; c < 4; ++c) { *(LAS v4u*)(kdst + 8 * c) = kB[c]; *(LAS v4u*)(vdst + 8 * c) = vB[c]; }
                    const bf16x8 Qc0 = qB0, Qc1 = qB1;
                    __syncthreads();
                    if (it + 3 * G < N_ATT) att_prefetch(it + 3 * G, PROJ, tid, wave, lane, kB, vB, qB0, qB1);
                    att_compute(it + G, O3, ML, lds, wave, lane, Qc0, Qc1);
                    __syncthreads();
                }
            }
        }
        for (int it = bx; it < N_GM; it += G) gmlp_item(it, PROJ, VST, wsp, bsp, lng, lnb, YA, lds, tid, wave, lane);
        for (int it = bx; it < N_SA; it += G) attn_sample_item(it, PROJ, c128, c512, c2048, O3, ML, wave, lane);
        for (int it = bx; it < N_SG; it += G) gmlp_sample_item(it, PROJ, VST, wsp, bsp, lng, lnb, YA, out, lds, tid, wave, lane);
    }
    xcd_barrier(xbar);
    for (int row = gw; row < MT; row += NGW) {
        const int head = lane >> 3;
        float mg[3], lg[3];
#pragma unroll
        for (int g = 0; g < 3; ++g) { const f32x2 a = *(const f32x2*)(ML + (((size_t)g * MT + row) * 8 + head) * 2); mg[g] = a[0]; lg[g] = a[1]; }
        const float mm = fmaxf(fmaxf(mg[0], mg[1]), mg[2]);
        float wg[3]; float den = 0.f;
#pragma unroll
        for (int g = 0; g < 3; ++g) { wg[g] = __expf(mg[g] - mm) * lg[g]; den += wg[g]; }
        const float rden = 1.f / den;
        float o[8] = {0.f, 0.f, 0.f, 0.f, 0.f, 0.f, 0.f, 0.f};
#pragma unroll
        for (int g = 0; g < 3; ++g) { const v4u raw = *(const v4u*)(O3 + ((size_t)g * MT + row) * 512 + lane * 8); const float w = wg[g] * rden;
            o[0] += w * bflo(raw.x); o[1] += w * bfhi(raw.x); o[2] += w * bflo(raw.y); o[3] += w * bfhi(raw.y); o[4] += w * bflo(raw.z); o[5] += w * bfhi(raw.z); o[6] += w * bflo(raw.w); o[7] += w * bfhi(raw.w); }
        const v4u zr = *(const v4u*)(PROJ + (size_t)row * DIN + C_ZB + lane * 8);
        v4u w; w.x = pk2(o[0] * silu(bflo(zr.x)), o[1] * silu(bfhi(zr.x))); w.y = pk2(o[2] * silu(bflo(zr.y)), o[3] * silu(bfhi(zr.y)));
        w.z = pk2(o[4] * silu(bflo(zr.z)), o[5] * silu(bfhi(zr.z))); w.w = pk2(o[6] * silu(bflo(zr.w)), o[7] * silu(bfhi(zr.w)));
        *(v4u*)(YB + (size_t)row * 512 + lane * 8) = w;
    }
    xcd_barrier(xbar);
    {
        if (bx < 128) sg_merge_task(bx, YA, YB, WPA_T, WPB_T, PROJ, MRG, wave, lane);
        pg8::Gemm gm{YA, WPA_T, MP, DM, DM}; pg8::StaticOrder S; S.init(MP, DM, G, bx);
        pg8::EpiGateA E{PROJ, PART};
        pg8::gemm_phase<pg8::EpiGateA, pg8::StaticOrder, true, true>(lds, gm, S, E);
    }
    {
        pg8::Gemm gm{YB, WPB_T, MP, DM, 512}; pg8::StaticOrder S; S.init(MP, DM, G, bx);
        pg8::EpiGateB E{PROJ, PART, MRG};
        pg8::gemm_phase<pg8::EpiGateB, pg8::StaticOrder, true, true>(lds, gm, S, E);
    }
    xcd_barrier(xbar);
    {
        if (bx < 128) sg_out_task(bx, MRG, WOUT_T, OUTB, wave, lane);
        pg8::Gemm gm{MRG, WOUT_T, MP, DM, DM}; pg8::StaticOrder S; S.init(MP, DM, G, bx);
        pg8::EpiF32 E{OUTB};
        pg8::gemm_phase<pg8::EpiF32, pg8::StaticOrder, true, true>(lds, gm, S, E);
    }
    xcd_barrier(xbar);
    for (int rb = gw; rb < MT / 8; rb += NGW) {
        const int rowb = rb * 8;
        const float* gate = MOD + (rowb < MP ? (rowb >> 11) : 8 + ((rowb - MP) >> 3)) * 3072 + 2048;
        f32x4 gt[4];
#pragma unroll
        for (int j = 0; j < 4; ++j) { const int c = 4 * lane + 256 * j; f32x4 a = (f32x4){0.f, 0.f, 0.f, 0.f};
#pragma unroll
            for (int q = 0; q < 4; ++q) a += *(const f32x4*)(gate + (size_t)q * 40 * 3072 + c);
            gt[j] = a * *(const f32x4*)(gpost + c); }
        const float* xb = rowb < MP ? xp + (size_t)rowb * DM : xs + (size_t)(rowb - MP) * DM;
#pragma unroll 1
        for (int i0 = 0; i0 < 8; i0 += 4) {
            v2u ov[4][4]; f32x4 xv[4][4];
#pragma unroll
            for (int i = 0; i < 4; ++i)
#pragma unroll
                for (int j = 0; j < 4; ++j) { ov[i][j] = ((const v2u*)(OUTB + (size_t)(rowb + i0 + i) * DM))[lane + 64 * j]; xv[i][j] = ((const f32x4*)(xb + (size_t)(i0 + i) * DM))[lane + 64 * j]; }
#pragma unroll
            for (int i = 0; i < 4; ++i) { f32x4 v[4]; float ss = 0.f;
#pragma unroll
                for (int j = 0; j < 4; ++j) { v[j] = (f32x4){bflo(ov[i][j].x), bfhi(ov[i][j].x), bflo(ov[i][j].y), bfhi(ov[i][j].y)}; ss += (v[j][0] * v[j][0] + v[j][1] * v[j][1]) + (v[j][2] * v[j][2] + v[j][3] * v[j][3]); }
                const float rstd = rsqrtf(wave_sum(ss) * (1.f / DM) + EPS);
#pragma unroll
                for (int j = 0; j < 4; ++j) { const int c = 4 * lane + 256 * j;
                    *(f32x4*)(out + (size_t)(rowb + i0 + i) * DM + c) = xv[i][j] + gt[j] * (v[j] * rstd); } } }
    }
}

extern "C" void kernel_launch(void* const* d_in, const int* in_sizes, int n_in, void* d_out, int out_size, void* d_ws, size_t ws_size, hipStream_t stream) {
    static int grid = 0;
    if (grid == 0) {
        if (n_in != 19 || (size_t)out_size != O_END || ws_size < WS_END) { fprintf(stderr, "kernel_launch: unexpected shapes: n_in %d out %d ws %zu\n", n_in, out_size, ws_size); grid = -1; return; }
        int dev = 0, cus = 0, per_cu = 0;
        if (hipGetDevice(&dev) != hipSuccess || hipDeviceGetAttribute(&cus, hipDeviceAttributeMultiprocessorCount, dev) != hipSuccess) { fprintf(stderr, "kernel_launch: device query failed\n"); grid = -1; return; }
        if (hipFuncSetAttribute((const void*)fwd_kernel, hipFuncAttributeMaxDynamicSharedMemorySize, LDS_BYTES) != hipSuccess) { fprintf(stderr, "kernel_launch: hipFuncSetAttribute failed\n"); grid = -1; return; }
        if (hipOccupancyMaxActiveBlocksPerMultiprocessor(&per_cu, (const void*)fwd_kernel, NTHR, LDS_BYTES) != hipSuccess || per_cu < 1) { fprintf(stderr, "kernel_launch: occupancy query says %d blocks per CU\n", per_cu); }
        (void)hipGetLastError();
        grid = cus;
    }
    if (grid < 0) return;
    if (hipMemsetAsync((char*)d_ws + 16384, 0, 16384, stream) != hipSuccess) { fprintf(stderr, "kernel_launch: memset of the barrier words failed\n"); return; }
    Args a{};
    for (int i = 0; i < 19; ++i) a.in[i] = (const float*)d_in[i];
    a.out = (float*)d_out; a.ws = (unsigned char*)d_ws;
    void* kargs[] = {&a};
    hipError_t e = hipLaunchCooperativeKernel((const void*)fwd_kernel, dim3(grid), dim3(NTHR), kargs, LDS_BYTES, stream);
    if (e != hipSuccess) fprintf(stderr, "kernel_launch: cooperative launch failed: %s (grid %d)\n", hipGetErrorString(e), grid);
}
```

```cpp
#include <hip/hip_runtime.h>
#include <hip/hip_cooperative_groups.h>
#include <cstdio>
#include <cstdint>
namespace cg = cooperative_groups;
namespace pg8 {
#define PG8_LAS __attribute__((address_space(3)))
typedef unsigned short bf16_t;
typedef short bf16x8 __attribute__((ext_vector_type(8)));
typedef float f32x4 __attribute__((ext_vector_type(4)));
typedef unsigned u32x4 __attribute__((ext_vector_type(4)));
constexpr int BM = 256, BK = 64, HALF = 128, HTB = HALF * BK * 2  , STAGE_BYTES = 8 * HTB, NXCD = 8, WGM = 8;

__host__ __device__ __forceinline__ int lds_byte(int r, int c) { const int st = (r >> 4) * 2 + (c >> 5), rr = r & 15, cc = c & 31, ob = rr * 64 + cc * 2; return st * 1024 + (ob ^ (((ob >> 9) & 1) << 5)); }
__host__ __device__ __forceinline__ void stage_rc(int b, int& R, int& C) { const int st = b / 1024, sb = b % 1024, swz = sb ^ (((sb >> 9) & 1) << 5); R = (st >> 1) * 16 + swz / 64; C = (st & 1) * 32 + (swz % 64) / 2; }
__host__ __device__ __forceinline__ int perm32(int rho) { const int n = rho >> 4, i = rho & 15; return 8 * (i >> 2) + 4 * n + (i & 3); }

struct Unit { int pm, pn; };
struct Gemm { const bf16_t* A; const bf16_t* Bt; int M, N, K; };

struct StaticOrder {
    int nM, nN, nwg, G, c;
    __host__ __device__ void init(int M, int N, int G_, int c_) { nM = M / BM; nN = N / BM; nwg = nM * nN; G = G_; c = c_; }
    __host__ __device__ bool next(int i, Unit& u) const {
        const long L = (long)i * G + c; if (L >= nwg) return false;
        int wgid = (int)L; { const int q = nwg / NXCD, r = nwg % NXCD, xcd = wgid % NXCD, off = wgid / NXCD; wgid = (xcd < r ? xcd * (q + 1) : r * (q + 1) + (xcd - r) * q) + off; }
        const int nig = WGM * nN, gid = wgid / nig, fm = gid * WGM, gsz = (nM - fm) < WGM ? (nM - fm) : WGM;
        u.pm = fm + ((wgid % nig) % gsz); u.pn = (wgid % nig) / gsz; return true;
    }
    __device__ __forceinline__ void a_ready(const Unit&) const {}
    __device__ __forceinline__ void done(const Unit&) const {}
};
__device__ __forceinline__ unsigned cvt_pk_bf16(float lo, float hi) { unsigned r; asm volatile("v_cvt_pk_bf16_f32 %0, %1, %2" : "=v"(r) : "v"(lo), "v"(hi)); return r; }
typedef float f32x2 __attribute__((ext_vector_type(2)));
template <class Epi, class Sched, bool ALIGN_EPI = false, bool SP2 = false>
__device__ __forceinline__ void gemm_phase(PG8_LAS unsigned char* lds, const Gemm g, const Sched& S, const Epi& E) {
    const int tid = threadIdx.x, wid = __builtin_amdgcn_readfirstlane(tid >> 6), lane = tid & 63, wr = wid >> 2, wc = wid & 3, fr = lane & 15, fq = lane >> 4;
    const int K = g.K, nt = K / BK;
    unsigned voffA[2], voffB[2];
#pragma unroll
    for (int i = 0; i < 2; ++i) { int R, C; stage_rc(tid * 16 + i * 8192, R, C); const int Rb = Epi::PERM ? ((R & ~31) + perm32(R & 31)) : R;
        voffA[i] = (unsigned)(R * K + C) * 2u; voffB[i] = (unsigned)(Rb * K + C) * 2u; }
    const size_t kstep = (size_t)(BK * 2);
    const size_t hstep = (size_t)HALF * K * 2;
    const size_t tstep = 2 * hstep;
    const unsigned ldsw = (unsigned)wid * 1024u;
    const int aoff = lds_byte(wr * 64 + fr, fq * 8), boff = lds_byte(wc * 32 + fr, fq * 8);
#define PG8_SA(b, h) (((b) * 2 + (h)) * HTB)
#define PG8_SB(b, h) ((4 + (b) * 2 + (h)) * HTB)
#define PG8_STAGE(bufoff, gbase, voff) do { _Pragma("unroll") for (int _i = 0; _i < 2; ++_i) \
        __builtin_amdgcn_global_load_lds((const unsigned*)((const char*)(gbase) + (voff)[_i]), (PG8_LAS unsigned*)(lds + (bufoff) + ldsw + _i * 8192), 16, 0, 0); } while (0)
#define PG8_LDA(dst, b, h) do { _Pragma("unroll") for (int m = 0; m < 4; ++m) _Pragma("unroll") for (int k = 0; k < 2; ++k) dst[m][k] = *(const PG8_LAS bf16x8*)(lds + PG8_SA(b, h) + aoff + m * 2048 + k * 1024); } while (0)
#define PG8_LDB(dst, b, h) do { _Pragma("unroll") for (int n = 0; n < 2; ++n) _Pragma("unroll") for (int k = 0; k < 2; ++k) dst[n][k] = *(const PG8_LAS bf16x8*)(lds + PG8_SB(b, h) + boff + n * 2048 + k * 1024); } while (0)
#define PG8_MMA(ai, bj, At, Bt) do { __builtin_amdgcn_s_setprio(1); _Pragma("unroll") for (int m = 0; m < 4; ++m) _Pragma("unroll") for (int n = 0; n < 2; ++n) _Pragma("unroll") for (int k = 0; k < 2; ++k) \
        acc[ai][bj][m][n] = __builtin_amdgcn_mfma_f32_16x16x32_bf16(Bt[n][k], At[m][k], acc[ai][bj][m][n], 0, 0, 0); __builtin_amdgcn_s_setprio(0); } while (0)
#define PG8_WAIT_V(n) asm volatile("s_waitcnt vmcnt(" #n ")" ::: "memory")
#define PG8_WAIT_L(n) asm volatile("s_waitcnt lgkmcnt(" #n ")" ::: "memory")
#define PG8_BAR __builtin_amdgcn_s_barrier()
#define PG8_SCHED __builtin_amdgcn_sched_barrier(0)
    Unit cur, nxt; int ui = 0;
    if (!S.next(0, cur)) return;
    f32x4 acc[2][2][4][2];
#pragma unroll
    for (int a = 0; a < 2; ++a)
#pragma unroll
        for (int b = 0; b < 2; ++b)
#pragma unroll
            for (int m = 0; m < 4; ++m)
#pragma unroll
                for (int n = 0; n < 2; ++n) acc[a][b][m][n] = (f32x4){0.f, 0.f, 0.f, 0.f};
    bf16x8 At[4][2], B0[2][2], B1[2][2];
    const char* cA = (const char*)g.A + (size_t)cur.pm * tstep; const char* cB = (const char*)g.Bt + (size_t)cur.pn * tstep;
    S.a_ready(cur);
    if constexpr (SP2) {
        PG8_STAGE(PG8_SB(0, 0), cB, voffB); PG8_STAGE(PG8_SB(0, 1), cB + hstep, voffB); PG8_STAGE(PG8_SA(0, 0), cA, voffA); PG8_STAGE(PG8_SA(0, 1), cA + hstep, voffA);
        if (wr == 1) PG8_BAR;
        PG8_WAIT_V(2); PG8_BAR;
        PG8_STAGE(PG8_SB(1, 0), cB + kstep, voffB); PG8_STAGE(PG8_SA(1, 0), cA + kstep, voffA); PG8_STAGE(PG8_SB(1, 1), cB + hstep + kstep, voffB);
        PG8_WAIT_V(6); PG8_BAR;
    } else {
        PG8_STAGE(PG8_SB(0, 0), cB, voffB); PG8_STAGE(PG8_SA(0, 0), cA, voffA); PG8_STAGE(PG8_SB(0, 1), cB + hstep, voffB); PG8_STAGE(PG8_SA(0, 1), cA + hstep, voffA);
        if (wr == 1) PG8_BAR;
        PG8_WAIT_V(4); PG8_BAR;
        PG8_STAGE(PG8_SB(1, 0), cB + kstep, voffB); PG8_STAGE(PG8_SA(1, 0), cA + kstep, voffA); PG8_STAGE(PG8_SB(1, 1), cB + hstep + kstep, voffB);
        PG8_WAIT_V(6); PG8_BAR;
    }
    for (;;) {
        const bool has_next = S.next(ui + 1, nxt);
        const char* nA = has_next ? (const char*)g.A + (size_t)nxt.pm * tstep : cA; const char* nB = has_next ? (const char*)g.Bt + (size_t)nxt.pn * tstep : cB;
        for (int t = 0; t < nt; t += 2) {
            const bool last = (t == nt - 2);
            const char* a1 = cA + (size_t)(t + 1) * kstep;
            const char* a2 = last ? nA : cA + (size_t)(t + 2) * kstep; const char* b2 = last ? nB : cB + (size_t)(t + 2) * kstep;
            const char* a3 = a2 + kstep; const char* b3 = b2 + kstep;
            if (last && has_next) S.a_ready(nxt);
            if constexpr (SP2) {
            PG8_LDB(B0, 0, 0); PG8_LDB(B1, 0, 1); PG8_SCHED; PG8_LDA(At, 0, 0); PG8_STAGE(PG8_SA(1, 1), a1 + hstep, voffA);
            PG8_WAIT_V(8); PG8_WAIT_L(0); PG8_BAR; PG8_MMA(0, 0, At, B0); PG8_MMA(0, 1, At, B1); PG8_BAR; PG8_SCHED;
            PG8_LDA(At, 0, 1); PG8_STAGE(PG8_SB(0, 0), b2, voffB); PG8_STAGE(PG8_SB(0, 1), b2 + hstep, voffB); PG8_STAGE(PG8_SA(0, 0), a2, voffA);
            PG8_WAIT_V(8); PG8_WAIT_L(0); PG8_BAR; PG8_MMA(1, 0, At, B0); PG8_MMA(1, 1, At, B1); PG8_BAR; PG8_SCHED;
            PG8_LDB(B0, 1, 0); PG8_LDB(B1, 1, 1); PG8_SCHED; PG8_LDA(At, 1, 0); PG8_STAGE(PG8_SA(0, 1), a2 + hstep, voffA);
            PG8_WAIT_V(8); PG8_WAIT_L(0); PG8_BAR; PG8_MMA(0, 0, At, B0); PG8_MMA(0, 1, At, B1); PG8_BAR; PG8_SCHED;
            PG8_LDA(At, 1, 1); PG8_STAGE(PG8_SB(1, 0), b3, voffB); PG8_STAGE(PG8_SB(1, 1), b3 + hstep, voffB); PG8_STAGE(PG8_SA(1, 0), a3, voffA);
            PG8_WAIT_V(8); PG8_WAIT_L(0); PG8_BAR; PG8_MMA(1, 0, At, B0); PG8_MMA(1, 1, At, B1); PG8_BAR; PG8_SCHED;
            } else {
            PG8_LDB(B0, 0, 0); PG8_SCHED; PG8_LDA(At, 0, 0); PG8_STAGE(PG8_SA(1, 1), a1 + hstep, voffA);
            PG8_WAIT_L(8); PG8_BAR; PG8_WAIT_L(0); PG8_MMA(0, 0, At, B0); PG8_BAR; PG8_SCHED;
            PG8_LDB(B1, 0, 1); PG8_STAGE(PG8_SB(0, 0), b2, voffB);
            PG8_BAR; PG8_WAIT_L(0); PG8_MMA(0, 1, At, B1); PG8_BAR;
            PG8_LDA(At, 0, 1); PG8_STAGE(PG8_SA(0, 0), a2, voffA);
            PG8_BAR; PG8_WAIT_L(0); PG8_MMA(1, 0, At, B0); PG8_BAR; PG8_SCHED;
            PG8_STAGE(PG8_SB(0, 1), b2 + hstep, voffB);
            PG8_WAIT_V(6); PG8_BAR; PG8_MMA(1, 1, At, B1); PG8_BAR;
            PG8_LDB(B0, 1, 0); PG8_SCHED; PG8_LDA(At, 1, 0); PG8_STAGE(PG8_SA(0, 1), a2 + hstep, voffA);
            PG8_WAIT_L(8); PG8_BAR; PG8_WAIT_L(0); PG8_MMA(0, 0, At, B0); PG8_BAR; PG8_SCHED;
            PG8_LDB(B1, 1, 1); PG8_STAGE(PG8_SB(1, 0), b3, voffB);
            PG8_BAR; PG8_WAIT_L(0); PG8_MMA(0, 1, At, B1); PG8_BAR;
            PG8_LDA(At, 1, 1); PG8_STAGE(PG8_SA(1, 0), a3, voffA);
            PG8_BAR; PG8_WAIT_L(0); PG8_MMA(1, 0, At, B0); PG8_BAR; PG8_SCHED;
            PG8_STAGE(PG8_SB(1, 1), b3 + hstep, voffB);
            PG8_WAIT_V(6); PG8_BAR; PG8_MMA(1, 1, At, B1); PG8_BAR;
            }
        }
        if constexpr (ALIGN_EPI) { if (wr == 0) PG8_BAR; }
        if constexpr (!Epi::AFTER_DRAIN) { E(acc, cur, wr, wc, fr, fq); S.done(cur); }
        if (!has_next) break;
#pragma unroll
        for (int a = 0; a < 2; ++a)
#pragma unroll
            for (int b = 0; b < 2; ++b)
#pragma unroll
                for (int m = 0; m < 4; ++m)
#pragma unroll
                    for (int n = 0; n < 2; ++n) acc[a][b][m][n] = (f32x4){0.f, 0.f, 0.f, 0.f};
        cur = nxt; cA = nA; cB = nB; ++ui;
        if constexpr (ALIGN_EPI) { if (wr == 1) PG8_BAR; }
    }
    PG8_WAIT_V(0);
    if constexpr (!ALIGN_EPI) { if (wr == 0) PG8_BAR; }
    PG8_BAR;
    if constexpr (Epi::AFTER_DRAIN) { E.fused(acc, cur, wr, wc, fr, fq, lds, wid, lane); S.done(cur); }
#undef PG8_SA
#undef PG8_SB
#undef PG8_STAGE
#undef PG8_LDA
#undef PG8_LDB
#undef PG8_MMA
#undef PG8_WAIT_V
#undef PG8_WAIT_L
#undef PG8_BAR
#undef PG8_SCHED
}
}

#define GAS __attribute__((address_space(1)))
#define LAS __attribute__((address_space(3)))
typedef unsigned short bf16;
typedef unsigned v4u __attribute__((ext_vector_type(4)));
typedef unsigned v2u __attribute__((ext_vector_type(2)));
typedef float f32x4 __attribute__((ext_vector_type(4)));
typedef float f32x2 __attribute__((ext_vector_type(2)));
typedef short bf16x8 __attribute__((ext_vector_type(8)));

constexpr int NWAVES = 8, NTHR = 512;
constexpr int DM = 1024, NBP = 8, SEQ = 2048, NBS = 32, TS = 8;
constexpr int MP = NBP * SEQ, MS = NBS * TS, MT = MP + MS;
constexpr int DIN = 10240;
constexpr int C_U = 0, C_V = 1024, C_Z = 2048, C_Q = 3072, C_K = 4608, C_VV = 6144, C_ZB = 7680, C_GA = 8192, C_GB = 9216;
constexpr float EPS = 1e-6f;
constexpr size_t O_Y = 0, O_KVP0 = (size_t)MT * DM, O_KVP1 = O_KVP0 + (size_t)8 * 128 * 1024, O_KVP2 = O_KVP1 + (size_t)8 * 512 * 1024,
                 O_KVS0 = O_KVP2 + (size_t)8 * 2048 * 1024, O_KVS1 = O_KVS0 + 262144, O_KVS2 = O_KVS1 + 262144, O_VCH = O_KVS2 + 262144, O_END = O_VCH + 262144;
constexpr size_t MiB = 1u << 20;
constexpr size_t WS_WIN = 2 * MiB, WS_WPA = 22 * MiB, WS_WPB = 24 * MiB, WS_WOUT = 25 * MiB, WS_MOD = 27 * MiB, WS_VST = 29 * MiB, WS_ML = 32 * MiB,
                 WS_H = 36 * MiB, WS_YA = 70 * MiB, WS_YB = 104 * MiB, WS_MRG = 122 * MiB, WS_O3 = 156 * MiB, WS_PART = 206 * MiB, WS_OUT = 272 * MiB,
                 WS_PROJ = 340 * MiB, WS_END = 672 * MiB;
static_assert(WS_PROJ + (size_t)MT * DIN * 2 <= WS_END, "ws map");
constexpr int LDS_BYTES = 147456;

#define LDS_WAIT() asm volatile("s_waitcnt lgkmcnt(0)" ::: "memory")
__device__ __forceinline__ unsigned f2bf(float f) { unsigned u = __builtin_bit_cast(unsigned, f); return (u + 0x7fffu + ((u >> 16) & 1u)) >> 16; }
typedef __bf16 bf16x2_t __attribute__((ext_vector_type(2)));
__device__ __forceinline__ unsigned pk2(float lo, float hi) { const f32x2 v = {lo, hi}; return __builtin_bit_cast(unsigned, __builtin_convertvector(v, bf16x2_t)); }
__device__ __forceinline__ float bflo(unsigned w) { return __builtin_bit_cast(float, w << 16); }
__device__ __forceinline__ float bfhi(unsigned w) { return __builtin_bit_cast(float, w & 0xffff0000u); }
__device__ __forceinline__ float bf2f(bf16 h) { return __builtin_bit_cast(float, (unsigned)h << 16); }
__device__ __forceinline__ float sigm(float x) { return 1.f / (1.f + __expf(-x)); }
__device__ __forceinline__ float silu(float x) { return x / (1.f + __expf(-x)); }
__device__ __forceinline__ float wave_sum(float v) {
#pragma unroll
    for (int o = 1; o < 64; o <<= 1) v += __shfl_xor(v, o);
    return v;
}
__device__ __forceinline__ float wave_max(float v) {
#pragma unroll
    for (int o = 1; o < 64; o <<= 1) v = fmaxf(v, __shfl_xor(v, o));
    return v;
}
__device__ __forceinline__ float rdlane(float v, int l) { return __builtin_bit_cast(float, __builtin_amdgcn_readlane(__builtin_bit_cast(int, v), l)); }

#define XB_TMO      128
#define XB_XCNT(j)  (256  + 64 * (j))
#define XB_XSUB(j)  (1280 + 64 * (j))
#define XB_XGEN(j)  (2304 + 64 * (j))
#define XB_TOP      3328
#define XB_TOPGEN   3392
#define XCD_BAR_WORDS 3456
#define XB_SPIN_CAP (1u << 18)

__device__ __forceinline__ unsigned xb_ld(unsigned* p)              { return __hip_atomic_load(p, __ATOMIC_RELAXED, __HIP_MEMORY_SCOPE_AGENT); }
__device__ __forceinline__ unsigned xb_add(unsigned* p, unsigned v) { return __hip_atomic_fetch_add(p, v, __ATOMIC_RELAXED, __HIP_MEMORY_SCOPE_AGENT); }
__device__ __forceinline__ unsigned xb_xcc_id() { return (unsigned)__builtin_amdgcn_s_getreg((3 << 11) | 20) & 0xFu; }
#define XB_SPIN(cond, bar) do { unsigned _sp = 0; while (cond) { __builtin_amdgcn_s_sleep(1); \
    if ((++_sp & 255u) == 0u) { if (xb_ld(&(bar)[XB_TMO])) break; if (_sp > XB_SPIN_CAP) { atomicAdd(&(bar)[XB_TMO], 1u); break; } } } } while (0)

struct XcdBarrier {
    unsigned* bar; unsigned x;
    volatile LAS unsigned* st;
};

__device__ __forceinline__ XcdBarrier xcd_barrier_post(unsigned* bar, volatile LAS unsigned* st) {
    XcdBarrier b; b.bar = bar; b.x = xb_xcc_id(); b.st = st;
    if (threadIdx.x == 0) (void)xb_add(&bar[XB_XCNT(b.x)], 1u);
    return b;
}
__device__ __forceinline__ void xcd_barrier_complete(unsigned* bar, unsigned x, unsigned& nloc, unsigned& nx) {
    const unsigned G = gridDim.x * gridDim.y * gridDim.z;
    unsigned sum, cnt, mine, sp = 0u;
    for (;;) {
        sum = 0u; cnt = 0u; mine = 0u;
#pragma unroll
        for (unsigned j = 0; j < 16; ++j) { const unsigned c = xb_ld(&bar[XB_XCNT(j)]); sum += c; cnt += (c > 0u) ? 1u : 0u; mine = (j == x) ? c : mine; }
        if (sum == G) break;
        __builtin_amdgcn_s_sleep(1);
        if ((++sp & 255u) == 0u) { if (xb_ld(&bar[XB_TMO])) break; if (sp > XB_SPIN_CAP) { atomicAdd(&bar[XB_TMO], 1u); break; } }
    }
    nloc = mine > 0u ? mine : 1u; nx = cnt > 0u ? cnt : 1u;
}

__device__ __forceinline__ void xcd_barrier(const XcdBarrier& b) {
    asm volatile("s_waitcnt vmcnt(0)" ::: "memory");
    __syncthreads();
    if (threadIdx.x == 0) {
        unsigned* bar = b.bar;
        __builtin_amdgcn_s_waitcnt(0);
        unsigned nloc = b.st[0], nx = b.st[1];
        if (nloc == 0u) { xcd_barrier_complete(bar, b.x, nloc, nx); b.st[0] = nloc; b.st[1] = nx; }
        const unsigned old = xb_add(&bar[XB_XSUB(b.x)], 1u);
        const unsigned gen = old / nloc;
        if (old + 1u == (gen + 1u) * nloc) {
            __builtin_amdgcn_fence(__ATOMIC_RELEASE, "agent");
            asm volatile("s_waitcnt vmcnt(0)" ::: "memory");
            const unsigned og = xb_add(&bar[XB_TOP], 1u);
            const unsigned tg = og / nx;
            if (og + 1u == (tg + 1u) * nx) xb_add(&bar[XB_TOPGEN], 1u);
            else XB_SPIN(xb_ld(&bar[XB_TOPGEN]) == tg, bar);
            __builtin_amdgcn_fence(__ATOMIC_ACQUIRE, "agent");
            xb_add(&bar[XB_XGEN(b.x)], 1u);
            asm volatile("s_waitcnt vmcnt(0)" ::: "memory");
        } else {
            XB_SPIN(xb_ld(&bar[XB_XGEN(b.x)]) == gen, bar);
            __builtin_amdgcn_fence(__ATOMIC_ACQUIRE, "agent");
            asm volatile("s_waitcnt vmcnt(0)" ::: "memory");
        }
    }
    __syncthreads();
}

namespace pg8 {
struct EpiProj {
    static constexpr bool PERM = true, AFTER_DRAIN = false;
    bf16_t* P; float* out; float* vst;
    __device__ __forceinline__ void operator()(const f32x4 (&acc)[2][2][4][2], const Unit& u, int wr, int wc, int fr, int fq) const {
        const int row0 = u.pm * BM + wr * 64 + fr;
        const int colt = u.pn * BM + wc * 32 + 8 * fq;
#pragma unroll
        for (int ai = 0; ai < 2; ++ai)
#pragma unroll
            for (int m = 0; m < 4; ++m) { bf16_t* rowp = P + (size_t)(row0 + ai * HALF + m * 16) * DIN + colt;
#pragma unroll
                for (int bj = 0; bj < 2; ++bj) { const f32x4 v0 = acc[ai][bj][m][0], v1 = acc[ai][bj][m][1];
                    u32x4 w; w.x = cvt_pk_bf16(v0[0], v0[1]); w.y = cvt_pk_bf16(v0[2], v0[3]); w.z = cvt_pk_bf16(v1[0], v1[1]); w.w = cvt_pk_bf16(v1[2], v1[3]);
                    *(u32x4*)(rowp + bj * HALF) = w; } }
        if (u.pn >= 4 && u.pn < 8) {
#pragma unroll
            for (int ai = 0; ai < 2; ++ai)
#pragma unroll
                for (int m = 0; m < 4; ++m) { float s = 0.f, q = 0.f;
#pragma unroll
                    for (int bj = 0; bj < 2; ++bj)
#pragma unroll
                        for (int n = 0; n < 2; ++n) { const f32x4 x = acc[ai][bj][m][n]; s += (x[0] + x[1]) + (x[2] + x[3]); q += (x[0] * x[0] + x[1] * x[1]) + (x[2] * x[2] + x[3] * x[3]); }
                    s += __shfl_xor(s, 16); s += __shfl_xor(s, 32); q += __shfl_xor(q, 16); q += __shfl_xor(q, 32);
                    if (fq == 0) { float* d = vst + ((size_t)(row0 + ai * HALF + m * 16) * 16 + (u.pn - 4) * 4 + wc) * 2; *(f32x2*)d = (f32x2){s, q}; } }
        }
        if (u.pn >= 18 && u.pn < 30) {
            const int kv = u.pn >= 24 ? 1 : 0; const int t = u.pn - 18 - 6 * kv; const int g = t >> 1, half = t & 1;
            const int dcol = kv * 512 + half * 256 + wc * 32 + 8 * fq;
            const int R = g == 0 ? 128 : (g == 1 ? 512 : 2048);
            const size_t obp = g == 0 ? O_KVP0 : (g == 1 ? O_KVP1 : O_KVP2), obs = g == 0 ? O_KVS0 : (g == 1 ? O_KVS1 : O_KVS2);
#pragma unroll
            for (int ai = 0; ai < 2; ++ai)
#pragma unroll
                for (int m = 0; m < 4; ++m) { const int row = row0 + ai * HALF + m * 16; float* base = nullptr;
                    if (row < MP) { const int b = row >> 11, s = row & 2047, r = s - (2048 - R); if (r >= 0) base = out + obp + (size_t)(b * R + r) * 1024 + dcol; }
                    else base = out + obs + (size_t)(row - MP) * 1024 + dcol;
                    if (base) {
#pragma unroll
                        for (int bj = 0; bj < 2; ++bj)
#pragma unroll
                            for (int n = 0; n < 2; ++n) *(f32x4*)(base + bj * HALF + 4 * n) = acc[ai][bj][m][n]; } }
        }
    }
};
struct EpiGateA {
    static constexpr bool PERM = true, AFTER_DRAIN = false;
    const bf16_t* P; bf16_t* part;
    __device__ __forceinline__ void operator()(const f32x4 (&acc)[2][2][4][2], const Unit& u, int wr, int wc, int fr, int fq) const {
        const int row0 = u.pm * BM + wr * 64 + fr; const int colt = u.pn * BM + wc * 32 + 8 * fq;
#pragma unroll
        for (int ai = 0; ai < 2; ++ai)
#pragma unroll
            for (int m = 0; m < 4; ++m) { const size_t row = (size_t)(row0 + ai * HALF + m * 16); const bf16_t* gp = P + row * DIN + C_GA + colt; bf16_t* pp = part + row * DM + colt;
#pragma unroll
                for (int bj = 0; bj < 2; ++bj) { const u32x4 gw = *(const u32x4*)(gp + bj * HALF); const f32x4 a0 = acc[ai][bj][m][0], a1 = acc[ai][bj][m][1];
                    f32x4 o0, o1; o0[0] = a0[0] * sigm(bflo(gw.x)); o0[1] = a0[1] * sigm(bfhi(gw.x)); o0[2] = a0[2] * sigm(bflo(gw.y)); o0[3] = a0[3] * sigm(bfhi(gw.y));
                    o1[0] = a1[0] * sigm(bflo(gw.z)); o1[1] = a1[1] * sigm(bfhi(gw.z)); o1[2] = a1[2] * sigm(bflo(gw.w)); o1[3] = a1[3] * sigm(bfhi(gw.w));
                    u32x4 w; w.x = cvt_pk_bf16(o0[0], o0[1]); w.y = cvt_pk_bf16(o0[2], o0[3]); w.z = cvt_pk_bf16(o1[0], o1[1]); w.w = cvt_pk_bf16(o1[2], o1[3]);
                    *(u32x4*)(pp + bj * HALF) = w; } }
    }
};
struct EpiGateB {
    static constexpr bool PERM = true, AFTER_DRAIN = false;
    const bf16_t* P; const bf16_t* part; bf16_t* mrg;
    __device__ __forceinline__ void operator()(const f32x4 (&acc)[2][2][4][2], const Unit& u, int wr, int wc, int fr, int fq) const {
        const int row0 = u.pm * BM + wr * 64 + fr; const int colt = u.pn * BM + wc * 32 + 8 * fq;
#pragma unroll
        for (int ai = 0; ai < 2; ++ai)
#pragma unroll
            for (int m = 0; m < 4; ++m) { const size_t row = (size_t)(row0 + ai * HALF + m * 16); const bf16_t* gp = P + row * DIN + C_GB + colt; const bf16_t* pp = part + row * DM + colt;
#pragma unroll
                for (int bj = 0; bj < 2; ++bj) { const u32x4 gw = *(const u32x4*)(gp + bj * HALF); const f32x4 a0 = acc[ai][bj][m][0], a1 = acc[ai][bj][m][1];
                    const u32x4 pw = *(const u32x4*)(pp + bj * HALF);
                    const f32x4 p0 = (f32x4){bflo(pw.x), bfhi(pw.x), bflo(pw.y), bfhi(pw.y)}, p1 = (f32x4){bflo(pw.z), bfhi(pw.z), bflo(pw.w), bfhi(pw.w)};
                    f32x4 o0, o1; o0[0] = p0[0] + a0[0] * sigm(bflo(gw.x)); o0[1] = p0[1] + a0[1] * sigm(bfhi(gw.x)); o0[2] = p0[2] + a0[2] * sigm(bflo(gw.y)); o0[3] = p0[3] + a0[3] * sigm(bfhi(gw.y));
                    o1[0] = p1[0] + a1[0] * sigm(bflo(gw.z)); o1[1] = p1[1] + a1[1] * sigm(bfhi(gw.z)); o1[2] = p1[2] + a1[2] * sigm(bflo(gw.w)); o1[3] = p1[3] + a1[3] * sigm(bfhi(gw.w));
                    u32x4 w; w.x = cvt_pk_bf16(o0[0], o0[1]); w.y = cvt_pk_bf16(o0[2], o0[3]); w.z = cvt_pk_bf16(o1[0], o1[1]); w.w = cvt_pk_bf16(o1[2], o1[3]);
                    *(u32x4*)(mrg + row * DM + colt + bj * HALF) = w; } }
    }
};
struct EpiF32 {
    static constexpr bool PERM = true, AFTER_DRAIN = false;
    bf16_t* O;
    __device__ __forceinline__ void operator()(const f32x4 (&acc)[2][2][4][2], const Unit& u, int wr, int wc, int fr, int fq) const {
        const int row0 = u.pm * BM + wr * 64 + fr; const int colt = u.pn * BM + wc * 32 + 8 * fq;
#pragma unroll
        for (int ai = 0; ai < 2; ++ai)
#pragma unroll
            for (int m = 0; m < 4; ++m) { bf16_t* pp = O + (size_t)(row0 + ai * HALF + m * 16) * DM + colt;
#pragma unroll
                for (int bj = 0; bj < 2; ++bj) { const f32x4 v0 = acc[ai][bj][m][0], v1 = acc[ai][bj][m][1];
                    u32x4 w; w.x = cvt_pk_bf16(v0[0], v0[1]); w.y = cvt_pk_bf16(v0[2], v0[3]); w.z = cvt_pk_bf16(v1[0], v1[1]); w.w = cvt_pk_bf16(v1[2], v1[3]);
                    *(u32x4*)(pp + bj * HALF) = w; } }
    }
};
}

__device__ __forceinline__ void p0_transpose_item(const float* W, int K, int N, bf16* WT, int row_off, LAS float* scr, int item, int lane) {
    const int nblk = N / 32, kb = item / nblk, nb = item % nblk, k0 = 64 * kb, n0 = 32 * nb;
#pragma unroll
    for (int i = 0; i < 32; ++i) { const int kk = 2 * i + (lane >> 5); scr[kk * 33 + (lane & 31)] = W[(size_t)(k0 + kk) * N + n0 + (lane & 31)]; }
    LDS_WAIT(); asm volatile("" ::: "memory");
    const int c = lane & 7;
#pragma unroll
    for (int j = 0; j < 4; ++j) { const int n = (lane >> 3) + 8 * j; const LAS float* s = scr + (8 * c) * 33 + n;
        v4u o; o.x = pk2(s[0 * 33], s[1 * 33]); o.y = pk2(s[2 * 33], s[3 * 33]); o.z = pk2(s[4 * 33], s[5 * 33]); o.w = pk2(s[6 * 33], s[7 * 33]);
        *(GAS v4u*)(WT + (size_t)(row_off + n0 + n) * K + k0 + 8 * c) = o; }
    LDS_WAIT(); asm volatile("" ::: "memory");
}
__device__ __forceinline__ void mod_task(int task, const float* cp, const float* cs, const float* Wc, const float* bc, float* MODP, LAS unsigned char* lds, int tid, int wave, int lane) {
    const int chunk = task >> 2, kq = task & 3;
    const int k0 = kq * 256 + wave * 32;
    float sc[40], acc[40];
#pragma unroll
    for (int r = 0; r < 40; ++r) { const float* crow = (r < 8) ? cp + r * 1024 : cs + (r - 8) * 1024; sc[r] = silu(crow[k0 + (lane & 31)]); acc[r] = 0.f; }
    const float* wp = Wc + (size_t)k0 * 3072 + chunk * 64 + lane;
#pragma unroll 8
    for (int kk = 0; kk < 32; ++kk) { const float wv = wp[(size_t)kk * 3072];
#pragma unroll
        for (int r = 0; r < 40; ++r) acc[r] += rdlane(sc[r], kk) * wv; }
    LAS float* red = (LAS float*)lds;
#pragma unroll
    for (int r = 0; r < 40; ++r) red[(wave * 40 + r) * 64 + lane] = acc[r];
    __syncthreads();
    for (int idx = tid; idx < 2560; idx += NTHR) { const int r = idx >> 6, cl = idx & 63; float s = 0.f;
#pragma unroll
        for (int w = 0; w < 8; ++w) s += red[(w * 40 + r) * 64 + cl];
        if (kq == 0) s += bc[chunk * 64 + cl];
        MODP[((size_t)kq * 40 + r) * 3072 + chunk * 64 + cl] = s; }
    __syncthreads();
}

typedef short s16x4 __attribute__((ext_vector_type(4)));
__device__ __forceinline__ s16x4 lds_tr(const LAS bf16* p) { return __builtin_bit_cast(s16x4, __builtin_amdgcn_ds_read_tr16_b64_v4i16((LAS s16x4*)p)); }
__device__ __forceinline__ void att_decode(int idx, int& g, int& b, int& h, int& d, int& n, int& r) {
    g = idx >> 10; int rem = idx & 1023; b = rem >> 7; rem &= 127; h = rem >> 4; const int sub = rem & 15;
    if (g == 0) { d = 1; n = sub; r = 0; } else if (g == 1) { d = 4; r = sub >> 2; n = sub & 3; } else { d = 16; r = sub; n = 0; }
}
__device__ __forceinline__ void att_prefetch(int idx, const bf16* PROJ, int tid, int wave, int lane, v4u (&kk)[4], v4u (&vv)[4], bf16x8& Q0, bf16x8& Q1) {
    int g, b, h, d, n, r; att_decode(idx, g, b, h, d, n, r);
    const int key = tid >> 1, half = tid & 1; const int m = 128 * (n - 1) + key;
    if (m >= 0) { const size_t row = (size_t)b * 2048 + (size_t)d * m + r; const bf16* src = PROJ + row * DIN + g * 512 + h * 64 + half * 32;
#pragma unroll
        for (int c = 0; c < 4; ++c) { kk[c] = *(const v4u*)(src + C_K + 8 * c); vv[c] = *(const v4u*)(src + C_VV + 8 * c); } }
    else {
#pragma unroll
        for (int c = 0; c < 4; ++c) { kk[c] = (v4u){0u, 0u, 0u, 0u}; vv[c] = (v4u){0u, 0u, 0u, 0u}; } }
    const int fr = lane & 15, fq = lane >> 4; const int i = 16 * wave + fr;
    const size_t rowq = (size_t)b * 2048 + (size_t)d * (128 * n + i) + r;
    const bf16* qsrc = PROJ + rowq * DIN + C_Q + g * 512 + h * 64 + 8 * fq;
    Q0 = *(const bf16x8*)qsrc; Q1 = *(const bf16x8*)(qsrc + 32);
}
__device__ __forceinline__ void att_compute(int idx, bf16* O3, float* ML, LAS unsigned char* lds, int wave, int lane, const bf16x8 Q0, const bf16x8 Q1) {
    int g, b, h, d, n, r; att_decode(idx, g, b, h, d, n, r);
    const LAS bf16* Ks = (const LAS bf16*)lds;
    const LAS bf16* Vs = (const LAS bf16*)(lds + 36864);
    const int fr = lane & 15, fq = lane >> 4;
    const int i = 16 * wave + fr;
    const size_t rowq = (size_t)b * 2048 + (size_t)d * (128 * n + i) + r;
    const int start = wave & ~1; const int lo = (n == 0) ? 8 : start;
    f32x4 S[10]; float mx = -1e30f;
#pragma unroll
    for (int p = 0; p < 10; ++p) { const int tile = start + p;
        if (tile >= lo) {
            const LAS bf16* kp = Ks + (tile * 16 + fr) * 72 + 8 * fq;
            const bf16x8 K0 = *(const LAS bf16x8*)kp, K1 = *(const LAS bf16x8*)(kp + 32);
            f32x4 s = (f32x4){0.f, 0.f, 0.f, 0.f};
            s = __builtin_amdgcn_mfma_f32_16x16x32_bf16(K0, Q0, s, 0, 0, 0); s = __builtin_amdgcn_mfma_f32_16x16x32_bf16(K1, Q1, s, 0, 0, 0);
#pragma unroll
            for (int e = 0; e < 4; ++e) { const int j = tile * 16 + 4 * fq + e; const bool valid = (j >= i) && (j <= i + 128); s[e] = valid ? s[e] * 0.125f : -1e30f; mx = fmaxf(mx, s[e]); }
            S[p] = s;
        } else S[p] = (f32x4){-1e30f, -1e30f, -1e30f, -1e30f};
    }
    mx = fmaxf(mx, __shfl_xor(mx, 16)); mx = fmaxf(mx, __shfl_xor(mx, 32));
    float l = 0.f;
#pragma unroll
    for (int p = 0; p < 10; ++p)
#pragma unroll
        for (int e = 0; e < 4; ++e) { const float ex = __expf(S[p][e] - mx); S[p][e] = ex; l += ex; }
    l += __shfl_xor(l, 16); l += __shfl_xor(l, 32);
    f32x4 O[4];
#pragma unroll
    for (int dt = 0; dt < 4; ++dt) O[dt] = (f32x4){0.f, 0.f, 0.f, 0.f};
#pragma unroll
    for (int pp = 0; pp < 5; ++pp) {
        if (start + 2 * pp >= lo) {
            v4u pw; pw.x = pk2(S[2 * pp][0], S[2 * pp][1]); pw.y = pk2(S[2 * pp][2], S[2 * pp][3]); pw.z = pk2(S[2 * pp + 1][0], S[2 * pp + 1][1]); pw.w = pk2(S[2 * pp + 1][2], S[2 * pp + 1][3]);
            const bf16x8 Pf = __builtin_bit_cast(bf16x8, pw);
            const LAS bf16* vbase = Vs + ((start + 2 * pp) * 16 + 4 * fq + (fr >> 2)) * 72 + 4 * (fr & 3);
#pragma unroll
            for (int dt = 0; dt < 4; ++dt) { const s16x4 va = lds_tr(vbase + 16 * dt), vb = lds_tr(vbase + 16 * 72 + 16 * dt);
                const bf16x8 Vf = (bf16x8){va[0], va[1], va[2], va[3], vb[0], vb[1], vb[2], vb[3]};
                O[dt] = __builtin_amdgcn_mfma_f32_16x16x32_bf16(Vf, Pf, O[dt], 0, 0, 0); }
        }
    }
    const float inv = 1.f / l;
    bf16* op = O3 + ((size_t)g * MT + rowq) * 512 + h * 64 + 4 * fq;
#pragma unroll
    for (int dt = 0; dt < 4; ++dt) { v2u w; w.x = pk2(O[dt][0] * inv, O[dt][1] * inv); w.y = pk2(O[dt][2] * inv, O[dt][3] * inv); *(v2u*)(op + 16 * dt) = w; }
    if (fq == 0) { float* mp = ML + (((size_t)g * MT + rowq) * 8 + h) * 2; *(f32x2*)mp = (f32x2){mx, l}; }
}

__device__ __forceinline__ void gmlp_item(int idx, const bf16* PROJ, const float* VST, const float* Wsp, const float* bsp, const float* lng, const float* lnb, bf16* YA,
                                          LAS unsigned char* lds, int tid, int wave, int lane) {
    const int ci = idx >> 3, g = idx & 7; const int row0 = ci * 128;
    LAS bf16* VN = (LAS bf16*)lds;
    LAS bf16* WS = (LAS bf16*)(lds + 34816);
    const int s = tid >> 2, cp = tid & 3;
    const int fr = lane & 15, fq = lane >> 4;
    const int t = 16 * wave + fr;
    const f32x4 st0 = ((const f32x4*)(VST + (size_t)(row0 + s) * 32))[2 * cp], st1 = ((const f32x4*)(VST + (size_t)(row0 + s) * 32))[2 * cp + 1];
    const bf16* vp = PROJ + (size_t)(row0 + s) * DIN + C_V + g * 128 + cp * 32;
    v4u vraw[4];
#pragma unroll
    for (int c = 0; c < 4; ++c) vraw[c] = *(const v4u*)(vp + 8 * c);
    const float* wp = Wsp + ((size_t)g * 128 + s) * 128 + cp * 32;
    f32x4 wv[8];
#pragma unroll
    for (int c = 0; c < 8; ++c) wv[c] = ((const f32x4*)wp)[c];
    const size_t rowt = (size_t)row0 + t;
    const bf16* up = PROJ + rowt * DIN + g * 128 + 4 * fq;
    v2u uu[8], zz[8];
#pragma unroll
    for (int ct = 0; ct < 8; ++ct) { uu[ct] = *(const v2u*)(up + C_U + 16 * ct); zz[ct] = *(const v2u*)(up + C_Z + 16 * ct); }
    const float bs = bsp[g * 128 + t];
    float sm = (st0[0] + st0[2]) + (st1[0] + st1[2]), sq = (st0[1] + st0[3]) + (st1[1] + st1[3]);
    sm += __shfl_xor(sm, 1); sm += __shfl_xor(sm, 2); sq += __shfl_xor(sq, 1); sq += __shfl_xor(sq, 2);
    const float mu = sm * (1.f / 1024.f); const float rstd = rsqrtf(sq * (1.f / 1024.f) - mu * mu + EPS);
#pragma unroll
    for (int c = 0; c < 4; ++c) { const f32x4 a = wv[2 * c], b2 = wv[2 * c + 1]; const int s0 = cp * 32 + 8 * c;
        float v[8] = {a[0], a[1], a[2], a[3], b2[0], b2[1], b2[2], b2[3]};
#pragma unroll
        for (int e = 0; e < 8; ++e) v[e] = (s0 + e <= s) ? v[e] : 0.f;
        v4u w; w.x = pk2(v[0], v[1]); w.y = pk2(v[2], v[3]); w.z = pk2(v[4], v[5]); w.w = pk2(v[6], v[7]);
        *(LAS v4u*)(WS + s * 136 + s0) = w; }
#pragma unroll
    for (int c = 0; c < 4; ++c) { const v4u raw = vraw[c]; const int ch = g * 128 + cp * 32 + 8 * c;
        const f32x4 g0 = *(const f32x4*)(lng + ch), g1 = *(const f32x4*)(lng + ch + 4), b0 = *(const f32x4*)(lnb + ch), b1 = *(const f32x4*)(lnb + ch + 4);
        v4u w;
        w.x = pk2((bflo(raw.x) - mu) * rstd * g0[0] + b0[0], (bfhi(raw.x) - mu) * rstd * g0[1] + b0[1]);
        w.y = pk2((bflo(raw.y) - mu) * rstd * g0[2] + b0[2], (bfhi(raw.y) - mu) * rstd * g0[3] + b0[3]);
        w.z = pk2((bflo(raw.z) - mu) * rstd * g1[0] + b1[0], (bfhi(raw.z) - mu) * rstd * g1[1] + b1[1]);
        w.w = pk2((bflo(raw.w) - mu) * rstd * g1[2] + b1[2], (bfhi(raw.w) - mu) * rstd * g1[3] + b1[3]);
        *(LAS v4u*)(VN + s * 136 + cp * 32 + 8 * c) = w; }
    __syncthreads();
    const int nks = (wave >> 1) + 1;
    f32x4 acc[8];
#pragma unroll
    for (int ct = 0; ct < 8; ++ct) acc[ct] = (f32x4){0.f, 0.f, 0.f, 0.f};
#pragma unroll
    for (int ks = 0; ks < 4; ++ks) {
        if (ks < nks) { const bf16x8 Wf = *(const LAS bf16x8*)(WS + t * 136 + 32 * ks + 8 * fq);
            const LAS bf16* vb = VN + (32 * ks + 8 * fq + (fr >> 2)) * 136 + 4 * (fr & 3);
#pragma unroll
            for (int ct = 0; ct < 8; ++ct) { const s16x4 va = lds_tr(vb + 16 * ct), vb2 = lds_tr(vb + 4 * 136 + 16 * ct);
                const bf16x8 Vf = (bf16x8){va[0], va[1], va[2], va[3], vb2[0], vb2[1], vb2[2], vb2[3]};
                acc[ct] = __builtin_amdgcn_mfma_f32_16x16x32_bf16(Vf, Wf, acc[ct], 0, 0, 0); } }
    }
    bf16* yp = YA + rowt * DM + g * 128 + 4 * fq;
#pragma unroll
    for (int ct = 0; ct < 8; ++ct) {
        const float y0 = bflo(uu[ct].x) * (acc[ct][0] + bs) * silu(bflo(zz[ct].x)), y1 = bfhi(uu[ct].x) * (acc[ct][1] + bs) * silu(bfhi(zz[ct].x));
        const float y2 = bflo(uu[ct].y) * (acc[ct][2] + bs) * silu(bflo(zz[ct].y)), y3 = bfhi(uu[ct].y) * (acc[ct][3] + bs) * silu(bfhi(zz[ct].y));
        v2u w; w.x = pk2(y0, y1); w.y = pk2(y2, y3); *(v2u*)(yp + 16 * ct) = w; }
    __syncthreads();
}

__device__ __forceinline__ void gmlp_sample_item(int b, const bf16* PROJ, const float* VST, const float* Wsp, const float* bsp, const float* lng, const float* lnb, bf16* YA, float* out,
                                                 LAS unsigned char* lds, int tid, int wave, int lane) {
    const int r0 = MP + b * 8;
    LAS float* st = (LAS float*)lds;
    if (tid < 8) { const float* p = VST + (size_t)(r0 + tid) * 32; float s = 0.f, q = 0.f;
#pragma unroll
        for (int k = 0; k < 8; ++k) { const f32x4 a = ((const f32x4*)p)[k]; s += a[0] + a[2]; q += a[1] + a[3]; }
        const float mu = s * (1.f / 1024.f); const float var = q * (1.f / 1024.f) - mu * mu; st[2 * tid] = mu; st[2 * tid + 1] = rsqrtf(var + EPS); }
    __syncthreads();
    const int ch = 2 * tid, g = wave;
    const float lg0 = lng[ch], lg1 = lng[ch + 1], lb0 = lnb[ch], lb1 = lnb[ch + 1];
    float vn0[8], vn1[8];
#pragma unroll
    for (int s = 0; s < 8; ++s) { const unsigned raw = *(const unsigned*)(PROJ + (size_t)(r0 + s) * DIN + C_V + ch); const float mu = st[2 * s], rstd = st[2 * s + 1];
        vn0[s] = (bflo(raw) - mu) * rstd * lg0 + lb0; vn1[s] = (bfhi(raw) - mu) * rstd * lg1 + lb1;
        *(f32x2*)(out + O_VCH + (size_t)(b * 8 + s) * 1024 + ch) = (f32x2){vn0[s], vn1[s]}; }
#pragma unroll
    for (int t = 0; t < 8; ++t) { float z0 = bsp[g * 128 + t], z1 = z0;
#pragma unroll
        for (int s = 0; s < 8; ++s) if (s <= t) { const float w = Wsp[((size_t)g * 128 + t) * 128 + s]; z0 += w * vn0[s]; z1 += w * vn1[s]; }
        const unsigned uu = *(const unsigned*)(PROJ + (size_t)(r0 + t) * DIN + C_U + ch), zz = *(const unsigned*)(PROJ + (size_t)(r0 + t) * DIN + C_Z + ch);
        *(unsigned*)(YA + (size_t)(r0 + t) * DM + ch) = pk2(bflo(uu) * z0 * silu(bflo(zz)), bfhi(uu) * z1 * silu(bfhi(zz))); }
    __syncthreads();
}

__device__ __forceinline__ f32x4 sa_load(const bf16* PROJ, const float* cache, int b, int lw, int ix, int pcol, int ccol, bool maybe_new) {
    if (maybe_new && ix >= lw) { const v2u raw = *(const v2u*)(PROJ + (size_t)(MP + b * 8 + ix - lw) * DIN + pcol); return (f32x4){bflo(raw.x), bfhi(raw.x), bflo(raw.y), bfhi(raw.y)}; }
    const int ic = ix < lw ? ix : lw - 1;
    return *(const f32x4*)(cache + (size_t)ic * 1024 + ccol);
}
__device__ __forceinline__ void attn_sample_item(int idx, const bf16* PROJ, const float* c128, const float* c512, const float* c2048, bf16* O3, float* ML, int wave, int lane) {
    const int b = idx / 24; const int rem = idx - b * 24; const int g = rem >> 3, t = rem & 7; const int h = wave;
    const int lw = g == 0 ? 128 : (g == 1 ? 512 : 2048), d = g == 0 ? 1 : (g == 1 ? 4 : 16);
    const float* cache = (g == 0 ? c128 : (g == 1 ? c512 : c2048)) + (size_t)b * lw * 1024;
    const size_t rq = (size_t)MP + b * 8 + t;
    const int ks = lane >> 4, dq = lane & 15;
    const int hc = g * 512 + h * 64 + 4 * dq;
    const v2u qraw = *(const v2u*)(PROJ + rq * DIN + C_Q + hc);
    const float q0 = bflo(qraw.x) * 0.125f, q1 = bfhi(qraw.x) * 0.125f, q2 = bflo(qraw.y) * 0.125f, q3 = bfhi(qraw.y) * 0.125f;
    const float* kbase = cache + h * 64;
    const unsigned lo4 = 4u * (unsigned)dq;
    constexpr int NVA = 8;
    const int ixb = lw + t - d * ks;
    f32x4 kk[33], va[NVA];
#pragma unroll
    for (int it = 0; it < 33; ++it) { int ix = (it < 32 || ks == 0) ? ixb - 4 * d * it : lw + t - 128 * d; ix = ix < lw ? ix : lw - 1; kk[it] = *(const f32x4*)(kbase + ((unsigned)ix * 1024u + lo4)); }
#pragma unroll
    for (int it = 0; it < NVA; ++it) { int ix = ixb - 4 * d * it; ix = ix < lw ? ix : lw - 1; va[it] = *(const f32x4*)(kbase + ((unsigned)ix * 1024u + 512u + lo4)); }
#pragma unroll
    for (int it = 0; it < 2; ++it) { const int ix = ixb - 4 * d * it;
        if (ix >= lw) { const bf16* pr = PROJ + (size_t)(MP + b * 8 + ix - lw) * DIN + hc; const v2u rk = *(const v2u*)(pr + C_K), rv = *(const v2u*)(pr + C_VV);
            kk[it] = (f32x4){bflo(rk.x), bfhi(rk.x), bflo(rk.y), bfhi(rk.y)}; va[it] = (f32x4){bflo(rv.x), bfhi(rv.x), bflo(rv.y), bfhi(rv.y)}; } }
    float s[33]; float mx = -1e30f;
#pragma unroll
    for (int it = 0; it < 33; ++it) {
        float a = (kk[it][0] * q0 + kk[it][1] * q1) + (kk[it][2] * q2 + kk[it][3] * q3);
        a += __shfl_xor(a, 1); a += __shfl_xor(a, 2); a += __shfl_xor(a, 4); a += __shfl_xor(a, 8);
        s[it] = ((it < 32) || (ks == 0)) ? a : -1e30f; mx = fmaxf(mx, s[it]);
    }
    __builtin_amdgcn_sched_barrier(0);
    f32x4 vb[33 - NVA];
#pragma unroll
    for (int it = NVA; it < 33; ++it) { int ix = (it < 32 || ks == 0) ? ixb - 4 * d * it : lw + t - 128 * d; vb[it - NVA] = *(const f32x4*)(kbase + ((unsigned)ix * 1024u + 512u + lo4)); }
    mx = fmaxf(mx, __shfl_xor(mx, 16)); mx = fmaxf(mx, __shfl_xor(mx, 32));
    float l = 0.f;
#pragma unroll
    for (int it = 0; it < 33; ++it) { s[it] = __expf(s[it] - mx); l += s[it]; }
    l += __shfl_xor(l, 16); l += __shfl_xor(l, 32);
    f32x4 o = (f32x4){0.f, 0.f, 0.f, 0.f};
#pragma unroll
    for (int it = 0; it < NVA; ++it) o += va[it] * s[it];
#pragma unroll
    for (int it = NVA; it < 33; ++it) o += vb[it - NVA] * s[it];
#pragma unroll
    for (int e = 0; e < 4; ++e) { o[e] += __shfl_xor(o[e], 16); o[e] += __shfl_xor(o[e], 32); }
    const float inv = 1.f / l;
    if (ks == 0) { v2u w; w.x = pk2(o[0] * inv, o[1] * inv); w.y = pk2(o[2] * inv, o[3] * inv); *(v2u*)(O3 + ((size_t)g * MT + rq) * 512 + h * 64 + 4 * dq) = w; }
    if (lane == 0) { float* mp = ML + (((size_t)g * MT + rq) * 8 + h) * 2; mp[0] = mx; mp[1] = l; }
}

template <int MW, int NT>
__device__ __forceinline__ void sg_mma(f32x4 (&acc)[MW][NT], const bf16* A, const bf16* Bt, int K, int lane) {
    const int fr = lane & 15, fq = lane >> 4;
    const bf16* ap = A + (size_t)fr * K + 8 * fq; const bf16* bp = Bt + (size_t)fr * K + 8 * fq;
    constexpr int UNR = (MW * NT == 1) ? 16 : 4;
#pragma unroll UNR
    for (int ks = 0; ks < K / 32; ++ks) {
        bf16x8 a[MW], b[NT];
#pragma unroll
        for (int mi = 0; mi < MW; ++mi) a[mi] = *(const bf16x8*)(ap + (size_t)mi * 16 * K + 32 * ks);
#pragma unroll
        for (int ni = 0; ni < NT; ++ni) b[ni] = *(const bf16x8*)(bp + (size_t)ni * 16 * K + 32 * ks);
#pragma unroll
        for (int mi = 0; mi < MW; ++mi)
#pragma unroll
            for (int ni = 0; ni < NT; ++ni) acc[mi][ni] = __builtin_amdgcn_mfma_f32_16x16x32_bf16(b[ni], a[mi], acc[mi][ni], 0, 0, 0);
    }
}
__device__ __forceinline__ void sg_proj_task(int ts, const bf16* H, const bf16* WIN_T, bf16* PROJ, float* out, float* VST, int wave, int lane) {
    const int fr = lane & 15, fq = lane >> 4; const int n0 = 64 * ts; const int r0 = MP + 32 * wave;
    f32x4 acc[2][4];
#pragma unroll
    for (int mi = 0; mi < 2; ++mi)
#pragma unroll
        for (int ni = 0; ni < 4; ++ni) acc[mi][ni] = (f32x4){0.f, 0.f, 0.f, 0.f};
    sg_mma<2, 4>(acc, H + (size_t)r0 * DM, WIN_T + (size_t)n0 * DM, DM, lane);
#pragma unroll
    for (int mi = 0; mi < 2; ++mi) { const int row = r0 + 16 * mi + fr;
#pragma unroll
        for (int ni = 0; ni < 4; ++ni) { const int col = n0 + 16 * ni + 4 * fq; const f32x4 v = acc[mi][ni];
            v2u w; w.x = pk2(v[0], v[1]); w.y = pk2(v[2], v[3]); *(v2u*)(PROJ + (size_t)row * DIN + col) = w;
            if (col >= C_K && col < C_ZB) { const int kv = col >= C_VV ? 1 : 0; const int cc = col - (kv ? C_VV : C_K); const int g = cc >> 9, hc = cc & 511;
                const size_t obs = g == 0 ? O_KVS0 : (g == 1 ? O_KVS1 : O_KVS2);
                *(f32x4*)(out + obs + (size_t)(row - MP) * 1024 + kv * 512 + hc) = v; } }
        if (n0 >= C_V && n0 < C_Z) { float s = 0.f, q = 0.f;
#pragma unroll
            for (int ni = 0; ni < 4; ++ni) { const f32x4 x = acc[mi][ni]; s += (x[0] + x[1]) + (x[2] + x[3]); q += (x[0] * x[0] + x[1] * x[1]) + (x[2] * x[2] + x[3] * x[3]); }
            s += __shfl_xor(s, 16); s += __shfl_xor(s, 32); q += __shfl_xor(q, 16); q += __shfl_xor(q, 32);
            if (fq == 0) *(f32x2*)(VST + ((size_t)row * 16 + ((n0 - C_V) >> 6)) * 2) = (f32x2){s, q}; } }
}
__device__ __forceinline__ void sg_merge_task(int ts, const bf16* YA, const bf16* YB, const bf16* WPA_T, const bf16* WPB_T, const bf16* PROJ, bf16* MRG, int wave, int lane) {
    const int fr = lane & 15, fq = lane >> 4; const int n0 = 16 * (ts & 63); const int r0 = MP + 128 * (ts >> 6) + 16 * wave;
    f32x4 aa[1][1], ab[1][1]; aa[0][0] = (f32x4){0.f, 0.f, 0.f, 0.f}; ab[0][0] = (f32x4){0.f, 0.f, 0.f, 0.f};
    sg_mma<1, 1>(aa, YA + (size_t)r0 * DM, WPA_T + (size_t)n0 * DM, DM, lane);
    sg_mma<1, 1>(ab, YB + (size_t)r0 * 512, WPB_T + (size_t)n0 * 512, 512, lane);
    const size_t row = (size_t)r0 + fr; const int col = n0 + 4 * fq;
    const v2u ga = *(const v2u*)(PROJ + row * DIN + C_GA + col), gb = *(const v2u*)(PROJ + row * DIN + C_GB + col);
    const float m0 = aa[0][0][0] * sigm(bflo(ga.x)) + ab[0][0][0] * sigm(bflo(gb.x)), m1 = aa[0][0][1] * sigm(bfhi(ga.x)) + ab[0][0][1] * sigm(bfhi(gb.x));
    const float m2 = aa[0][0][2] * sigm(bflo(ga.y)) + ab[0][0][2] * sigm(bflo(gb.y)), m3 = aa[0][0][3] * sigm(bfhi(ga.y)) + ab[0][0][3] * sigm(bfhi(gb.y));
    v2u w; w.x = pk2(m0, m1); w.y = pk2(m2, m3); *(v2u*)(MRG + row * DM + col) = w;
}
__device__ __forceinline__ void sg_out_task(int ts, const bf16* MRG, const bf16* WOUT_T, bf16* OUTB, int wave, int lane) {
    const int fr = lane & 15, fq = lane >> 4; const int n0 = 16 * (ts & 63); const int r0 = MP + 128 * (ts >> 6) + 16 * wave;
    f32x4 aa[1][1]; aa[0][0] = (f32x4){0.f, 0.f, 0.f, 0.f};
    sg_mma<1, 1>(aa, MRG + (size_t)r0 * DM, WOUT_T + (size_t)n0 * DM, DM, lane);
    { v2u w; w.x = pk2(aa[0][0][0], aa[0][0][1]); w.y = pk2(aa[0][0][2], aa[0][0][3]); *(v2u*)(OUTB + ((size_t)r0 + fr) * DM + n0 + 4 * fq) = w; }
}

struct Args { const float* in[19]; float* out; unsigned char* ws; };
__global__ void __launch_bounds__(NTHR, 2) fwd_kernel(Args args) {
    extern __shared__ __attribute__((aligned(16))) unsigned char lds_raw[];
    cg::grid_group grid = cg::this_grid();
    LAS unsigned char* lds = (LAS unsigned char*)lds_raw;
    const int tid = threadIdx.x, lane = tid & 63, wave = __builtin_amdgcn_readfirstlane(tid >> 6);
    const int G = gridDim.x, bx = blockIdx.x;
    const int gw = bx * NWAVES + wave, NGW = G * NWAVES;
    const float* xp = args.in[0]; const float* xs = args.in[1];
    const float* c128 = args.in[2]; const float* c512 = args.in[3]; const float* c2048 = args.in[4];
    const float* cpr = args.in[5]; const float* csm = args.in[6]; const float* wcond = args.in[7]; const float* bcond = args.in[8]; const float* gpre = args.in[9];
    const float* win = args.in[10]; const float* lng = args.in[11]; const float* lnb = args.in[12]; const float* wsp = args.in[13]; const float* bsp = args.in[14];
    const float* wpa = args.in[15]; const float* wpb = args.in[16]; const float* wout = args.in[17]; const float* gpost = args.in[18];
    float* out = args.out; unsigned char* ws = args.ws;
    bf16* WIN_T = (bf16*)(ws + WS_WIN); bf16* WPA_T = (bf16*)(ws + WS_WPA); bf16* WPB_T = (bf16*)(ws + WS_WPB); bf16* WOUT_T = (bf16*)(ws + WS_WOUT);
    float* MOD = (float*)(ws + WS_MOD); float* VST = (float*)(ws + WS_VST); float* ML = (float*)(ws + WS_ML);
    bf16* H = (bf16*)(ws + WS_H); bf16* YA = (bf16*)(ws + WS_YA); bf16* YB = (bf16*)(ws + WS_YB); bf16* MRG = (bf16*)(ws + WS_MRG); bf16* O3 = (bf16*)(ws + WS_O3);
    bf16* PART = (bf16*)(ws + WS_PART); bf16* OUTB = (bf16*)(ws + WS_OUT); bf16* PROJ = (bf16*)(ws + WS_PROJ);

    unsigned* barw = (unsigned*)(ws + 16384);
    volatile LAS unsigned* bst = (volatile LAS unsigned*)(lds + 139264);
    if (tid < 2) bst[tid] = 0u;
    __syncthreads();
    const XcdBarrier xbar = xcd_barrier_post(barw, bst);
    if (args.ws == nullptr) grid.sync();
    if (bx < 192) mod_task(bx, cpr, csm, wcond, bcond, MOD, lds, tid, wave, lane);
    {
        LAS float* scr = (LAS float*)(lds + wave * 16384);
        constexpr int I_IN = (1024 / 64) * (DIN / 32), I_PA = (1024 / 64) * (1024 / 32), I_PB = (512 / 64) * (1024 / 32), I_OUT = I_PA;
        constexpr int NITEMS = I_IN + I_PA + I_PB + I_OUT;
        for (int it = gw; it < NITEMS; it += NGW) {
            int r = it;
            if (r < I_IN) { p0_transpose_item(win, 1024, DIN, WIN_T, 0, scr, r, lane); continue; } r -= I_IN;
            if (r < I_PA) { p0_transpose_item(wpa, 1024, 1024, WPA_T, 0, scr, r, lane); continue; } r -= I_PA;
            if (r < I_PB) { p0_transpose_item(wpb, 512, 1024, WPB_T, 0, scr, r, lane); continue; } r -= I_PB;
            p0_transpose_item(wout, 1024, 1024, WOUT_T, 0, scr, r, lane);
        }
    }
    xcd_barrier(xbar);
    for (int rb = gw; rb < MT / 8; rb += NGW) {
        const int rowb = rb * 8;
        const float* mod = MOD + (rowb < MP ? (rowb >> 11) : 8 + ((rowb - MP) >> 3)) * 3072;
        f32x4 gs[4], sh[4];
#pragma unroll
        for (int j = 0; j < 4; ++j) { const int c = 4 * lane + 256 * j; f32x4 a = (f32x4){0.f, 0.f, 0.f, 0.f}, s2 = (f32x4){1.f, 1.f, 1.f, 1.f};
#pragma unroll
            for (int q = 0; q < 4; ++q) { a += *(const f32x4*)(mod + (size_t)q * 40 * 3072 + c); s2 += *(const f32x4*)(mod + (size_t)q * 40 * 3072 + 1024 + c); }
            sh[j] = a; gs[j] = s2 * *(const f32x4*)(gpre + c); }
        const float* xb = rowb < MP ? xp + (size_t)rowb * DM : xs + (size_t)(rowb - MP) * DM;
#pragma unroll 1
        for (int i0 = 0; i0 < 8; i0 += 4) {
            f32x4 v[4][4];
#pragma unroll
            for (int i = 0; i < 4; ++i)
#pragma unroll
                for (int j = 0; j < 4; ++j) v[i][j] = ((const f32x4*)(xb + (size_t)(i0 + i) * DM))[lane + 64 * j];
#pragma unroll
            for (int i = 0; i < 4; ++i) { float ss = 0.f;
#pragma unroll
                for (int j = 0; j < 4; ++j) ss += (v[i][j][0] * v[i][j][0] + v[i][j][1] * v[i][j][1]) + (v[i][j][2] * v[i][j][2] + v[i][j][3] * v[i][j][3]);
                const float rstd = rsqrtf(wave_sum(ss) * (1.f / DM) + EPS);
#pragma unroll
                for (int j = 0; j < 4; ++j) { const int c = 4 * lane + 256 * j; const f32x4 hh = v[i][j] * rstd * gs[j] + sh[j];
                    v2u w; w.x = pk2(hh[0], hh[1]); w.y = pk2(hh[2], hh[3]); *(v2u*)(H + (size_t)(rowb + i0 + i) * DM + c) = w; } } }
    }
    xcd_barrier(xbar);
    {
        if (bx < 160) sg_proj_task(bx, H, WIN_T, PROJ, out, VST, wave, lane);
        pg8::Gemm gm{H, WIN_T, MP, DIN, DM}; pg8::StaticOrder S; S.init(MP, DIN, G, bx);
        pg8::EpiProj E{PROJ, out, VST};
        pg8::gemm_phase<pg8::EpiProj, pg8::StaticOrder, true, true>(lds, gm, S, E);
    }
    xcd_barrier(xbar);
    {
        constexpr int N_ATT = 3072, N_GM = 1024, N_SA = 768, N_SG = 32;
        const bool sa_first = false;
        if (sa_first) {
            for (int it = bx; it < N_SA; it += G) attn_sample_item(it, PROJ, c128, c512, c2048, O3, ML, wave, lane);
        }
        {
            v4u kA[4], vA[4], kB[4], vB[4]; bf16x8 qA0, qA1, qB0, qB1;
            if (bx < N_ATT) att_prefetch(bx, PROJ, tid, wave, lane, kA, vA, qA0, qA1);
            if (bx + G < N_ATT) att_prefetch(bx + G, PROJ, tid, wave, lane, kB, vB, qB0, qB1);
            const int key = tid >> 1, half = tid & 1;
            LAS bf16* kdst = (LAS bf16*)lds + key * 72 + half * 32; LAS bf16* vdst = (LAS bf16*)(lds + 36864) + key * 72 + half * 32;
            for (int it = bx; it < N_ATT; it += 2 * G) {
                {
#pragma unroll
                    for (int c = 0; c < 4; ++c) { *(LAS v4u*)(kdst + 8 * c) = kA[c]; *(LAS v4u*)(vdst + 8 * c) = vA[c]; }
                    const bf16x8 Qc0 = qA0, Qc1 = qA1;
                    __syncthreads();
                    if (it + 2 * G < N_ATT) att_prefetch(it + 2 * G, PROJ, tid, wave, lane, kA, vA, qA0, qA1);
                    att_compute(it, O3, ML, lds, wave, lane, Qc0, Qc1);
                    __syncthreads();
                }
                if (it + G < N_ATT) {
#pragma unroll
                    for (int c = 0; c < 4; ++c) { *(LAS v4u*)(kdst + 8 * c) = kB[c]; *(LAS v4u*)(vdst + 8 * c) = vB[c]; }
                    const bf16x8 Qc0 = qB0, Qc1 = qB1;
                    __syncthreads();
                    if (it + 3 * G < N_ATT) att_prefetch(it + 3 * G, PROJ, tid, wave, lane, kB, vB, qB0, qB1);
                    att_compute(it + G, O3, ML, lds, wave, lane, Qc0, Qc1);
                    __syncthreads();
                }
            }
        }
        for (int it = bx; it < N_GM; it += G) gmlp_item(it, PROJ, VST, wsp, bsp, lng, lnb, YA, lds, tid, wave, lane);
        if (!sa_first) {
            for (int it = bx; it < N_SA; it += G) attn_sample_item(it, PROJ, c128, c512, c2048, O3, ML, wave, lane);
        }
        for (int it = bx; it < N_SG; it += G) gmlp_sample_item(it, PROJ, VST, wsp, bsp, lng, lnb, YA, out, lds, tid, wave, lane);
    }
    xcd_barrier(xbar);
    for (int row = gw; row < MT; row += NGW) {
        const int head = lane >> 3;
        float mg[3], lg[3];
#pragma unroll
        for (int g = 0; g < 3; ++g) { const f32x2 a = *(const f32x2*)(ML + (((size_t)g * MT + row) * 8 + head) * 2); mg[g] = a[0]; lg[g] = a[1]; }
        const float mm = fmaxf(fmaxf(mg[0], mg[1]), mg[2]);
        float wg[3]; float den = 0.f;
#pragma unroll
        for (int g = 0; g < 3; ++g) { wg[g] = __expf(mg[g] - mm) * lg[g]; den += wg[g]; }
        const float rden = 1.f / den;
        float o[8] = {0.f, 0.f, 0.f, 0.f, 0.f, 0.f, 0.f, 0.f};
#pragma unroll
        for (int g = 0; g < 3; ++g) { const v4u raw = *(const v4u*)(O3 + ((size_t)g * MT + row) * 512 + lane * 8); const float w = wg[g] * rden;
            o[0] += w * bflo(raw.x); o[1] += w * bfhi(raw.x); o[2] += w * bflo(raw.y); o[3] += w * bfhi(raw.y); o[4] += w * bflo(raw.z); o[5] += w * bfhi(raw.z); o[6] += w * bflo(raw.w); o[7] += w * bfhi(raw.w); }
        const v4u zr = *(const v4u*)(PROJ + (size_t)row * DIN + C_ZB + lane * 8);
        v4u w; w.x = pk2(o[0] * silu(bflo(zr.x)), o[1] * silu(bfhi(zr.x))); w.y = pk2(o[2] * silu(bflo(zr.y)), o[3] * silu(bfhi(zr.y)));
        w.z = pk2(o[4] * silu(bflo(zr.z)), o[5] * silu(bfhi(zr.z))); w.w = pk2(o[6] * silu(bflo(zr.w)), o[7] * silu(bfhi(zr.w)));
        *(v4u*)(YB + (size_t)row * 512 + lane * 8) = w;
    }
    xcd_barrier(xbar);
    {
        if (bx < 128) sg_merge_task(bx, YA, YB, WPA_T, WPB_T, PROJ, MRG, wave, lane);
        pg8::Gemm gm{YA, WPA_T, MP, DM, DM}; pg8::StaticOrder S; S.init(MP, DM, G, bx);
        pg8::EpiGateA E{PROJ, PART};
        pg8::gemm_phase<pg8::EpiGateA, pg8::StaticOrder, true, true>(lds, gm, S, E);
    }
    {
        pg8::Gemm gm{YB, WPB_T, MP, DM, 512}; pg8::StaticOrder S; S.init(MP, DM, G, bx);
        pg8::EpiGateB E{PROJ, PART, MRG};
        pg8::gemm_phase<pg8::EpiGateB, pg8::StaticOrder, true, true>(lds, gm, S, E);
    }
    xcd_barrier(xbar);
    {
        if (bx < 128) sg_out_task(bx, MRG, WOUT_T, OUTB, wave, lane);
        pg8::Gemm gm{MRG, WOUT_T, MP, DM, DM}; pg8::StaticOrder S; S.init(MP, DM, G, bx);
        pg8::EpiF32 E{OUTB};
        pg8::gemm_phase<pg8::EpiF32, pg8::StaticOrder, true, true>(lds, gm, S, E);
    }
    xcd_barrier(xbar);
    for (int rb = gw; rb < MT / 8; rb += NGW) {
        const int rowb = rb * 8;
        const float* gate = MOD + (rowb < MP ? (rowb >> 11) : 8 + ((rowb - MP) >> 3)) * 3072 + 2048;
        f32x4 gt[4];
#pragma unroll
        for (int j = 0; j < 4; ++j) { const int c = 4 * lane + 256 * j; f32x4 a = (f32x4){0.f, 0.f, 0.f, 0.f};
#pragma unroll
            for (int q = 0; q < 4; ++q) a += *(const f32x4*)(gate + (size_t)q * 40 * 3072 + c);
            gt[j] = a * *(const f32x4*)(gpost + c); }
        const float* xb = rowb < MP ? xp + (size_t)rowb * DM : xs + (size_t)(rowb - MP) * DM;
#pragma unroll 1
        for (int i0 = 0; i0 < 8; i0 += 4) {
            v2u ov[4][4]; f32x4 xv[4][4];
#pragma unroll
            for (int i = 0; i < 4; ++i)
#pragma unroll
                for (int j = 0; j < 4; ++j) { ov[i][j] = ((const v2u*)(OUTB + (size_t)(rowb + i0 + i) * DM))[lane + 64 * j]; xv[i][j] = ((const f32x4*)(xb + (size_t)(i0 + i) * DM))[lane + 64 * j]; }
#pragma unroll
            for (int i = 0; i < 4; ++i) { f32x4 v[4]; float ss = 0.f;
#pragma unroll
                for (int j = 0; j < 4; ++j) { v[j] = (f32x4){bflo(ov[i][j].x), bfhi(ov[i][j].x), bflo(ov[i][j].y), bfhi(ov[i][j].y)}; ss += (v[j][0] * v[j][0] + v[j][1] * v[j][1]) + (v[j][2] * v[j][2] + v[j][3] * v[j][3]); }
                const float rstd = rsqrtf(wave_sum(ss) * (1.f / DM) + EPS);
#pragma unroll
                for (int j = 0; j < 4; ++j) { const int c = 4 * lane + 256 * j;
                    *(f32x4*)(out + (size_t)(rowb + i0 + i) * DM + c) = xv[i][j] + gt[j] * (v[j] * rstd); } } }
    }
}

extern "C" void kernel_launch(void* const* d_in, const int* in_sizes, int n_in, void* d_out, int out_size, void* d_ws, size_t ws_size, hipStream_t stream) {
    static int grid = 0;
    if (grid == 0) {
        if (n_in != 19 || (size_t)out_size != O_END || ws_size < WS_END) { fprintf(stderr, "kernel_launch: unexpected shapes: n_in %d out %d ws %zu\n", n_in, out_size, ws_size); grid = -1; return; }
        int dev = 0, cus = 0, per_cu = 0;
        if (hipGetDevice(&dev) != hipSuccess || hipDeviceGetAttribute(&cus, hipDeviceAttributeMultiprocessorCount, dev) != hipSuccess) { fprintf(stderr, "kernel_launch: device query failed\n"); grid = -1; return; }
        if (hipFuncSetAttribute((const void*)fwd_kernel, hipFuncAttributeMaxDynamicSharedMemorySize, LDS_BYTES) != hipSuccess) { fprintf(stderr, "kernel_launch: hipFuncSetAttribute failed\n"); grid = -1; return; }
        if (hipOccupancyMaxActiveBlocksPerMultiprocessor(&per_cu, (const void*)fwd_kernel, NTHR, LDS_BYTES) != hipSuccess || per_cu < 1) { fprintf(stderr, "kernel_launch: occupancy query says %d blocks per CU\n", per_cu); }
        (void)hipGetLastError();
        grid = cus;
    }
    if (grid < 0) return;
    if (hipMemsetAsync((char*)d_ws + 16384, 0, 16384, stream) != hipSuccess) { fprintf(stderr, "kernel_launch: memset of the barrier words failed\n"); return; }
    Args a{};
    for (int i = 0; i < 19; ++i) a.in[i] = (const float*)d_in[i];
    a.out = (float*)d_out; a.ws = (unsigned char*)d_ws;
    void* kargs[] = {&a};
    hipError_t e = hipLaunchCooperativeKernel((const void*)fwd_kernel, dim3(grid), dim3(NTHR), kargs, LDS_BYTES, stream);
    if (e != hipSuccess) fprintf(stderr, "kernel_launch: cooperative launch failed: %s (grid %d)\n", hipGetErrorString(e), grid);
}
```

```cpp
#include <hip/hip_runtime.h>
#include <hip/hip_cooperative_groups.h>
#include <cstdio>
#include <cstdint>
namespace cg = cooperative_groups;
namespace pg8 {
#define PG8_LAS __attribute__((address_space(3)))
typedef unsigned short bf16_t;
typedef short bf16x8 __attribute__((ext_vector_type(8)));
typedef float f32x4 __attribute__((ext_vector_type(4)));
typedef unsigned u32x4 __attribute__((ext_vector_type(4)));
constexpr int BM = 256, BK = 64, HALF = 128, HTB = HALF * BK * 2  , STAGE_BYTES = 8 * HTB, NXCD = 8, WGM = 8;

__host__ __device__ __forceinline__ int lds_byte(int r, int c) { const int st = (r >> 4) * 2 + (c >> 5), rr = r & 15, cc = c & 31, ob = rr * 64 + cc * 2; return st * 1024 + (ob ^ (((ob >> 9) & 1) << 5)); }
__host__ __device__ __forceinline__ void stage_rc(int b, int& R, int& C) { const int st = b / 1024, sb = b % 1024, swz = sb ^ (((sb >> 9) & 1) << 5); R = (st >> 1) * 16 + swz / 64; C = (st & 1) * 32 + (swz % 64) / 2; }
__host__ __device__ __forceinline__ int perm32(int rho) { const int n = rho >> 4, i = rho & 15; return 8 * (i >> 2) + 4 * n + (i & 3); }

struct Unit { int pm, pn; };
struct Gemm { const bf16_t* A; const bf16_t* Bt; int M, N, K; };

struct StaticOrder {
    int nM, nN, nwg, G, c;
    __host__ __device__ void init(int M, int N, int G_, int c_) { nM = M / BM; nN = N / BM; nwg = nM * nN; G = G_; c = c_; }
    __host__ __device__ bool next(int i, Unit& u) const {
        const long L = (long)i * G + c; if (L >= nwg) return false;
        int wgid = (int)L; { const int q = nwg / NXCD, r = nwg % NXCD, xcd = wgid % NXCD, off = wgid / NXCD; wgid = (xcd < r ? xcd * (q + 1) : r * (q + 1) + (xcd - r) * q) + off; }
        const int nig = WGM * nN, gid = wgid / nig, fm = gid * WGM, gsz = (nM - fm) < WGM ? (nM - fm) : WGM;
        u.pm = fm + ((wgid % nig) % gsz); u.pn = (wgid % nig) / gsz; return true;
    }
    __device__ __forceinline__ void a_ready(const Unit&) const {}
    __device__ __forceinline__ void done(const Unit&) const {}
};
__device__ __forceinline__ unsigned cvt_pk_bf16(float lo, float hi) { unsigned r; asm volatile("v_cvt_pk_bf16_f32 %0, %1, %2" : "=v"(r) : "v"(lo), "v"(hi)); return r; }
typedef float f32x2 __attribute__((ext_vector_type(2)));
template <class Epi, class Sched, bool ALIGN_EPI = false, bool SP2 = false>
__device__ __forceinline__ void gemm_phase(PG8_LAS unsigned char* lds, const Gemm g, const Sched& S, const Epi& E) {
    const int tid = threadIdx.x, wid = __builtin_amdgcn_readfirstlane(tid >> 6), lane = tid & 63, wr = wid >> 2, wc = wid & 3, fr = lane & 15, fq = lane >> 4;
    const int K = g.K, nt = K / BK;
    unsigned voffA[2], voffB[2];
#pragma unroll
    for (int i = 0; i < 2; ++i) { int R, C; stage_rc(tid * 16 + i * 8192, R, C); const int Rb = Epi::PERM ? ((R & ~31) + perm32(R & 31)) : R;
        voffA[i] = (unsigned)(R * K + C) * 2u; voffB[i] = (unsigned)(Rb * K + C) * 2u; }
    const size_t kstep = (size_t)(BK * 2);
    const size_t hstep = (size_t)HALF * K * 2;
    const size_t tstep = 2 * hstep;
    const unsigned ldsw = (unsigned)wid * 1024u;
    const int aoff = lds_byte(wr * 64 + fr, fq * 8), boff = lds_byte(wc * 32 + fr, fq * 8);
#define PG8_SA(b, h) (((b) * 2 + (h)) * HTB)
#define PG8_SB(b, h) ((4 + (b) * 2 + (h)) * HTB)
#define PG8_STAGE(bufoff, gbase, voff) do { _Pragma("unroll") for (int _i = 0; _i < 2; ++_i) \
        __builtin_amdgcn_global_load_lds((const unsigned*)((const char*)(gbase) + (voff)[_i]), (PG8_LAS unsigned*)(lds + (bufoff) + ldsw + _i * 8192), 16, 0, 0); } while (0)
#define PG8_LDA(dst, b, h) do { _Pragma("unroll") for (int m = 0; m < 4; ++m) _Pragma("unroll") for (int k = 0; k < 2; ++k) dst[m][k] = *(const PG8_LAS bf16x8*)(lds + PG8_SA(b, h) + aoff + m * 2048 + k * 1024); } while (0)
#define PG8_LDB(dst, b, h) do { _Pragma("unroll") for (int n = 0; n < 2; ++n) _Pragma("unroll") for (int k = 0; k < 2; ++k) dst[n][k] = *(const PG8_LAS bf16x8*)(lds + PG8_SB(b, h) + boff + n * 2048 + k * 1024); } while (0)
#define PG8_MMA(ai, bj, At, Bt) do { __builtin_amdgcn_s_setprio(1); _Pragma("unroll") for (int m = 0; m < 4; ++m) _Pragma("unroll") for (int n = 0; n < 2; ++n) _Pragma("unroll") for (int k = 0; k < 2; ++k) \
        acc[ai][bj][m][n] = __builtin_amdgcn_mfma_f32_16x16x32_bf16(Bt[n][k], At[m][k], acc[ai][bj][m][n], 0, 0, 0); __builtin_amdgcn_s_setprio(0); } while (0)
#define PG8_WAIT_V(n) asm volatile("s_waitcnt vmcnt(" #n ")" ::: "memory")
#define PG8_WAIT_L(n) asm volatile("s_waitcnt lgkmcnt(" #n ")" ::: "memory")
#define PG8_BAR __builtin_amdgcn_s_barrier()
#define PG8_SCHED __builtin_amdgcn_sched_barrier(0)
    Unit cur, nxt; int ui = 0;
    if (!S.next(0, cur)) return;
    f32x4 acc[2][2][4][2];
#pragma unroll
    for (int a = 0; a < 2; ++a)
#pragma unroll
        for (int b = 0; b < 2; ++b)
#pragma unroll
            for (int m = 0; m < 4; ++m)
#pragma unroll
                for (int n = 0; n < 2; ++n) acc[a][b][m][n] = (f32x4){0.f, 0.f, 0.f, 0.f};
    bf16x8 At[4][2], B0[2][2], B1[2][2];
    const char* cA = (const char*)g.A + (size_t)cur.pm * tstep; const char* cB = (const char*)g.Bt + (size_t)cur.pn * tstep;
    S.a_ready(cur);
    if constexpr (SP2) {
        PG8_STAGE(PG8_SB(0, 0), cB, voffB); PG8_STAGE(PG8_SB(0, 1), cB + hstep, voffB); PG8_STAGE(PG8_SA(0, 0), cA, voffA); PG8_STAGE(PG8_SA(0, 1), cA + hstep, voffA);
        if (wr == 1) PG8_BAR;
        PG8_WAIT_V(2); PG8_BAR;
        PG8_STAGE(PG8_SB(1, 0), cB + kstep, voffB); PG8_STAGE(PG8_SA(1, 0), cA + kstep, voffA); PG8_STAGE(PG8_SB(1, 1), cB + hstep + kstep, voffB);
        PG8_WAIT_V(6); PG8_BAR;
    } else {
        PG8_STAGE(PG8_SB(0, 0), cB, voffB); PG8_STAGE(PG8_SA(0, 0), cA, voffA); PG8_STAGE(PG8_SB(0, 1), cB + hstep, voffB); PG8_STAGE(PG8_SA(0, 1), cA + hstep, voffA);
        if (wr == 1) PG8_BAR;
        PG8_WAIT_V(4); PG8_BAR;
        PG8_STAGE(PG8_SB(1, 0), cB + kstep, voffB); PG8_STAGE(PG8_SA(1, 0), cA + kstep, voffA); PG8_STAGE(PG8_SB(1, 1), cB + hstep + kstep, voffB);
        PG8_WAIT_V(6); PG8_BAR;
    }
    for (;;) {
        const bool has_next = S.next(ui + 1, nxt);
        const char* nA = has_next ? (const char*)g.A + (size_t)nxt.pm * tstep : cA; const char* nB = has_next ? (const char*)g.Bt + (size_t)nxt.pn * tstep : cB;
        for (int t = 0; t < nt; t += 2) {
            if constexpr (Epi::HAS_MID) { if (t == Epi::MID_T) E.mid(acc, cur, wr, wc, fr, fq); }
            const bool last = (t == nt - 2);
            const char* a1 = cA + (size_t)(t + 1) * kstep;
            const char* a2 = last ? nA : cA + (size_t)(t + 2) * kstep; const char* b2 = last ? nB : cB + (size_t)(t + 2) * kstep;
            const char* a3 = a2 + kstep; const char* b3 = b2 + kstep;
            if (last && has_next) S.a_ready(nxt);
            if constexpr (SP2) {
            PG8_LDB(B0, 0, 0); PG8_LDB(B1, 0, 1); PG8_SCHED; PG8_LDA(At, 0, 0); PG8_STAGE(PG8_SA(1, 1), a1 + hstep, voffA);
            PG8_WAIT_V(8); PG8_WAIT_L(0); PG8_BAR; PG8_MMA(0, 0, At, B0); PG8_MMA(0, 1, At, B1); PG8_BAR; PG8_SCHED;
            PG8_LDA(At, 0, 1); PG8_STAGE(PG8_SB(0, 0), b2, voffB); PG8_STAGE(PG8_SB(0, 1), b2 + hstep, voffB); PG8_STAGE(PG8_SA(0, 0), a2, voffA);
            PG8_WAIT_V(8); PG8_WAIT_L(0); PG8_BAR; PG8_MMA(1, 0, At, B0); PG8_MMA(1, 1, At, B1); PG8_BAR; PG8_SCHED;
            PG8_LDB(B0, 1, 0); PG8_LDB(B1, 1, 1); PG8_SCHED; PG8_LDA(At, 1, 0); PG8_STAGE(PG8_SA(0, 1), a2 + hstep, voffA);
            PG8_WAIT_V(8); PG8_WAIT_L(0); PG8_BAR; PG8_MMA(0, 0, At, B0); PG8_MMA(0, 1, At, B1); PG8_BAR; PG8_SCHED;
            PG8_LDA(At, 1, 1); PG8_STAGE(PG8_SB(1, 0), b3, voffB); PG8_STAGE(PG8_SB(1, 1), b3 + hstep, voffB); PG8_STAGE(PG8_SA(1, 0), a3, voffA);
            PG8_WAIT_V(8); PG8_WAIT_L(0); PG8_BAR; PG8_MMA(1, 0, At, B0); PG8_MMA(1, 1, At, B1); PG8_BAR; PG8_SCHED;
            } else {
            PG8_LDB(B0, 0, 0); PG8_SCHED; PG8_LDA(At, 0, 0); PG8_STAGE(PG8_SA(1, 1), a1 + hstep, voffA);
            PG8_WAIT_L(8); PG8_BAR; PG8_WAIT_L(0); PG8_MMA(0, 0, At, B0); PG8_BAR; PG8_SCHED;
            PG8_LDB(B1, 0, 1); PG8_STAGE(PG8_SB(0, 0), b2, voffB);
            PG8_BAR; PG8_WAIT_L(0); PG8_MMA(0, 1, At, B1); PG8_BAR;
            PG8_LDA(At, 0, 1); PG8_STAGE(PG8_SA(0, 0), a2, voffA);
            PG8_BAR; PG8_WAIT_L(0); PG8_MMA(1, 0, At, B0); PG8_BAR; PG8_SCHED;
            PG8_STAGE(PG8_SB(0, 1), b2 + hstep, voffB);
            PG8_WAIT_V(6); PG8_BAR; PG8_MMA(1, 1, At, B1); PG8_BAR;
            PG8_LDB(B0, 1, 0); PG8_SCHED; PG8_LDA(At, 1, 0); PG8_STAGE(PG8_SA(0, 1), a2 + hstep, voffA);
            PG8_WAIT_L(8); PG8_BAR; PG8_WAIT_L(0); PG8_MMA(0, 0, At, B0); PG8_BAR; PG8_SCHED;
            PG8_LDB(B1, 1, 1); PG8_STAGE(PG8_SB(1, 0), b3, voffB);
            PG8_BAR; PG8_WAIT_L(0); PG8_MMA(0, 1, At, B1); PG8_BAR;
            PG8_LDA(At, 1, 1); PG8_STAGE(PG8_SA(1, 0), a3, voffA);
            PG8_BAR; PG8_WAIT_L(0); PG8_MMA(1, 0, At, B0); PG8_BAR; PG8_SCHED;
            PG8_STAGE(PG8_SB(1, 1), b3 + hstep, voffB);
            PG8_WAIT_V(6); PG8_BAR; PG8_MMA(1, 1, At, B1); PG8_BAR;
            }
        }
        if constexpr (ALIGN_EPI) { if (wr == 0) PG8_BAR; }
        if constexpr (!Epi::AFTER_DRAIN) { E(acc, cur, wr, wc, fr, fq); S.done(cur); }
        if (!has_next) break;
#pragma unroll
        for (int a = 0; a < 2; ++a)
#pragma unroll
            for (int b = 0; b < 2; ++b)
#pragma unroll
                for (int m = 0; m < 4; ++m)
#pragma unroll
                    for (int n = 0; n < 2; ++n) acc[a][b][m][n] = (f32x4){0.f, 0.f, 0.f, 0.f};
        cur = nxt; cA = nA; cB = nB; ++ui;
        if constexpr (ALIGN_EPI) { if (wr == 1) PG8_BAR; }
    }
    PG8_WAIT_V(0);
    if constexpr (!ALIGN_EPI) { if (wr == 0) PG8_BAR; }
    PG8_BAR;
    if constexpr (Epi::AFTER_DRAIN) { E.fused(acc, cur, wr, wc, fr, fq, lds, wid, lane); S.done(cur); }
#undef PG8_SA
#undef PG8_SB
#undef PG8_STAGE
#undef PG8_LDA
#undef PG8_LDB
#undef PG8_MMA
#undef PG8_WAIT_V
#undef PG8_WAIT_L
#undef PG8_BAR
#undef PG8_SCHED
}
}

#define GAS __attribute__((address_space(1)))
#define LAS __attribute__((address_space(3)))
typedef unsigned short bf16;
typedef unsigned v4u __attribute__((ext_vector_type(4)));
typedef unsigned v2u __attribute__((ext_vector_type(2)));
typedef float f32x4 __attribute__((ext_vector_type(4)));
typedef float f32x2 __attribute__((ext_vector_type(2)));
typedef short bf16x8 __attribute__((ext_vector_type(8)));

constexpr int NWAVES = 8, NTHR = 512;
constexpr int DM = 1024, NBP = 8, SEQ = 2048, NBS = 32, TS = 8;
constexpr int MP = NBP * SEQ, MS = NBS * TS, MT = MP + MS;
constexpr int DIN = 10240;
constexpr int C_U = 0, C_V = 1024, C_Z = 2048, C_Q = 3072, C_K = 4608, C_VV = 6144, C_ZB = 7680, C_GA = 8192, C_GB = 9216;
constexpr float EPS = 1e-6f;
constexpr size_t O_Y = 0, O_KVP0 = (size_t)MT * DM, O_KVP1 = O_KVP0 + (size_t)8 * 128 * 1024, O_KVP2 = O_KVP1 + (size_t)8 * 512 * 1024,
                 O_KVS0 = O_KVP2 + (size_t)8 * 2048 * 1024, O_KVS1 = O_KVS0 + 262144, O_KVS2 = O_KVS1 + 262144, O_VCH = O_KVS2 + 262144, O_END = O_VCH + 262144;
constexpr size_t MiB = 1u << 20;
constexpr size_t WS_WIN = 2 * MiB, WS_WPA = 22 * MiB, WS_WPB = 24 * MiB, WS_WOUT = 25 * MiB, WS_MOD = 27 * MiB, WS_VST = 29 * MiB, WS_ML = 32 * MiB,
                 WS_H = 36 * MiB, WS_YA = 70 * MiB, WS_YB = 104 * MiB, WS_MRG = 122 * MiB, WS_O3 = 156 * MiB, WS_PART = 206 * MiB, WS_OUT = 272 * MiB,
                 WS_PROJ = 340 * MiB, WS_END = 672 * MiB;
static_assert(WS_PROJ + (size_t)MT * DIN * 2 <= WS_END, "ws map");
constexpr int LDS_BYTES = 147456;

#define LDS_WAIT() asm volatile("s_waitcnt lgkmcnt(0)" ::: "memory")
__device__ __forceinline__ unsigned f2bf(float f) { unsigned u = __builtin_bit_cast(unsigned, f); return (u + 0x7fffu + ((u >> 16) & 1u)) >> 16; }
typedef __bf16 bf16x2_t __attribute__((ext_vector_type(2)));
__device__ __forceinline__ unsigned pk2(float lo, float hi) { const f32x2 v = {lo, hi}; return __builtin_bit_cast(unsigned, __builtin_convertvector(v, bf16x2_t)); }
__device__ __forceinline__ float bflo(unsigned w) { return __builtin_bit_cast(float, w << 16); }
__device__ __forceinline__ float bfhi(unsigned w) { return __builtin_bit_cast(float, w & 0xffff0000u); }
__device__ __forceinline__ float bf2f(bf16 h) { return __builtin_bit_cast(float, (unsigned)h << 16); }
__device__ __forceinline__ float sigm(float x) { return __builtin_amdgcn_rcpf(1.f + __expf(-x)); }
__device__ __forceinline__ float silu(float x) { return x * __builtin_amdgcn_rcpf(1.f + __expf(-x)); }
__device__ __forceinline__ float wave_sum(float v) {
#pragma unroll
    for (int o = 1; o < 64; o <<= 1) v += __shfl_xor(v, o);
    return v;
}
__device__ __forceinline__ float wave_max(float v) {
#pragma unroll
    for (int o = 1; o < 64; o <<= 1) v = fmaxf(v, __shfl_xor(v, o));
    return v;
}
__device__ __forceinline__ float rdlane(float v, int l) { return __builtin_bit_cast(float, __builtin_amdgcn_readlane(__builtin_bit_cast(int, v), l)); }

#define XB_TMO      128
#define XB_XCNT(j)  (256  + 64 * (j))
#define XB_XSUB(j)  (1280 + 64 * (j))
#define XB_XGEN(j)  (2304 + 64 * (j))
#define XB_TOP      3328
#define XB_TOPGEN   3392
#define XCD_BAR_WORDS 3456
#define XB_SPIN_CAP (1u << 18)

__device__ __forceinline__ unsigned xb_ld(unsigned* p)              { return __hip_atomic_load(p, __ATOMIC_RELAXED, __HIP_MEMORY_SCOPE_AGENT); }
__device__ __forceinline__ unsigned xb_add(unsigned* p, unsigned v) { return __hip_atomic_fetch_add(p, v, __ATOMIC_RELAXED, __HIP_MEMORY_SCOPE_AGENT); }
__device__ __forceinline__ unsigned xb_xcc_id() { return (unsigned)__builtin_amdgcn_s_getreg((3 << 11) | 20) & 0xFu; }
#define XB_SPIN(cond, bar) do { unsigned _sp = 0; while (cond) { __builtin_amdgcn_s_sleep(1); \
    if ((++_sp & 255u) == 0u) { if (xb_ld(&(bar)[XB_TMO])) break; if (_sp > XB_SPIN_CAP) { atomicAdd(&(bar)[XB_TMO], 1u); break; } } } } while (0)

struct XcdBarrier {
    unsigned* bar; unsigned x;
    volatile LAS unsigned* st;
};

__device__ __forceinline__ XcdBarrier xcd_barrier_post(unsigned* bar, volatile LAS unsigned* st) {
    XcdBarrier b; b.bar = bar; b.x = xb_xcc_id(); b.st = st;
    if (threadIdx.x == 0) (void)xb_add(&bar[XB_XCNT(b.x)], 1u);
    return b;
}
__device__ __forceinline__ void xcd_barrier_complete(unsigned* bar, unsigned x, unsigned& nloc, unsigned& nx) {
    const unsigned G = gridDim.x * gridDim.y * gridDim.z;
    unsigned sum, cnt, mine, sp = 0u;
    for (;;) {
        sum = 0u; cnt = 0u; mine = 0u;
#pragma unroll
        for (unsigned j = 0; j < 16; ++j) { const unsigned c = xb_ld(&bar[XB_XCNT(j)]); sum += c; cnt += (c > 0u) ? 1u : 0u; mine = (j == x) ? c : mine; }
        if (sum == G) break;
        __builtin_amdgcn_s_sleep(1);
        if ((++sp & 255u) == 0u) { if (xb_ld(&bar[XB_TMO])) break; if (sp > XB_SPIN_CAP) { atomicAdd(&bar[XB_TMO], 1u); break; } }
    }
    nloc = mine > 0u ? mine : 1u; nx = cnt > 0u ? cnt : 1u;
}

__device__ __forceinline__ void xcd_barrier(const XcdBarrier& b) {
    asm volatile("s_waitcnt vmcnt(0)" ::: "memory");
    __syncthreads();
    if (threadIdx.x == 0) {
        unsigned* bar = b.bar;
        __builtin_amdgcn_s_waitcnt(0);
        unsigned nloc = b.st[0], nx = b.st[1];
        if (nloc == 0u) { xcd_barrier_complete(bar, b.x, nloc, nx); b.st[0] = nloc; b.st[1] = nx; }
        const unsigned old = xb_add(&bar[XB_XSUB(b.x)], 1u);
        const unsigned gen = old / nloc;
        if (old + 1u == (gen + 1u) * nloc) {
            __builtin_amdgcn_fence(__ATOMIC_RELEASE, "agent");
            asm volatile("s_waitcnt vmcnt(0)" ::: "memory");
            const unsigned og = xb_add(&bar[XB_TOP], 1u);
            const unsigned tg = og / nx;
            if (og + 1u == (tg + 1u) * nx) xb_add(&bar[XB_TOPGEN], 1u);
            else XB_SPIN(xb_ld(&bar[XB_TOPGEN]) == tg, bar);
            __builtin_amdgcn_fence(__ATOMIC_ACQUIRE, "agent");
            xb_add(&bar[XB_XGEN(b.x)], 1u);
            asm volatile("s_waitcnt vmcnt(0)" ::: "memory");
        } else {
            XB_SPIN(xb_ld(&bar[XB_XGEN(b.x)]) == gen, bar);
            __builtin_amdgcn_fence(__ATOMIC_ACQUIRE, "agent");
            asm volatile("s_waitcnt vmcnt(0)" ::: "memory");
        }
    }
    __syncthreads();
}

namespace pg8 {
struct EpiProj {
    static constexpr bool PERM = true, AFTER_DRAIN = false, HAS_MID = false; static constexpr int MID_T = -1;
    bf16_t* P; float* out; float* vst;
    __device__ __forceinline__ void operator()(const f32x4 (&acc)[2][2][4][2], const Unit& u, int wr, int wc, int fr, int fq) const {
        const int row0 = u.pm * BM + wr * 64 + fr;
        const int colt = u.pn * BM + wc * 32 + 8 * fq;
#pragma unroll
        for (int ai = 0; ai < 2; ++ai)
#pragma unroll
            for (int m = 0; m < 4; ++m) { bf16_t* rowp = P + (size_t)(row0 + ai * HALF + m * 16) * DIN + colt;
#pragma unroll
                for (int bj = 0; bj < 2; ++bj) { const f32x4 v0 = acc[ai][bj][m][0], v1 = acc[ai][bj][m][1];
                    u32x4 w; w.x = cvt_pk_bf16(v0[0], v0[1]); w.y = cvt_pk_bf16(v0[2], v0[3]); w.z = cvt_pk_bf16(v1[0], v1[1]); w.w = cvt_pk_bf16(v1[2], v1[3]);
                    *(u32x4*)(rowp + bj * HALF) = w; } }
        if (u.pn >= 4 && u.pn < 8) {
#pragma unroll
            for (int ai = 0; ai < 2; ++ai)
#pragma unroll
                for (int m = 0; m < 4; ++m) { float s = 0.f, q = 0.f;
#pragma unroll
                    for (int bj = 0; bj < 2; ++bj)
#pragma unroll
                        for (int n = 0; n < 2; ++n) { const f32x4 x = acc[ai][bj][m][n]; s += (x[0] + x[1]) + (x[2] + x[3]); q += (x[0] * x[0] + x[1] * x[1]) + (x[2] * x[2] + x[3] * x[3]); }
                    s += __shfl_xor(s, 16); s += __shfl_xor(s, 32); q += __shfl_xor(q, 16); q += __shfl_xor(q, 32);
                    if (fq == 0) { float* d = vst + ((size_t)(row0 + ai * HALF + m * 16) * 16 + (u.pn - 4) * 4 + wc) * 2; *(f32x2*)d = (f32x2){s, q}; } }
        }
        if (u.pn >= 18 && u.pn < 30) {
            const int kv = u.pn >= 24 ? 1 : 0; const int t = u.pn - 18 - 6 * kv; const int g = t >> 1, half = t & 1;
            const int dcol = kv * 512 + half * 256 + wc * 32 + 8 * fq;
            const int R = g == 0 ? 128 : (g == 1 ? 512 : 2048);
            const size_t obp = g == 0 ? O_KVP0 : (g == 1 ? O_KVP1 : O_KVP2), obs = g == 0 ? O_KVS0 : (g == 1 ? O_KVS1 : O_KVS2);
#pragma unroll
            for (int ai = 0; ai < 2; ++ai)
#pragma unroll
                for (int m = 0; m < 4; ++m) { const int row = row0 + ai * HALF + m * 16; float* base = nullptr;
                    if (row < MP) { const int b = row >> 11, s = row & 2047, r = s - (2048 - R); if (r >= 0) base = out + obp + (size_t)(b * R + r) * 1024 + dcol; }
                    else base = out + obs + (size_t)(row - MP) * 1024 + dcol;
                    if (base) {
#pragma unroll
                        for (int bj = 0; bj < 2; ++bj)
#pragma unroll
                            for (int n = 0; n < 2; ++n) *(f32x4*)(base + bj * HALF + 4 * n) = acc[ai][bj][m][n]; } }
        }
    }
};
struct EpiMerge {
    static constexpr bool PERM = true, AFTER_DRAIN = false, HAS_MID = true; static constexpr int MID_T = 16;
    const bf16_t* P; bf16_t* mrg;
    __device__ __forceinline__ void mid(f32x4 (&acc)[2][2][4][2], const Unit& u, int wr, int wc, int fr, int fq) const {
        int ln = (int)__builtin_amdgcn_mbcnt_hi(~0u, __builtin_amdgcn_mbcnt_lo(~0u, 0u));
        asm volatile("" : "+v"(ln));
        const int row0 = u.pm * BM + wr * 64 + (ln & 15); const int colt = u.pn * BM + wc * 32 + 8 * (ln >> 4);
#pragma unroll
        for (int ai = 0; ai < 2; ++ai)
#pragma unroll
            for (int m = 0; m < 4; ++m) { const size_t row = (size_t)(row0 + ai * HALF + m * 16); const bf16_t* gp = P + row * DIN + colt;
#pragma unroll
                for (int bj = 0; bj < 2; ++bj)
#pragma unroll
                    for (int n = 0; n < 2; ++n) { typedef unsigned u32x2 __attribute__((ext_vector_type(2)));
                        const u32x2 ga = *(const u32x2*)(gp + C_GA + bj * HALF + 4 * n), gb = *(const u32x2*)(gp + C_GB + bj * HALF + 4 * n);
                        f32x4 r;
                        r[0] = (1.f + __expf(-fmaxf(bflo(gb.x), -60.f))) * __builtin_amdgcn_rcpf(1.f + __expf(-bflo(ga.x)));
                        r[1] = (1.f + __expf(-fmaxf(bfhi(gb.x), -60.f))) * __builtin_amdgcn_rcpf(1.f + __expf(-bfhi(ga.x)));
                        r[2] = (1.f + __expf(-fmaxf(bflo(gb.y), -60.f))) * __builtin_amdgcn_rcpf(1.f + __expf(-bflo(ga.y)));
                        r[3] = (1.f + __expf(-fmaxf(bfhi(gb.y), -60.f))) * __builtin_amdgcn_rcpf(1.f + __expf(-bfhi(ga.y)));
                        acc[ai][bj][m][n] *= r;
                        __builtin_amdgcn_sched_barrier(0); }
                asm volatile("" ::: "memory"); }
    }
    __device__ __forceinline__ void operator()(const f32x4 (&acc)[2][2][4][2], const Unit& u, int wr, int wc, int fr, int fq) const {
        const int row0 = u.pm * BM + wr * 64 + fr; const int colt = u.pn * BM + wc * 32 + 8 * fq;
#pragma unroll
        for (int ai = 0; ai < 2; ++ai)
#pragma unroll
            for (int m = 0; m < 4; ++m) { const size_t row = (size_t)(row0 + ai * HALF + m * 16); const bf16_t* gp = P + row * DIN + C_GB + colt;
#pragma unroll
                for (int bj = 0; bj < 2; ++bj) { const u32x4 gw = *(const u32x4*)(gp + bj * HALF); const f32x4 a0 = acc[ai][bj][m][0], a1 = acc[ai][bj][m][1];
                    const float b[8] = {bflo(gw.x), bfhi(gw.x), bflo(gw.y), bfhi(gw.y), bflo(gw.z), bfhi(gw.z), bflo(gw.w), bfhi(gw.w)};
                    float o[8];
#pragma unroll
                    for (int e = 0; e < 8; ++e) o[e] = (e < 4 ? a0[e & 3] : a1[e & 3]) * __builtin_amdgcn_rcpf(1.f + __expf(-fmaxf(b[e], -60.f)));
                    u32x4 w; w.x = cvt_pk_bf16(o[0], o[1]); w.y = cvt_pk_bf16(o[2], o[3]); w.z = cvt_pk_bf16(o[4], o[5]); w.w = cvt_pk_bf16(o[6], o[7]);
                    *(u32x4*)(mrg + row * DM + colt + bj * HALF) = w; } }
    }
};
struct EpiF32 {
    static constexpr bool PERM = true, AFTER_DRAIN = false, HAS_MID = false; static constexpr int MID_T = -1;
    bf16_t* O;
    __device__ __forceinline__ void operator()(const f32x4 (&acc)[2][2][4][2], const Unit& u, int wr, int wc, int fr, int fq) const {
        const int row0 = u.pm * BM + wr * 64 + fr; const int colt = u.pn * BM + wc * 32 + 8 * fq;
#pragma unroll
        for (int ai = 0; ai < 2; ++ai)
#pragma unroll
            for (int m = 0; m < 4; ++m) { bf16_t* pp = O + (size_t)(row0 + ai * HALF + m * 16) * DM + colt;
#pragma unroll
                for (int bj = 0; bj < 2; ++bj) { const f32x4 v0 = acc[ai][bj][m][0], v1 = acc[ai][bj][m][1];
                    u32x4 w; w.x = cvt_pk_bf16(v0[0], v0[1]); w.y = cvt_pk_bf16(v0[2], v0[3]); w.z = cvt_pk_bf16(v1[0], v1[1]); w.w = cvt_pk_bf16(v1[2], v1[3]);
                    *(u32x4*)(pp + bj * HALF) = w; } }
    }
};
}

__device__ __forceinline__ void p0_transpose_item(const float* W, int K, int N, bf16* WT, int ldk, int koff, LAS float* scr, int item, int lane) {
    const int nblk = N / 32, kb = item / nblk, nb = item % nblk, k0 = 64 * kb, n0 = 32 * nb;
#pragma unroll
    for (int i = 0; i < 32; ++i) { const int kk = 2 * i + (lane >> 5); scr[kk * 33 + (lane & 31)] = W[(size_t)(k0 + kk) * N + n0 + (lane & 31)]; }
    LDS_WAIT(); asm volatile("" ::: "memory");
    const int c = lane & 7;
#pragma unroll
    for (int j = 0; j < 4; ++j) { const int n = (lane >> 3) + 8 * j; const LAS float* s = scr + (8 * c) * 33 + n;
        v4u o; o.x = pk2(s[0 * 33], s[1 * 33]); o.y = pk2(s[2 * 33], s[3 * 33]); o.z = pk2(s[4 * 33], s[5 * 33]); o.w = pk2(s[6 * 33], s[7 * 33]);
        *(GAS v4u*)(WT + (size_t)(n0 + n) * ldk + koff + k0 + 8 * c) = o; }
    LDS_WAIT(); asm volatile("" ::: "memory");
}
__device__ __forceinline__ void mod_task(int task, const float* cp, const float* cs, const float* Wc, const float* bc, float* MODP, LAS unsigned char* lds, int tid, int wave, int lane) {
    const int chunk = task >> 2, kq = task & 3;
    const int k0 = kq * 256 + wave * 32;
    float sc[40], acc[40];
#pragma unroll
    for (int r = 0; r < 40; ++r) { const float* crow = (r < 8) ? cp + r * 1024 : cs + (r - 8) * 1024; sc[r] = silu(crow[k0 + (lane & 31)]); acc[r] = 0.f; }
    const float* wp = Wc + (size_t)k0 * 3072 + chunk * 64 + lane;
#pragma unroll 8
    for (int kk = 0; kk < 32; ++kk) { const float wv = wp[(size_t)kk * 3072];
#pragma unroll
        for (int r = 0; r < 40; ++r) acc[r] += rdlane(sc[r], kk) * wv; }
    LAS float* red = (LAS float*)lds;
#pragma unroll
    for (int r = 0; r < 40; ++r) red[(wave * 40 + r) * 64 + lane] = acc[r];
    __syncthreads();
    for (int idx = tid; idx < 2560; idx += NTHR) { const int r = idx >> 6, cl = idx & 63; float s = 0.f;
#pragma unroll
        for (int w = 0; w < 8; ++w) s += red[(w * 40 + r) * 64 + cl];
        if (kq == 0) s += bc[chunk * 64 + cl];
        MODP[((size_t)kq * 40 + r) * 3072 + chunk * 64 + cl] = s; }
    __syncthreads();
}

typedef short s16x4 __attribute__((ext_vector_type(4)));
__device__ __forceinline__ s16x4 lds_tr(const LAS bf16* p) { return __builtin_bit_cast(s16x4, __builtin_amdgcn_ds_read_tr16_b64_v4i16((LAS s16x4*)p)); }
__device__ __forceinline__ void att_decode(int idx, int& g, int& b, int& h, int& d, int& n, int& r) {
    b = 7 - idx / 384; int rem = idx % 384; g = rem >> 7; rem &= 127; h = rem >> 4; const int sub = rem & 15;
    if (g == 0) { d = 1; n = sub; r = 0; } else if (g == 1) { d = 4; r = sub >> 2; n = sub & 3; } else { d = 16; r = sub; n = 0; }
}
__device__ __forceinline__ void att_prefetch(int idx, const bf16* PROJ, int tid, int wave, int lane, v4u (&kk)[4], v4u (&vv)[4], bf16x8& Q0, bf16x8& Q1) {
    int g, b, h, d, n, r; att_decode(idx, g, b, h, d, n, r);
    const int key = tid >> 1, half = tid & 1; const int m = 128 * (n - 1) + key;
    if (m >= 0) { const size_t row = (size_t)b * 2048 + (size_t)d * m + r; const bf16* src = PROJ + row * DIN + g * 512 + h * 64 + half * 32;
#pragma unroll
        for (int c = 0; c < 4; ++c) { kk[c] = *(const v4u*)(src + C_K + 8 * c); vv[c] = *(const v4u*)(src + C_VV + 8 * c); } }
    else {
#pragma unroll
        for (int c = 0; c < 4; ++c) { kk[c] = (v4u){0u, 0u, 0u, 0u}; vv[c] = (v4u){0u, 0u, 0u, 0u}; } }
    const int fr = lane & 15, fq = lane >> 4; const int i = 16 * wave + fr;
    const size_t rowq = (size_t)b * 2048 + (size_t)d * (128 * n + i) + r;
    const bf16* qsrc = PROJ + rowq * DIN + C_Q + g * 512 + h * 64 + 8 * fq;
    Q0 = *(const bf16x8*)qsrc; Q1 = *(const bf16x8*)(qsrc + 32);
}
__device__ __forceinline__ void att_compute(int idx, bf16* O3, float* ML, LAS unsigned char* lds, int wave, int lane, const bf16x8 Q0, const bf16x8 Q1) {
    int g, b, h, d, n, r; att_decode(idx, g, b, h, d, n, r);
    const LAS bf16* Ks = (const LAS bf16*)lds;
    const LAS bf16* Vs = (const LAS bf16*)(lds + 36864);
    const int fr = lane & 15, fq = lane >> 4;
    const int i = 16 * wave + fr;
    const size_t rowq = (size_t)b * 2048 + (size_t)d * (128 * n + i) + r;
    const int start = wave & ~1; const int lo = (n == 0) ? 8 : start;
    f32x4 S[10]; float mx = -1e30f;
#pragma unroll
    for (int p = 0; p < 10; ++p) { const int tile = start + p;
        if (tile >= lo) {
            const LAS bf16* kp = Ks + (tile * 16 + fr) * 72 + 8 * fq;
            const bf16x8 K0 = *(const LAS bf16x8*)kp, K1 = *(const LAS bf16x8*)(kp + 32);
            f32x4 s = (f32x4){0.f, 0.f, 0.f, 0.f};
            s = __builtin_amdgcn_mfma_f32_16x16x32_bf16(K0, Q0, s, 0, 0, 0); s = __builtin_amdgcn_mfma_f32_16x16x32_bf16(K1, Q1, s, 0, 0, 0);
#pragma unroll
            for (int e = 0; e < 4; ++e) { const int j = tile * 16 + 4 * fq + e; const bool valid = (j >= i) && (j <= i + 128); s[e] = valid ? s[e] * 0.125f : -1e30f; mx = fmaxf(mx, s[e]); }
            S[p] = s;
        } else S[p] = (f32x4){-1e30f, -1e30f, -1e30f, -1e30f};
    }
    mx = fmaxf(mx, __shfl_xor(mx, 16)); mx = fmaxf(mx, __shfl_xor(mx, 32));
    float l = 0.f;
#pragma unroll
    for (int p = 0; p < 10; ++p)
#pragma unroll
        for (int e = 0; e < 4; ++e) { const float ex = __expf(S[p][e] - mx); S[p][e] = ex; l += ex; }
    l += __shfl_xor(l, 16); l += __shfl_xor(l, 32);
    f32x4 O[4];
#pragma unroll
    for (int dt = 0; dt < 4; ++dt) O[dt] = (f32x4){0.f, 0.f, 0.f, 0.f};
#pragma unroll
    for (int pp = 0; pp < 5; ++pp) {
        if (start + 2 * pp >= lo) {
            v4u pw; pw.x = pk2(S[2 * pp][0], S[2 * pp][1]); pw.y = pk2(S[2 * pp][2], S[2 * pp][3]); pw.z = pk2(S[2 * pp + 1][0], S[2 * pp + 1][1]); pw.w = pk2(S[2 * pp + 1][2], S[2 * pp + 1][3]);
            const bf16x8 Pf = __builtin_bit_cast(bf16x8, pw);
            const LAS bf16* vbase = Vs + ((start + 2 * pp) * 16 + 4 * fq + (fr >> 2)) * 72 + 4 * (fr & 3);
#pragma unroll
            for (int dt = 0; dt < 4; ++dt) { const s16x4 va = lds_tr(vbase + 16 * dt), vb = lds_tr(vbase + 16 * 72 + 16 * dt);
                const bf16x8 Vf = (bf16x8){va[0], va[1], va[2], va[3], vb[0], vb[1], vb[2], vb[3]};
                O[dt] = __builtin_amdgcn_mfma_f32_16x16x32_bf16(Vf, Pf, O[dt], 0, 0, 0); }
        }
    }
    const float inv = 1.f / l;
    bf16* op = O3 + ((size_t)g * MT + rowq) * 512 + h * 64 + 4 * fq;
#pragma unroll
    for (int dt = 0; dt < 4; ++dt) { v2u w; w.x = pk2(O[dt][0] * inv, O[dt][1] * inv); w.y = pk2(O[dt][2] * inv, O[dt][3] * inv); *(v2u*)(op + 16 * dt) = w; }
    if (fq == 0) { float* mp = ML + (((size_t)g * MT + rowq) * 8 + h) * 2; *(f32x2*)mp = (f32x2){mx, l}; }
}

#define GM_PREFETCH(idx_) do { const int ci_ = 127 - ((idx_) >> 3), g_ = (idx_) & 7; const int r0_ = ci_ * 128; \
        st0 = ((const f32x4*)(VST + (size_t)(r0_ + s) * 32))[2 * cp]; st1 = ((const f32x4*)(VST + (size_t)(r0_ + s) * 32))[2 * cp + 1]; \
        const bf16* vp_ = PROJ + (size_t)(r0_ + s) * DIN + C_V + g_ * 128 + cp * 32; \
        _Pragma("unroll") for (int c = 0; c < 4; ++c) vraw[c] = *(const v4u*)(vp_ + 8 * c); \
        const bf16* up_ = PROJ + (size_t)(r0_ + t) * DIN + g_ * 128 + 4 * fq; \
        _Pragma("unroll") for (int ct = 0; ct < 8; ++ct) { uu[ct] = *(const v2u*)(up_ + C_U + 16 * ct); zz[ct] = *(const v2u*)(up_ + C_Z + 16 * ct); } } while (0)
__device__ __forceinline__ void gmlp_phase(int bx, int G, int n_items, const bf16* PROJ, const float* VST, const float* Wsp, const float* bsp, const float* lng, const float* lnb, bf16* YA,
                                           LAS unsigned char* lds, int tid, int wave, int lane) {
    LAS bf16* VN = (LAS bf16*)lds;
    LAS bf16* WS = (LAS bf16*)(lds + 34816);
    const int s = tid >> 2, cp = tid & 3;
    const int fr = lane & 15, fq = lane >> 4;
    const int t = 16 * wave + fr;
    int g_staged = -1;
    f32x4 st0, st1; v4u vraw[4]; v2u uu[8], zz[8];
    int it = bx;
    if (it < n_items) GM_PREFETCH(it);
    for (; it < n_items; it += G) {
        const int ci = 127 - (it >> 3), g = it & 7; const int row0 = ci * 128;
        if (g != g_staged) {
            const float* wp = Wsp + ((size_t)g * 128 + s) * 128 + cp * 32;
#pragma unroll
            for (int c = 0; c < 4; ++c) { const f32x4 a = ((const f32x4*)wp)[2 * c], b2 = ((const f32x4*)wp)[2 * c + 1]; const int s0 = cp * 32 + 8 * c;
                float v[8] = {a[0], a[1], a[2], a[3], b2[0], b2[1], b2[2], b2[3]};
#pragma unroll
                for (int e = 0; e < 8; ++e) v[e] = (s0 + e <= s) ? v[e] : 0.f;
                v4u w; w.x = pk2(v[0], v[1]); w.y = pk2(v[2], v[3]); w.z = pk2(v[4], v[5]); w.w = pk2(v[6], v[7]);
                *(LAS v4u*)(WS + s * 136 + s0) = w; }
            g_staged = g;
        }
        float sm = (st0[0] + st0[2]) + (st1[0] + st1[2]), sq = (st0[1] + st0[3]) + (st1[1] + st1[3]);
        sm += __shfl_xor(sm, 1); sm += __shfl_xor(sm, 2); sq += __shfl_xor(sq, 1); sq += __shfl_xor(sq, 2);
        const float mu = sm * (1.f / 1024.f); const float rstd = rsqrtf(sq * (1.f / 1024.f) - mu * mu + EPS);
#pragma unroll
        for (int c = 0; c < 4; ++c) { const v4u raw = vraw[c]; const int ch = g * 128 + cp * 32 + 8 * c;
            const f32x4 g0 = *(const f32x4*)(lng + ch), g1 = *(const f32x4*)(lng + ch + 4), b0 = *(const f32x4*)(lnb + ch), b1 = *(const f32x4*)(lnb + ch + 4);
            v4u w;
            w.x = pk2((bflo(raw.x) - mu) * rstd * g0[0] + b0[0], (bfhi(raw.x) - mu) * rstd * g0[1] + b0[1]);
            w.y = pk2((bflo(raw.y) - mu) * rstd * g0[2] + b0[2], (bfhi(raw.y) - mu) * rstd * g0[3] + b0[3]);
            w.z = pk2((bflo(raw.z) - mu) * rstd * g1[0] + b1[0], (bfhi(raw.z) - mu) * rstd * g1[1] + b1[1]);
            w.w = pk2((bflo(raw.w) - mu) * rstd * g1[2] + b1[2], (bfhi(raw.w) - mu) * rstd * g1[3] + b1[3]);
            *(LAS v4u*)(VN + s * 136 + cp * 32 + 8 * c) = w; }
        v2u cu[8], cz[8];
#pragma unroll
        for (int ct = 0; ct < 8; ++ct) { cu[ct] = uu[ct]; cz[ct] = zz[ct]; }
        __syncthreads();
        if (it + G < n_items) GM_PREFETCH(it + G);
        const int nks = (wave >> 1) + 1;
        f32x4 acc[8];
#pragma unroll
        for (int ct = 0; ct < 8; ++ct) acc[ct] = (f32x4){0.f, 0.f, 0.f, 0.f};
#pragma unroll
        for (int ks = 0; ks < 4; ++ks) {
            if (ks < nks) { const bf16x8 Wf = *(const LAS bf16x8*)(WS + t * 136 + 32 * ks + 8 * fq);
                const LAS bf16* vb = VN + (32 * ks + 8 * fq + (fr >> 2)) * 136 + 4 * (fr & 3);
#pragma unroll
                for (int ct = 0; ct < 8; ++ct) { const s16x4 va = lds_tr(vb + 16 * ct), vb2 = lds_tr(vb + 4 * 136 + 16 * ct);
                    const bf16x8 Vf = (bf16x8){va[0], va[1], va[2], va[3], vb2[0], vb2[1], vb2[2], vb2[3]};
                    acc[ct] = __builtin_amdgcn_mfma_f32_16x16x32_bf16(Vf, Wf, acc[ct], 0, 0, 0); } }
        }
        const float bs = bsp[g * 128 + t];
        bf16* yp = YA + ((size_t)row0 + t) * 1536 + g * 128 + 4 * fq;
#pragma unroll
        for (int ct = 0; ct < 8; ++ct) {
            const float y0 = bflo(cu[ct].x) * (acc[ct][0] + bs) * silu(bflo(cz[ct].x)), y1 = bfhi(cu[ct].x) * (acc[ct][1] + bs) * silu(bfhi(cz[ct].x));
            const float y2 = bflo(cu[ct].y) * (acc[ct][2] + bs) * silu(bflo(cz[ct].y)), y3 = bfhi(cu[ct].y) * (acc[ct][3] + bs) * silu(bfhi(cz[ct].y));
            v2u w; w.x = pk2(y0, y1); w.y = pk2(y2, y3); *(v2u*)(yp + 16 * ct) = w; }
        __syncthreads();
    }
}

__device__ __forceinline__ void gmlp_sample_item(int b, const bf16* PROJ, const float* VST, const float* Wsp, const float* bsp, const float* lng, const float* lnb, bf16* YA, float* out,
                                                 LAS unsigned char* lds, int tid, int wave, int lane) {
    const int r0 = MP + b * 8;
    LAS float* st = (LAS float*)lds;
    if (tid < 8) { const float* p = VST + (size_t)(r0 + tid) * 32; float s = 0.f, q = 0.f;
#pragma unroll
        for (int k = 0; k < 8; ++k) { const f32x4 a = ((const f32x4*)p)[k]; s += a[0] + a[2]; q += a[1] + a[3]; }
        const float mu = s * (1.f / 1024.f); const float var = q * (1.f / 1024.f) - mu * mu; st[2 * tid] = mu; st[2 * tid + 1] = rsqrtf(var + EPS); }
    __syncthreads();
    const int ch = 2 * tid, g = wave;
    const float lg0 = lng[ch], lg1 = lng[ch + 1], lb0 = lnb[ch], lb1 = lnb[ch + 1];
    float vn0[8], vn1[8];
#pragma unroll
    for (int s = 0; s < 8; ++s) { const unsigned raw = *(const unsigned*)(PROJ + (size_t)(r0 + s) * DIN + C_V + ch); const float mu = st[2 * s], rstd = st[2 * s + 1];
        vn0[s] = (bflo(raw) - mu) * rstd * lg0 + lb0; vn1[s] = (bfhi(raw) - mu) * rstd * lg1 + lb1;
        *(f32x2*)(out + O_VCH + (size_t)(b * 8 + s) * 1024 + ch) = (f32x2){vn0[s], vn1[s]}; }
#pragma unroll
    for (int t = 0; t < 8; ++t) { float z0 = bsp[g * 128 + t], z1 = z0;
#pragma unroll
        for (int s = 0; s < 8; ++s) if (s <= t) { const float w = Wsp[((size_t)g * 128 + t) * 128 + s]; z0 += w * vn0[s]; z1 += w * vn1[s]; }
        const unsigned uu = *(const unsigned*)(PROJ + (size_t)(r0 + t) * DIN + C_U + ch), zz = *(const unsigned*)(PROJ + (size_t)(r0 + t) * DIN + C_Z + ch);
        *(unsigned*)(YA + (size_t)(r0 + t) * 1536 + ch) = pk2(bflo(uu) * z0 * silu(bflo(zz)), bfhi(uu) * z1 * silu(bfhi(zz))); }
    __syncthreads();
}

__device__ __forceinline__ f32x4 sa_load(const bf16* PROJ, const float* cache, int b, int lw, int ix, int pcol, int ccol, bool maybe_new) {
    if (maybe_new && ix >= lw) { const v2u raw = *(const v2u*)(PROJ + (size_t)(MP + b * 8 + ix - lw) * DIN + pcol); return (f32x4){bflo(raw.x), bfhi(raw.x), bflo(raw.y), bfhi(raw.y)}; }
    const int ic = ix < lw ? ix : lw - 1;
    return *(const f32x4*)(cache + (size_t)ic * 1024 + ccol);
}
__device__ __forceinline__ void attn_sample_item(int idx, const bf16* PROJ, const float* c128, const float* c512, const float* c2048, bf16* O3, float* ML, int wave, int lane) {
    const int b = idx / 24; const int rem = idx - b * 24; const int g = rem >> 3, t = rem & 7; const int h = wave;
    const int lw = g == 0 ? 128 : (g == 1 ? 512 : 2048), d = g == 0 ? 1 : (g == 1 ? 4 : 16);
    const float* cache = (g == 0 ? c128 : (g == 1 ? c512 : c2048)) + (size_t)b * lw * 1024;
    const size_t rq = (size_t)MP + b * 8 + t;
    const int ks = lane >> 4, dq = lane & 15;
    const int hc = g * 512 + h * 64 + 4 * dq;
    const v2u qraw = *(const v2u*)(PROJ + rq * DIN + C_Q + hc);
    const float q0 = bflo(qraw.x) * 0.125f, q1 = bfhi(qraw.x) * 0.125f, q2 = bflo(qraw.y) * 0.125f, q3 = bfhi(qraw.y) * 0.125f;
    const float* kbase = cache + h * 64;
    const unsigned lo4 = 4u * (unsigned)dq;
    constexpr int NVA = 8;
    const int ixb = lw + t - d * ks;
    f32x4 kk[33], va[NVA];
#pragma unroll
    for (int it = 0; it < 33; ++it) { int ix = (it < 32 || ks == 0) ? ixb - 4 * d * it : lw + t - 128 * d; ix = ix < lw ? ix : lw - 1; kk[it] = *(const f32x4*)(kbase + ((unsigned)ix * 1024u + lo4)); }
#pragma unroll
    for (int it = 0; it < NVA; ++it) { int ix = ixb - 4 * d * it; ix = ix < lw ? ix : lw - 1; va[it] = *(const f32x4*)(kbase + ((unsigned)ix * 1024u + 512u + lo4)); }
#pragma unroll
    for (int it = 0; it < 2; ++it) { const int ix = ixb - 4 * d * it;
        if (ix >= lw) { const bf16* pr = PROJ + (size_t)(MP + b * 8 + ix - lw) * DIN + hc; const v2u rk = *(const v2u*)(pr + C_K), rv = *(const v2u*)(pr + C_VV);
            kk[it] = (f32x4){bflo(rk.x), bfhi(rk.x), bflo(rk.y), bfhi(rk.y)}; va[it] = (f32x4){bflo(rv.x), bfhi(rv.x), bflo(rv.y), bfhi(rv.y)}; } }
    float s[33]; float mx = -1e30f;
#pragma unroll
    for (int it = 0; it < 33; ++it) {
        float a = (kk[it][0] * q0 + kk[it][1] * q1) + (kk[it][2] * q2 + kk[it][3] * q3);
        a += __shfl_xor(a, 1); a += __shfl_xor(a, 2); a += __shfl_xor(a, 4); a += __shfl_xor(a, 8);
        s[it] = ((it < 32) || (ks == 0)) ? a : -1e30f; mx = fmaxf(mx, s[it]);
    }
    __builtin_amdgcn_sched_barrier(0);
    f32x4 vb[33 - NVA];
#pragma unroll
    for (int it = NVA; it < 33; ++it) { int ix = (it < 32 || ks == 0) ? ixb - 4 * d * it : lw + t - 128 * d; vb[it - NVA] = *(const f32x4*)(kbase + ((unsigned)ix * 1024u + 512u + lo4)); }
    mx = fmaxf(mx, __shfl_xor(mx, 16)); mx = fmaxf(mx, __shfl_xor(mx, 32));
    float l = 0.f;
#pragma unroll
    for (int it = 0; it < 33; ++it) { s[it] = __expf(s[it] - mx); l += s[it]; }
    l += __shfl_xor(l, 16); l += __shfl_xor(l, 32);
    f32x4 o = (f32x4){0.f, 0.f, 0.f, 0.f};
#pragma unroll
    for (int it = 0; it < NVA; ++it) o += va[it] * s[it];
#pragma unroll
    for (int it = NVA; it < 33; ++it) o += vb[it - NVA] * s[it];
#pragma unroll
    for (int e = 0; e < 4; ++e) { o[e] += __shfl_xor(o[e], 16); o[e] += __shfl_xor(o[e], 32); }
    const float inv = 1.f / l;
    if (ks == 0) { v2u w; w.x = pk2(o[0] * inv, o[1] * inv); w.y = pk2(o[2] * inv, o[3] * inv); *(v2u*)(O3 + ((size_t)g * MT + rq) * 512 + h * 64 + 4 * dq) = w; }
    if (lane == 0) { float* mp = ML + (((size_t)g * MT + rq) * 8 + h) * 2; mp[0] = mx; mp[1] = l; }
}

template <int MW, int NT>
__device__ __forceinline__ void sg_mma(f32x4 (&acc)[MW][NT], const bf16* A, const bf16* Bt, int K, int lane, int lda = 0, int ldb = 0) {
    const int fr = lane & 15, fq = lane >> 4;
    if (lda == 0) lda = K; if (ldb == 0) ldb = K;
    const bf16* ap = A + (size_t)fr * lda + 8 * fq; const bf16* bp = Bt + (size_t)fr * ldb + 8 * fq;
    constexpr int UNR = (MW * NT == 1) ? 16 : 4;
#pragma unroll UNR
    for (int ks = 0; ks < K / 32; ++ks) {
        bf16x8 a[MW], b[NT];
#pragma unroll
        for (int mi = 0; mi < MW; ++mi) a[mi] = *(const bf16x8*)(ap + (size_t)mi * 16 * lda + 32 * ks);
#pragma unroll
        for (int ni = 0; ni < NT; ++ni) b[ni] = *(const bf16x8*)(bp + (size_t)ni * 16 * ldb + 32 * ks);
#pragma unroll
        for (int mi = 0; mi < MW; ++mi)
#pragma unroll
            for (int ni = 0; ni < NT; ++ni) acc[mi][ni] = __builtin_amdgcn_mfma_f32_16x16x32_bf16(b[ni], a[mi], acc[mi][ni], 0, 0, 0);
    }
}
__device__ __forceinline__ void sg_proj_task(int ts, const bf16* H, const bf16* WIN_T, bf16* PROJ, float* out, float* VST, int wave, int lane) {
    const int fr = lane & 15, fq = lane >> 4; const int n0 = 64 * ts; const int r0 = MP + 32 * wave;
    f32x4 acc[2][4];
#pragma unroll
    for (int mi = 0; mi < 2; ++mi)
#pragma unroll
        for (int ni = 0; ni < 4; ++ni) acc[mi][ni] = (f32x4){0.f, 0.f, 0.f, 0.f};
    sg_mma<2, 4>(acc, H + (size_t)r0 * DM, WIN_T + (size_t)n0 * DM, DM, lane);
#pragma unroll
    for (int mi = 0; mi < 2; ++mi) { const int row = r0 + 16 * mi + fr;
#pragma unroll
        for (int ni = 0; ni < 4; ++ni) { const int col = n0 + 16 * ni + 4 * fq; const f32x4 v = acc[mi][ni];
            v2u w; w.x = pk2(v[0], v[1]); w.y = pk2(v[2], v[3]); *(v2u*)(PROJ + (size_t)row * DIN + col) = w;
            if (col >= C_K && col < C_ZB) { const int kv = col >= C_VV ? 1 : 0; const int cc = col - (kv ? C_VV : C_K); const int g = cc >> 9, hc = cc & 511;
                const size_t obs = g == 0 ? O_KVS0 : (g == 1 ? O_KVS1 : O_KVS2);
                *(f32x4*)(out + obs + (size_t)(row - MP) * 1024 + kv * 512 + hc) = v; } }
        if (n0 >= C_V && n0 < C_Z) { float s = 0.f, q = 0.f;
#pragma unroll
            for (int ni = 0; ni < 4; ++ni) { const f32x4 x = acc[mi][ni]; s += (x[0] + x[1]) + (x[2] + x[3]); q += (x[0] * x[0] + x[1] * x[1]) + (x[2] * x[2] + x[3] * x[3]); }
            s += __shfl_xor(s, 16); s += __shfl_xor(s, 32); q += __shfl_xor(q, 16); q += __shfl_xor(q, 32);
            if (fq == 0) *(f32x2*)(VST + ((size_t)row * 16 + ((n0 - C_V) >> 6)) * 2) = (f32x2){s, q}; } }
}
template <int KS>
__device__ __forceinline__ void sgk_mma(f32x4 (&acc)[2][2], const bf16* A, int lda, const bf16* Bt, int ldb, int lane) {
    const int fr = lane & 15, fq = lane >> 4;
    const bf16* ap = A + (size_t)fr * lda + 8 * fq; const bf16* bp = Bt + (size_t)fr * ldb + 8 * fq;
    bf16x8 a[KS][2], b[KS][2];
#pragma unroll
    for (int ks = 0; ks < KS; ++ks)
#pragma unroll
        for (int i = 0; i < 2; ++i) { a[ks][i] = *(const bf16x8*)(ap + (size_t)i * 16 * lda + 32 * ks); b[ks][i] = *(const bf16x8*)(bp + (size_t)i * 16 * ldb + 32 * ks); }
#pragma unroll
    for (int ks = 0; ks < KS; ++ks)
#pragma unroll
        for (int mi = 0; mi < 2; ++mi)
#pragma unroll
            for (int ni = 0; ni < 2; ++ni) acc[mi][ni] = __builtin_amdgcn_mfma_f32_16x16x32_bf16(b[ks][ni], a[ks][mi], acc[mi][ni], 0, 0, 0);
}
__device__ __forceinline__ void sgk_put(const f32x4 (&acc)[2][2], LAS unsigned char* lds, int prod, int wave, int lane) {
#pragma unroll
    for (int mi = 0; mi < 2; ++mi)
#pragma unroll
        for (int ni = 0; ni < 2; ++ni) *(LAS f32x4*)(lds + (size_t)(((prod * 8 + wave) * 4 + mi * 2 + ni) * 64 + lane) * 16) = acc[mi][ni];
}
__device__ __forceinline__ f32x4 sgk_get(LAS unsigned char* lds, int prod, int tile, int ln) {
    f32x4 s = (f32x4){0.f, 0.f, 0.f, 0.f};
#pragma unroll
    for (int w = 0; w < 8; ++w) s += *(const LAS f32x4*)(lds + (size_t)(((prod * 8 + w) * 4 + tile) * 64 + ln) * 16);
    return s;
}
__device__ __forceinline__ void sg_merge_task(int ts, const bf16* YAB, const bf16* WAB_T, const bf16* PROJ, bf16* MRG, LAS unsigned char* lds, int wave) {
    int lane = (int)__builtin_amdgcn_mbcnt_hi(~0u, __builtin_amdgcn_mbcnt_lo(~0u, 0u)); asm volatile("" : "+v"(lane));
    const int tid = wave * 64 + lane;
    const int r0 = MP + 32 * (ts >> 5), n0 = 32 * (ts & 31);
    f32x4 aa[2][2], ab[2][2];
#pragma unroll
    for (int mi = 0; mi < 2; ++mi)
#pragma unroll
        for (int ni = 0; ni < 2; ++ni) { aa[mi][ni] = (f32x4){0.f, 0.f, 0.f, 0.f}; ab[mi][ni] = (f32x4){0.f, 0.f, 0.f, 0.f}; }
    sgk_mma<4>(aa, YAB + (size_t)r0 * 1536 + 128 * wave, 1536, WAB_T + (size_t)n0 * 1536 + 128 * wave, 1536, lane);
    sgk_mma<2>(ab, YAB + (size_t)r0 * 1536 + 1024 + 64 * wave, 1536, WAB_T + (size_t)n0 * 1536 + 1024 + 64 * wave, 1536, lane);
    sgk_put(aa, lds, 0, wave, lane); sgk_put(ab, lds, 1, wave, lane);
    __syncthreads();
    if (tid < 256) { const int tile = tid >> 6, ln = tid & 63; const f32x4 sa = sgk_get(lds, 0, tile, ln), sb = sgk_get(lds, 1, tile, ln);
        const size_t row = (size_t)r0 + 16 * (tile >> 1) + (ln & 15); const int col = n0 + 16 * (tile & 1) + 4 * (ln >> 4);
        const v2u ga = *(const v2u*)(PROJ + row * DIN + C_GA + col), gb = *(const v2u*)(PROJ + row * DIN + C_GB + col);
        const float m0 = sa[0] * sigm(bflo(ga.x)) + sb[0] * sigm(bflo(gb.x)), m1 = sa[1] * sigm(bfhi(ga.x)) + sb[1] * sigm(bfhi(gb.x));
        const float m2 = sa[2] * sigm(bflo(ga.y)) + sb[2] * sigm(bflo(gb.y)), m3 = sa[3] * sigm(bfhi(ga.y)) + sb[3] * sigm(bfhi(gb.y));
        v2u w; w.x = pk2(m0, m1); w.y = pk2(m2, m3); *(v2u*)(MRG + row * DM + col) = w; }
    __syncthreads();
}
__device__ __forceinline__ void sg_out_task(int ts, const bf16* MRG, const bf16* WOUT_T, bf16* OUTB, LAS unsigned char* lds, int wave) {
    int lane = (int)__builtin_amdgcn_mbcnt_hi(~0u, __builtin_amdgcn_mbcnt_lo(~0u, 0u)); asm volatile("" : "+v"(lane));
    const int tid = wave * 64 + lane;
    const int r0 = MP + 32 * (ts >> 5), n0 = 32 * (ts & 31);
    f32x4 aa[2][2];
#pragma unroll
    for (int mi = 0; mi < 2; ++mi)
#pragma unroll
        for (int ni = 0; ni < 2; ++ni) aa[mi][ni] = (f32x4){0.f, 0.f, 0.f, 0.f};
    sgk_mma<4>(aa, MRG + (size_t)r0 * DM + 128 * wave, DM, WOUT_T + (size_t)n0 * DM + 128 * wave, DM, lane);
    sgk_put(aa, lds, 0, wave, lane);
    __syncthreads();
    if (tid < 256) { const int tile = tid >> 6, ln = tid & 63; const f32x4 sa = sgk_get(lds, 0, tile, ln);
        const size_t row = (size_t)r0 + 16 * (tile >> 1) + (ln & 15); const int col = n0 + 16 * (tile & 1) + 4 * (ln >> 4);
        v2u w; w.x = pk2(sa[0], sa[1]); w.y = pk2(sa[2], sa[3]); *(v2u*)(OUTB + row * DM + col) = w; }
    __syncthreads();
}

struct Args { const float* in[19]; float* out; unsigned char* ws; };
__global__ void __launch_bounds__(NTHR, 2) fwd_kernel(Args args) {
    extern __shared__ __attribute__((aligned(16))) unsigned char lds_raw[];
    cg::grid_group grid = cg::this_grid();
    LAS unsigned char* lds = (LAS unsigned char*)lds_raw;
    const int tid = threadIdx.x, lane = tid & 63, wave = __builtin_amdgcn_readfirstlane(tid >> 6);
    const int G = gridDim.x, bx = blockIdx.x;
    const int gw = bx * NWAVES + wave, NGW = G * NWAVES;
    const float* xp = args.in[0]; const float* xs = args.in[1];
    const float* c128 = args.in[2]; const float* c512 = args.in[3]; const float* c2048 = args.in[4];
    const float* cpr = args.in[5]; const float* csm = args.in[6]; const float* wcond = args.in[7]; const float* bcond = args.in[8]; const float* gpre = args.in[9];
    const float* win = args.in[10]; const float* lng = args.in[11]; const float* lnb = args.in[12]; const float* wsp = args.in[13]; const float* bsp = args.in[14];
    const float* wpa = args.in[15]; const float* wpb = args.in[16]; const float* wout = args.in[17]; const float* gpost = args.in[18];
    float* out = args.out; unsigned char* ws = args.ws;
    bf16* WIN_T = (bf16*)(ws + WS_WIN); bf16* WAB_T = (bf16*)(ws + WS_WPA); bf16* WOUT_T = (bf16*)(ws + WS_WOUT);
    float* MOD = (float*)(ws + WS_MOD); float* VST = (float*)(ws + WS_VST); float* ML = (float*)(ws + WS_ML);
    bf16* H = (bf16*)(ws + WS_H); bf16* YAB = (bf16*)(ws + WS_YA); bf16* MRG = (bf16*)(ws + WS_MRG); bf16* O3 = (bf16*)(ws + WS_O3);
    bf16* OUTB = (bf16*)(ws + WS_OUT); bf16* PROJ = (bf16*)(ws + WS_PROJ);

    unsigned* barw = (unsigned*)(ws + 16384);
    volatile LAS unsigned* bst = (volatile LAS unsigned*)(lds + 139264);
    if (tid < 2) bst[tid] = 0u;
    __syncthreads();
    const XcdBarrier xbar = xcd_barrier_post(barw, bst);
    if (args.ws == nullptr) grid.sync();
    if (bx < 192) mod_task(bx, cpr, csm, wcond, bcond, MOD, lds, tid, wave, lane);
    {
        LAS float* scr = (LAS float*)(lds + wave * 16384);
        constexpr int I_IN = (1024 / 64) * (DIN / 32), I_PA = (1024 / 64) * (1024 / 32), I_PB = (512 / 64) * (1024 / 32), I_OUT = I_PA;
        constexpr int NITEMS = I_IN + I_PA + I_PB + I_OUT;
        for (int it = gw; it < NITEMS; it += NGW) {
            int r = it;
            if (r < I_IN) { p0_transpose_item(win, 1024, DIN, WIN_T, 1024, 0, scr, r, lane); continue; } r -= I_IN;
            if (r < I_PA) { p0_transpose_item(wpa, 1024, 1024, WAB_T, 1536, 0, scr, r, lane); continue; } r -= I_PA;
            if (r < I_PB) { p0_transpose_item(wpb, 512, 1024, WAB_T, 1536, 1024, scr, r, lane); continue; } r -= I_PB;
            p0_transpose_item(wout, 1024, 1024, WOUT_T, 1024, 0, scr, r, lane);
        }
    }
    xcd_barrier(xbar);
    for (int rb = gw; rb < MT / 8; rb += NGW) {
        const int rowb = rb * 8;
        const float* mod = MOD + (rowb < MP ? (rowb >> 11) : 8 + ((rowb - MP) >> 3)) * 3072;
        f32x4 gs[4], sh[4];
#pragma unroll
        for (int j = 0; j < 4; ++j) { const int c = 4 * lane + 256 * j; f32x4 a = (f32x4){0.f, 0.f, 0.f, 0.f}, s2 = (f32x4){1.f, 1.f, 1.f, 1.f};
#pragma unroll
            for (int q = 0; q < 4; ++q) { a += *(const f32x4*)(mod + (size_t)q * 40 * 3072 + c); s2 += *(const f32x4*)(mod + (size_t)q * 40 * 3072 + 1024 + c); }
            sh[j] = a; gs[j] = s2 * *(const f32x4*)(gpre + c); }
        const float* xb = rowb < MP ? xp + (size_t)rowb * DM : xs + (size_t)(rowb - MP) * DM;
#pragma unroll 1
        for (int i0 = 0; i0 < 8; i0 += 4) {
            f32x4 v[4][4];
#pragma unroll
            for (int i = 0; i < 4; ++i)
#pragma unroll
                for (int j = 0; j < 4; ++j) v[i][j] = ((const f32x4*)(xb + (size_t)(i0 + i) * DM))[lane + 64 * j];
#pragma unroll
            for (int i = 0; i < 4; ++i) { float ss = 0.f;
#pragma unroll
                for (int j = 0; j < 4; ++j) ss += (v[i][j][0] * v[i][j][0] + v[i][j][1] * v[i][j][1]) + (v[i][j][2] * v[i][j][2] + v[i][j][3] * v[i][j][3]);
                const float rstd = rsqrtf(wave_sum(ss) * (1.f / DM) + EPS);
#pragma unroll
                for (int j = 0; j < 4; ++j) { const int c = 4 * lane + 256 * j; const f32x4 hh = v[i][j] * rstd * gs[j] + sh[j];
                    v2u w; w.x = pk2(hh[0], hh[1]); w.y = pk2(hh[2], hh[3]); *(v2u*)(H + (size_t)(rowb + i0 + i) * DM + c) = w; } } }
    }
    xcd_barrier(xbar);
    {
        if (bx < 160) sg_proj_task(bx, H, WIN_T, PROJ, out, VST, wave, lane);
        pg8::Gemm gm{H, WIN_T, MP, DIN, DM}; pg8::StaticOrder S; S.init(MP, DIN, G, bx);
        pg8::EpiProj E{PROJ, out, VST};
        pg8::gemm_phase<pg8::EpiProj, pg8::StaticOrder, true, true>(lds, gm, S, E);
    }
    xcd_barrier(xbar);
    {
        constexpr int N_ATT = 3072, N_GM = 1024, N_SA = 768, N_SG = 32;
        const bool sa_first = false;
        if (sa_first) {
            for (int it = bx; it < N_SA; it += G) attn_sample_item(it, PROJ, c128, c512, c2048, O3, ML, wave, lane);
        }
        {
            v4u kA[4], vA[4], kB[4], vB[4]; bf16x8 qA0, qA1, qB0, qB1;
            if (bx < N_ATT) att_prefetch(bx, PROJ, tid, wave, lane, kA, vA, qA0, qA1);
            if (bx + G < N_ATT) att_prefetch(bx + G, PROJ, tid, wave, lane, kB, vB, qB0, qB1);
            const int key = tid >> 1, half = tid & 1;
            LAS bf16* kdst = (LAS bf16*)lds + key * 72 + half * 32; LAS bf16* vdst = (LAS bf16*)(lds + 36864) + key * 72 + half * 32;
            for (int it = bx; it < N_ATT; it += 2 * G) {
                {
#pragma unroll
                    for (int c = 0; c < 4; ++c) { *(LAS v4u*)(kdst + 8 * c) = kA[c]; *(LAS v4u*)(vdst + 8 * c) = vA[c]; }
                    const bf16x8 Qc0 = qA0, Qc1 = qA1;
                    __syncthreads();
                    if (it + 2 * G < N_ATT) att_prefetch(it + 2 * G, PROJ, tid, wave, lane, kA, vA, qA0, qA1);
                    att_compute(it, O3, ML, lds, wave, lane, Qc0, Qc1);
                    __syncthreads();
                }
                if (it + G < N_ATT) {
#pragma unroll
                    for (int c = 0; c < 4; ++c) { *(LAS v4u*)(kdst + 8 * c) = kB[c]; *(LAS v4u*)(vdst + 8 * c) = vB[c]; }
                    const bf16x8 Qc0 = qB0, Qc1 = qB1;
                    __syncthreads();
                    if (it + 3 * G < N_ATT) att_prefetch(it + 3 * G, PROJ, tid, wave, lane, kB, vB, qB0, qB1);
                    att_compute(it + G, O3, ML, lds, wave, lane, Qc0, Qc1);
                    __syncthreads();
                }
            }
        }
        gmlp_phase(bx, G, N_GM, PROJ, VST, wsp, bsp, lng, lnb, YAB, lds, tid, wave, lane);
        if (!sa_first) {
            for (int it = bx; it < N_SA; it += G) attn_sample_item(it, PROJ, c128, c512, c2048, O3, ML, wave, lane);
        }
        for (int it = bx; it < N_SG; it += G) gmlp_sample_item(it, PROJ, VST, wsp, bsp, lng, lnb, YAB, out, lds, tid, wave, lane);
    }
    xcd_barrier(xbar);
    for (int row = gw; row < MT; row += NGW) {
        const int head = lane >> 3;
        float mg[3], lg[3];
#pragma unroll
        for (int g = 0; g < 3; ++g) { const f32x2 a = *(const f32x2*)(ML + (((size_t)g * MT + row) * 8 + head) * 2); mg[g] = a[0]; lg[g] = a[1]; }
        const float mm = fmaxf(fmaxf(mg[0], mg[1]), mg[2]);
        float wg[3]; float den = 0.f;
#pragma unroll
        for (int g = 0; g < 3; ++g) { wg[g] = __expf(mg[g] - mm) * lg[g]; den += wg[g]; }
        const float rden = 1.f / den;
        float o[8] = {0.f, 0.f, 0.f, 0.f, 0.f, 0.f, 0.f, 0.f};
#pragma unroll
        for (int g = 0; g < 3; ++g) { const v4u raw = *(const v4u*)(O3 + ((size_t)g * MT + row) * 512 + lane * 8); const float w = wg[g] * rden;
            o[0] += w * bflo(raw.x); o[1] += w * bfhi(raw.x); o[2] += w * bflo(raw.y); o[3] += w * bfhi(raw.y); o[4] += w * bflo(raw.z); o[5] += w * bfhi(raw.z); o[6] += w * bflo(raw.w); o[7] += w * bfhi(raw.w); }
        const v4u zr = *(const v4u*)(PROJ + (size_t)row * DIN + C_ZB + lane * 8);
        v4u w; w.x = pk2(o[0] * silu(bflo(zr.x)), o[1] * silu(bfhi(zr.x))); w.y = pk2(o[2] * silu(bflo(zr.y)), o[3] * silu(bfhi(zr.y)));
        w.z = pk2(o[4] * silu(bflo(zr.z)), o[5] * silu(bfhi(zr.z))); w.w = pk2(o[6] * silu(bflo(zr.w)), o[7] * silu(bfhi(zr.w)));
        *(v4u*)(YAB + (size_t)row * 1536 + 1024 + lane * 8) = w;
    }
    xcd_barrier(xbar);
    {
        for (int ts = bx; ts < 256; ts += G) sg_merge_task(ts, YAB, WAB_T, PROJ, MRG, lds, wave);
        pg8::Gemm gm{YAB, WAB_T, MP, DM, 1536}; pg8::StaticOrder S; S.init(MP, DM, G, bx);
        pg8::EpiMerge E{PROJ, MRG};
        pg8::gemm_phase<pg8::EpiMerge, pg8::StaticOrder, true, true>(lds, gm, S, E);
    }
    xcd_barrier(xbar);
    {
        for (int ts = bx; ts < 256; ts += G) sg_out_task(ts, MRG, WOUT_T, OUTB, lds, wave);
        pg8::Gemm gm{MRG, WOUT_T, MP, DM, DM}; pg8::StaticOrder S; S.init(MP, DM, G, bx);
        pg8::EpiF32 E{OUTB};
        pg8::gemm_phase<pg8::EpiF32, pg8::StaticOrder, true, true>(lds, gm, S, E);
    }
    xcd_barrier(xbar);
    for (int rb = gw; rb < MT / 8; rb += NGW) {
        const int rowb = rb * 8;
        const float* gate = MOD + (rowb < MP ? (rowb >> 11) : 8 + ((rowb - MP) >> 3)) * 3072 + 2048;
        f32x4 gt[4];
#pragma unroll
        for (int j = 0; j < 4; ++j) { const int c = 4 * lane + 256 * j; f32x4 a = (f32x4){0.f, 0.f, 0.f, 0.f};
#pragma unroll
            for (int q = 0; q < 4; ++q) a += *(const f32x4*)(gate + (size_t)q * 40 * 3072 + c);
            gt[j] = a * *(const f32x4*)(gpost + c); }
        const float* xb = rowb < MP ? xp + (size_t)rowb * DM : xs + (size_t)(rowb - MP) * DM;
#pragma unroll 1
        for (int i0 = 0; i0 < 8; i0 += 4) {
            v2u ov[4][4]; f32x4 xv[4][4];
#pragma unroll
            for (int i = 0; i < 4; ++i)
#pragma unroll
                for (int j = 0; j < 4; ++j) { ov[i][j] = ((const v2u*)(OUTB + (size_t)(rowb + i0 + i) * DM))[lane + 64 * j]; xv[i][j] = ((const f32x4*)(xb + (size_t)(i0 + i) * DM))[lane + 64 * j]; }
#pragma unroll
            for (int i = 0; i < 4; ++i) { f32x4 v[4]; float ss = 0.f;
#pragma unroll
                for (int j = 0; j < 4; ++j) { v[j] = (f32x4){bflo(ov[i][j].x), bfhi(ov[i][j].x), bflo(ov[i][j].y), bfhi(ov[i][j].y)}; ss += (v[j][0] * v[j][0] + v[j][1] * v[j][1]) + (v[j][2] * v[j][2] + v[j][3] * v[j][3]); }
                const float rstd = rsqrtf(wave_sum(ss) * (1.f / DM) + EPS);
#pragma unroll
                for (int j = 0; j < 4; ++j) { const int c = 4 * lane + 256 * j;
                    *(f32x4*)(out + (size_t)(rowb + i0 + i) * DM + c) = xv[i][j] + gt[j] * (v[j] * rstd); } } }
    }
}

extern "C" void kernel_launch(void* const* d_in, const int* in_sizes, int n_in, void* d_out, int out_size, void* d_ws, size_t ws_size, hipStream_t stream) {
    static int grid = 0;
    if (grid == 0) {
        if (n_in != 19 || (size_t)out_size != O_END || ws_size < WS_END) { fprintf(stderr, "kernel_launch: unexpected shapes: n_in %d out %d ws %zu\n", n_in, out_size, ws_size); grid = -1; return; }
        int dev = 0, cus = 0, per_cu = 0;
        if (hipGetDevice(&dev) != hipSuccess || hipDeviceGetAttribute(&cus, hipDeviceAttributeMultiprocessorCount, dev) != hipSuccess) { fprintf(stderr, "kernel_launch: device query failed\n"); grid = -1; return; }
        if (hipFuncSetAttribute((const void*)fwd_kernel, hipFuncAttributeMaxDynamicSharedMemorySize, LDS_BYTES) != hipSuccess) { fprintf(stderr, "kernel_launch: hipFuncSetAttribute failed\n"); grid = -1; return; }
        if (hipOccupancyMaxActiveBlocksPerMultiprocessor(&per_cu, (const void*)fwd_kernel, NTHR, LDS_BYTES) != hipSuccess || per_cu < 1) { fprintf(stderr, "kernel_launch: occupancy query says %d blocks per CU\n", per_cu); }
        (void)hipGetLastError();
        grid = cus;
    }
    if (grid < 0) return;
    if (hipMemsetAsync((char*)d_ws + 16384, 0, 16384, stream) != hipSuccess) { fprintf(stderr, "kernel_launch: memset of the barrier words failed\n"); return; }
    Args a{};
    for (int i = 0; i < 19; ++i) a.in[i] = (const float*)d_in[i];
    a.out = (float*)d_out; a.ws = (unsigned char*)d_ws;
    void* kargs[] = {&a};
    hipError_t e = hipLaunchCooperativeKernel((const void*)fwd_kernel, dim3(grid), dim3(NTHR), kargs, LDS_BYTES, stream);
    if (e != hipSuccess) fprintf(stderr, "kernel_launch: cooperative launch failed: %s (grid %d)\n", hipGetErrorString(e), grid);
}
```

```cpp
#include <hip/hip_runtime.h>
#include <hip/hip_cooperative_groups.h>
#include <cstdio>
#include <cstdint>
namespace cg = cooperative_groups;
namespace pg8 {
#define PG8_LAS __attribute__((address_space(3)))
typedef unsigned short bf16_t;
typedef short bf16x8 __attribute__((ext_vector_type(8)));
typedef float f32x4 __attribute__((ext_vector_type(4)));
typedef unsigned u32x4 __attribute__((ext_vector_type(4)));
constexpr int BM = 256, BK = 64, HALF = 128, HTB = HALF * BK * 2  , STAGE_BYTES = 8 * HTB, NXCD = 8, WGM = 8;

__host__ __device__ __forceinline__ int lds_byte(int r, int c) { const int st = (r >> 4) * 2 + (c >> 5), rr = r & 15, cc = c & 31, ob = rr * 64 + cc * 2; return st * 1024 + (ob ^ (((ob >> 9) & 1) << 5)); }
__host__ __device__ __forceinline__ void stage_rc(int b, int& R, int& C) { const int st = b / 1024, sb = b % 1024, swz = sb ^ (((sb >> 9) & 1) << 5); R = (st >> 1) * 16 + swz / 64; C = (st & 1) * 32 + (swz % 64) / 2; }
__host__ __device__ __forceinline__ int perm32(int rho) { const int n = rho >> 4, i = rho & 15; return 8 * (i >> 2) + 4 * n + (i & 3); }

struct Unit { int pm, pn; };
struct Gemm { const bf16_t* A; const bf16_t* Bt; int M, N, K; };

struct StaticOrder {
    int nM, nN, nwg, G, c;
    __host__ __device__ void init(int M, int N, int G_, int c_) { nM = M / BM; nN = N / BM; nwg = nM * nN; G = G_; c = c_; }
    __host__ __device__ bool next(int i, Unit& u) const {
        const long L = (long)i * G + c; if (L >= nwg) return false;
        int wgid = (int)L; { const int q = nwg / NXCD, r = nwg % NXCD, xcd = wgid % NXCD, off = wgid / NXCD; wgid = (xcd < r ? xcd * (q + 1) : r * (q + 1) + (xcd - r) * q) + off; }
        const int nig = WGM * nN, gid = wgid / nig, fm = gid * WGM, gsz = (nM - fm) < WGM ? (nM - fm) : WGM;
        u.pm = fm + ((wgid % nig) % gsz); u.pn = (wgid % nig) / gsz; return true;
    }
    __device__ __forceinline__ void a_ready(const Unit&) const {}
    __device__ __forceinline__ void done(const Unit&) const {}
};
__device__ __forceinline__ unsigned cvt_pk_bf16(float lo, float hi) { unsigned r; asm volatile("v_cvt_pk_bf16_f32 %0, %1, %2" : "=v"(r) : "v"(lo), "v"(hi)); return r; }
typedef float f32x2 __attribute__((ext_vector_type(2)));
template <class Epi, class Sched, bool ALIGN_EPI = false, bool SP2 = false>
__device__ __forceinline__ void gemm_phase(PG8_LAS unsigned char* lds, const Gemm g, const Sched& S, const Epi& E) {
    const int tid = threadIdx.x, wid = __builtin_amdgcn_readfirstlane(tid >> 6), lane = tid & 63, wr = wid >> 2, wc = wid & 3, fr = lane & 15, fq = lane >> 4;
    const int K = g.K, nt = K / BK;
    unsigned voffA[2], voffB[2];
#pragma unroll
    for (int i = 0; i < 2; ++i) { int R, C; stage_rc(tid * 16 + i * 8192, R, C); const int Rb = Epi::PERM ? ((R & ~31) + perm32(R & 31)) : R;
        voffA[i] = (unsigned)(R * K + C) * 2u; voffB[i] = (unsigned)(Rb * K + C) * 2u; }
    const size_t kstep = (size_t)(BK * 2);
    const size_t hstep = (size_t)HALF * K * 2;
    const size_t tstep = 2 * hstep;
    const unsigned ldsw = (unsigned)wid * 1024u;
    const int aoff = lds_byte(wr * 64 + fr, fq * 8), boff = lds_byte(wc * 32 + fr, fq * 8);
#define PG8_SA(b, h) (((b) * 2 + (h)) * HTB)
#define PG8_SB(b, h) ((4 + (b) * 2 + (h)) * HTB)
#define PG8_STAGE(bufoff, gbase, voff) do { _Pragma("unroll") for (int _i = 0; _i < 2; ++_i) \
        __builtin_amdgcn_global_load_lds((const unsigned*)((const char*)(gbase) + (voff)[_i]), (PG8_LAS unsigned*)(lds + (bufoff) + ldsw + _i * 8192), 16, 0, 0); } while (0)
#define PG8_LDA(dst, b, h) do { _Pragma("unroll") for (int m = 0; m < 4; ++m) _Pragma("unroll") for (int k = 0; k < 2; ++k) dst[m][k] = *(const PG8_LAS bf16x8*)(lds + PG8_SA(b, h) + aoff + m * 2048 + k * 1024); } while (0)
#define PG8_LDB(dst, b, h) do { _Pragma("unroll") for (int n = 0; n < 2; ++n) _Pragma("unroll") for (int k = 0; k < 2; ++k) dst[n][k] = *(const PG8_LAS bf16x8*)(lds + PG8_SB(b, h) + boff + n * 2048 + k * 1024); } while (0)
#define PG8_MMA(ai, bj, At, Bt) do { __builtin_amdgcn_s_setprio(1); _Pragma("unroll") for (int m = 0; m < 4; ++m) _Pragma("unroll") for (int n = 0; n < 2; ++n) _Pragma("unroll") for (int k = 0; k < 2; ++k) \
        acc[ai][bj][m][n] = __builtin_amdgcn_mfma_f32_16x16x32_bf16(Bt[n][k], At[m][k], acc[ai][bj][m][n], 0, 0, 0); __builtin_amdgcn_s_setprio(0); } while (0)
#define PG8_WAIT_V(n) asm volatile("s_waitcnt vmcnt(" #n ")" ::: "memory")
#define PG8_WAIT_L(n) asm volatile("s_waitcnt lgkmcnt(" #n ")" ::: "memory")
#define PG8_BAR __builtin_amdgcn_s_barrier()
#define PG8_SCHED __builtin_amdgcn_sched_barrier(0)
    Unit cur, nxt; int ui = 0;
    if (!S.next(0, cur)) return;
    f32x4 acc[2][2][4][2];
#pragma unroll
    for (int a = 0; a < 2; ++a)
#pragma unroll
        for (int b = 0; b < 2; ++b)
#pragma unroll
            for (int m = 0; m < 4; ++m)
#pragma unroll
                for (int n = 0; n < 2; ++n) acc[a][b][m][n] = (f32x4){0.f, 0.f, 0.f, 0.f};
    bf16x8 At[4][2], B0[2][2], B1[2][2];
    const char* cA = (const char*)g.A + (size_t)cur.pm * tstep; const char* cB = (const char*)g.Bt + (size_t)cur.pn * tstep;
    S.a_ready(cur);
    if constexpr (SP2) {
        PG8_STAGE(PG8_SB(0, 0), cB, voffB); PG8_STAGE(PG8_SB(0, 1), cB + hstep, voffB); PG8_STAGE(PG8_SA(0, 0), cA, voffA); PG8_STAGE(PG8_SA(0, 1), cA + hstep, voffA);
        if (wr == 1) PG8_BAR;
        PG8_WAIT_V(2); PG8_BAR;
        PG8_STAGE(PG8_SB(1, 0), cB + kstep, voffB); PG8_STAGE(PG8_SA(1, 0), cA + kstep, voffA); PG8_STAGE(PG8_SB(1, 1), cB + hstep + kstep, voffB);
        PG8_WAIT_V(6); PG8_BAR;
    } else {
        PG8_STAGE(PG8_SB(0, 0), cB, voffB); PG8_STAGE(PG8_SA(0, 0), cA, voffA); PG8_STAGE(PG8_SB(0, 1), cB + hstep, voffB); PG8_STAGE(PG8_SA(0, 1), cA + hstep, voffA);
        if (wr == 1) PG8_BAR;
        PG8_WAIT_V(4); PG8_BAR;
        PG8_STAGE(PG8_SB(1, 0), cB + kstep, voffB); PG8_STAGE(PG8_SA(1, 0), cA + kstep, voffA); PG8_STAGE(PG8_SB(1, 1), cB + hstep + kstep, voffB);
        PG8_WAIT_V(6); PG8_BAR;
    }
    for (;;) {
        const bool has_next = S.next(ui + 1, nxt);
        const char* nA = has_next ? (const char*)g.A + (size_t)nxt.pm * tstep : cA; const char* nB = has_next ? (const char*)g.Bt + (size_t)nxt.pn * tstep : cB;
        for (int t = 0; t < nt; t += 2) {
            if constexpr (Epi::HAS_MID) { if (t == Epi::MID_T) E.mid(acc, cur, wr, wc, fr, fq); }
            const bool last = (t == nt - 2);
            const char* a1 = cA + (size_t)(t + 1) * kstep;
            const char* a2 = last ? nA : cA + (size_t)(t + 2) * kstep; const char* b2 = last ? nB : cB + (size_t)(t + 2) * kstep;
            const char* a3 = a2 + kstep; const char* b3 = b2 + kstep;
            if (last && has_next) S.a_ready(nxt);
            if constexpr (SP2) {
            PG8_LDB(B0, 0, 0); PG8_LDB(B1, 0, 1); PG8_SCHED; PG8_LDA(At, 0, 0); PG8_STAGE(PG8_SA(1, 1), a1 + hstep, voffA);
            PG8_WAIT_V(8); PG8_WAIT_L(0); PG8_BAR; PG8_MMA(0, 0, At, B0); PG8_MMA(0, 1, At, B1); PG8_BAR; PG8_SCHED;
            PG8_LDA(At, 0, 1); PG8_STAGE(PG8_SB(0, 0), b2, voffB); PG8_STAGE(PG8_SB(0, 1), b2 + hstep, voffB); PG8_STAGE(PG8_SA(0, 0), a2, voffA);
            PG8_WAIT_V(8); PG8_WAIT_L(0); PG8_BAR; PG8_MMA(1, 0, At, B0); PG8_MMA(1, 1, At, B1); PG8_BAR; PG8_SCHED;
            PG8_LDB(B0, 1, 0); PG8_LDB(B1, 1, 1); PG8_SCHED; PG8_LDA(At, 1, 0); PG8_STAGE(PG8_SA(0, 1), a2 + hstep, voffA);
            PG8_WAIT_V(8); PG8_WAIT_L(0); PG8_BAR; PG8_MMA(0, 0, At, B0); PG8_MMA(0, 1, At, B1); PG8_BAR; PG8_SCHED;
            PG8_LDA(At, 1, 1); PG8_STAGE(PG8_SB(1, 0), b3, voffB); PG8_STAGE(PG8_SB(1, 1), b3 + hstep, voffB); PG8_STAGE(PG8_SA(1, 0), a3, voffA);
            PG8_WAIT_V(8); PG8_WAIT_L(0); PG8_BAR; PG8_MMA(1, 0, At, B0); PG8_MMA(1, 1, At, B1); PG8_BAR; PG8_SCHED;
            } else {
            PG8_LDB(B0, 0, 0); PG8_SCHED; PG8_LDA(At, 0, 0); PG8_STAGE(PG8_SA(1, 1), a1 + hstep, voffA);
            PG8_WAIT_L(8); PG8_BAR; PG8_WAIT_L(0); PG8_MMA(0, 0, At, B0); PG8_BAR; PG8_SCHED;
            PG8_LDB(B1, 0, 1); PG8_STAGE(PG8_SB(0, 0), b2, voffB);
            PG8_BAR; PG8_WAIT_L(0); PG8_MMA(0, 1, At, B1); PG8_BAR;
            PG8_LDA(At, 0, 1); PG8_STAGE(PG8_SA(0, 0), a2, voffA);
            PG8_BAR; PG8_WAIT_L(0); PG8_MMA(1, 0, At, B0); PG8_BAR; PG8_SCHED;
            PG8_STAGE(PG8_SB(0, 1), b2 + hstep, voffB);
            PG8_WAIT_V(6); PG8_BAR; PG8_MMA(1, 1, At, B1); PG8_BAR;
            PG8_LDB(B0, 1, 0); PG8_SCHED; PG8_LDA(At, 1, 0); PG8_STAGE(PG8_SA(0, 1), a2 + hstep, voffA);
            PG8_WAIT_L(8); PG8_BAR; PG8_WAIT_L(0); PG8_MMA(0, 0, At, B0); PG8_BAR; PG8_SCHED;
            PG8_LDB(B1, 1, 1); PG8_STAGE(PG8_SB(1, 0), b3, voffB);
            PG8_BAR; PG8_WAIT_L(0); PG8_MMA(0, 1, At, B1); PG8_BAR;
            PG8_LDA(At, 1, 1); PG8_STAGE(PG8_SA(1, 0), a3, voffA);
            PG8_BAR; PG8_WAIT_L(0); PG8_MMA(1, 0, At, B0); PG8_BAR; PG8_SCHED;
            PG8_STAGE(PG8_SB(1, 1), b3 + hstep, voffB);
            PG8_WAIT_V(6); PG8_BAR; PG8_MMA(1, 1, At, B1); PG8_BAR;
            }
        }
        if constexpr (ALIGN_EPI) { if (wr == 0) PG8_BAR; }
        if constexpr (!Epi::AFTER_DRAIN) { E(acc, cur, wr, wc, fr, fq); S.done(cur); }
        if (!has_next) break;
#pragma unroll
        for (int a = 0; a < 2; ++a)
#pragma unroll
            for (int b = 0; b < 2; ++b)
#pragma unroll
                for (int m = 0; m < 4; ++m)
#pragma unroll
                    for (int n = 0; n < 2; ++n) acc[a][b][m][n] = (f32x4){0.f, 0.f, 0.f, 0.f};
        cur = nxt; cA = nA; cB = nB; ++ui;
        if constexpr (ALIGN_EPI) { if (wr == 1) PG8_BAR; }
    }
    PG8_WAIT_V(0);
    if constexpr (!ALIGN_EPI) { if (wr == 0) PG8_BAR; }
    PG8_BAR;
    if constexpr (Epi::AFTER_DRAIN) { E.fused(acc, cur, wr, wc, fr, fq, lds, wid, lane); S.done(cur); }
#undef PG8_SA
#undef PG8_SB
#undef PG8_STAGE
#undef PG8_LDA
#undef PG8_LDB
#undef PG8_MMA
#undef PG8_WAIT_V
#undef PG8_WAIT_L
#undef PG8_BAR
#undef PG8_SCHED
}
}

#define GAS __attribute__((address_space(1)))
#define LAS __attribute__((address_space(3)))
typedef unsigned short bf16;
typedef unsigned v4u __attribute__((ext_vector_type(4)));
typedef unsigned v2u __attribute__((ext_vector_type(2)));
typedef float f32x4 __attribute__((ext_vector_type(4)));
typedef float f32x2 __attribute__((ext_vector_type(2)));
typedef short bf16x8 __attribute__((ext_vector_type(8)));

constexpr int NWAVES = 8, NTHR = 512;
constexpr int DM = 1024, NBP = 8, SEQ = 2048, NBS = 32, TS = 8;
constexpr int MP = NBP * SEQ, MS = NBS * TS, MT = MP + MS;
constexpr int DIN = 10240;
constexpr int C_U = 0, C_V = 1024, C_Z = 2048, C_Q = 3072, C_K = 4608, C_VV = 6144, C_ZB = 7680, C_GA = 8192, C_GB = 9216;
constexpr float EPS = 1e-6f;
constexpr size_t O_Y = 0, O_KVP0 = (size_t)MT * DM, O_KVP1 = O_KVP0 + (size_t)8 * 128 * 1024, O_KVP2 = O_KVP1 + (size_t)8 * 512 * 1024,
                 O_KVS0 = O_KVP2 + (size_t)8 * 2048 * 1024, O_KVS1 = O_KVS0 + 262144, O_KVS2 = O_KVS1 + 262144, O_VCH = O_KVS2 + 262144, O_END = O_VCH + 262144;
constexpr size_t MiB = 1u << 20;
constexpr size_t WS_WIN = 2 * MiB, WS_WPA = 22 * MiB, WS_WPB = 24 * MiB, WS_WOUT = 25 * MiB, WS_MOD = 27 * MiB, WS_VST = 29 * MiB, WS_ML = 32 * MiB,
                 WS_H = 36 * MiB, WS_YA = 70 * MiB, WS_YB = 104 * MiB, WS_MRG = 122 * MiB, WS_O3 = 156 * MiB, WS_PART = 206 * MiB, WS_OUT = 272 * MiB,
                 WS_PROJ = 340 * MiB, WS_END = 672 * MiB;
static_assert(WS_PROJ + (size_t)MT * DIN * 2 <= WS_END, "ws map");
constexpr int LDS_BYTES = 147456;

#define LDS_WAIT() asm volatile("s_waitcnt lgkmcnt(0)" ::: "memory")
__device__ __forceinline__ unsigned f2bf(float f) { unsigned u = __builtin_bit_cast(unsigned, f); return (u + 0x7fffu + ((u >> 16) & 1u)) >> 16; }
typedef __bf16 bf16x2_t __attribute__((ext_vector_type(2)));
__device__ __forceinline__ unsigned pk2(float lo, float hi) { const f32x2 v = {lo, hi}; return __builtin_bit_cast(unsigned, __builtin_convertvector(v, bf16x2_t)); }
__device__ __forceinline__ float bflo(unsigned w) { return __builtin_bit_cast(float, w << 16); }
__device__ __forceinline__ float bfhi(unsigned w) { return __builtin_bit_cast(float, w & 0xffff0000u); }
__device__ __forceinline__ float bf2f(bf16 h) { return __builtin_bit_cast(float, (unsigned)h << 16); }
__device__ __forceinline__ float sigm(float x) { return __builtin_amdgcn_rcpf(1.f + __expf(-x)); }
__device__ __forceinline__ float silu(float x) { return x * __builtin_amdgcn_rcpf(1.f + __expf(-x)); }
__device__ __forceinline__ float wave_sum(float v) {
#pragma unroll
    for (int o = 1; o < 64; o <<= 1) v += __shfl_xor(v, o);
    return v;
}
__device__ __forceinline__ float wave_max(float v) {
#pragma unroll
    for (int o = 1; o < 64; o <<= 1) v = fmaxf(v, __shfl_xor(v, o));
    return v;
}
__device__ __forceinline__ float rdlane(float v, int l) { return __builtin_bit_cast(float, __builtin_amdgcn_readlane(__builtin_bit_cast(int, v), l)); }

#define XB_TMO      128
#define XB_XCNT(j)  (256  + 64 * (j))
#define XB_XSUB(j)  (1280 + 64 * (j))
#define XB_XGEN(j)  (2304 + 64 * (j))
#define XB_TOP      3328
#define XB_TOPGEN   3392
#define XCD_BAR_WORDS 3456
#define XB_SPIN_CAP (1u << 18)

__device__ __forceinline__ unsigned xb_ld(unsigned* p)              { return __hip_atomic_load(p, __ATOMIC_RELAXED, __HIP_MEMORY_SCOPE_AGENT); }
__device__ __forceinline__ unsigned xb_add(unsigned* p, unsigned v) { return __hip_atomic_fetch_add(p, v, __ATOMIC_RELAXED, __HIP_MEMORY_SCOPE_AGENT); }
__device__ __forceinline__ unsigned xb_xcc_id() { return (unsigned)__builtin_amdgcn_s_getreg((3 << 11) | 20) & 0xFu; }
#define XB_SPIN(cond, bar) do { unsigned _sp = 0; while (cond) { __builtin_amdgcn_s_sleep(1); \
    if ((++_sp & 255u) == 0u) { if (xb_ld(&(bar)[XB_TMO])) break; if (_sp > XB_SPIN_CAP) { atomicAdd(&(bar)[XB_TMO], 1u); break; } } } } while (0)

struct XcdBarrier {
    unsigned* bar; unsigned x;
    volatile LAS unsigned* st;
};

__device__ __forceinline__ XcdBarrier xcd_barrier_post(unsigned* bar, volatile LAS unsigned* st) {
    XcdBarrier b; b.bar = bar; b.x = xb_xcc_id(); b.st = st;
    if (threadIdx.x == 0) (void)xb_add(&bar[XB_XCNT(b.x)], 1u);
    return b;
}
__device__ __forceinline__ void xcd_barrier_complete(unsigned* bar, unsigned x, unsigned& nloc, unsigned& nx) {
    const unsigned G = gridDim.x * gridDim.y * gridDim.z;
    unsigned sum, cnt, mine, sp = 0u;
    for (;;) {
        sum = 0u; cnt = 0u; mine = 0u;
#pragma unroll
        for (unsigned j = 0; j < 16; ++j) { const unsigned c = xb_ld(&bar[XB_XCNT(j)]); sum += c; cnt += (c > 0u) ? 1u : 0u; mine = (j == x) ? c : mine; }
        if (sum == G) break;
        __builtin_amdgcn_s_sleep(1);
        if ((++sp & 255u) == 0u) { if (xb_ld(&bar[XB_TMO])) break; if (sp > XB_SPIN_CAP) { atomicAdd(&bar[XB_TMO], 1u); break; } }
    }
    nloc = mine > 0u ? mine : 1u; nx = cnt > 0u ? cnt : 1u;
}

__device__ __forceinline__ void xcd_barrier(const XcdBarrier& b) {
    asm volatile("s_waitcnt vmcnt(0)" ::: "memory");
    __syncthreads();
    if (threadIdx.x == 0) {
        unsigned* bar = b.bar;
        __builtin_amdgcn_s_waitcnt(0);
        unsigned nloc = b.st[0], nx = b.st[1];
        if (nloc == 0u) { xcd_barrier_complete(bar, b.x, nloc, nx); b.st[0] = nloc; b.st[1] = nx; }
        const unsigned old = xb_add(&bar[XB_XSUB(b.x)], 1u);
        const unsigned gen = old / nloc;
        if (old + 1u == (gen + 1u) * nloc) {
            __builtin_amdgcn_fence(__ATOMIC_RELEASE, "agent");
            asm volatile("s_waitcnt vmcnt(0)" ::: "memory");
            const unsigned og = xb_add(&bar[XB_TOP], 1u);
            const unsigned tg = og / nx;
            if (og + 1u == (tg + 1u) * nx) xb_add(&bar[XB_TOPGEN], 1u);
            else XB_SPIN(xb_ld(&bar[XB_TOPGEN]) == tg, bar);
            __builtin_amdgcn_fence(__ATOMIC_ACQUIRE, "agent");
            xb_add(&bar[XB_XGEN(b.x)], 1u);
            asm volatile("s_waitcnt vmcnt(0)" ::: "memory");
        } else {
            XB_SPIN(xb_ld(&bar[XB_XGEN(b.x)]) == gen, bar);
            __builtin_amdgcn_fence(__ATOMIC_ACQUIRE, "agent");
            asm volatile("s_waitcnt vmcnt(0)" ::: "memory");
        }
    }
    __syncthreads();
}

namespace pg8 {
struct EpiProj {
    static constexpr bool PERM = true, AFTER_DRAIN = false, HAS_MID = false; static constexpr int MID_T = -1;
    bf16_t* P; float* out; float* vst;
    __device__ __forceinline__ void operator()(const f32x4 (&acc)[2][2][4][2], const Unit& u, int wr, int wc, int fr, int fq) const {
        const int row0 = u.pm * BM + wr * 64 + fr;
        const int colt = u.pn * BM + wc * 32 + 8 * fq;
#pragma unroll
        for (int ai = 0; ai < 2; ++ai)
#pragma unroll
            for (int m = 0; m < 4; ++m) { bf16_t* rowp = P + (size_t)(row0 + ai * HALF + m * 16) * DIN + colt;
#pragma unroll
                for (int bj = 0; bj < 2; ++bj) { const f32x4 v0 = acc[ai][bj][m][0], v1 = acc[ai][bj][m][1];
                    u32x4 w; w.x = cvt_pk_bf16(v0[0], v0[1]); w.y = cvt_pk_bf16(v0[2], v0[3]); w.z = cvt_pk_bf16(v1[0], v1[1]); w.w = cvt_pk_bf16(v1[2], v1[3]);
                    *(u32x4*)(rowp + bj * HALF) = w; } }
        if (u.pn >= 4 && u.pn < 8) {
#pragma unroll
            for (int ai = 0; ai < 2; ++ai)
#pragma unroll
                for (int m = 0; m < 4; ++m) { float s = 0.f, q = 0.f;
#pragma unroll
                    for (int bj = 0; bj < 2; ++bj)
#pragma unroll
                        for (int n = 0; n < 2; ++n) { const f32x4 x = acc[ai][bj][m][n]; s += (x[0] + x[1]) + (x[2] + x[3]); q += (x[0] * x[0] + x[1] * x[1]) + (x[2] * x[2] + x[3] * x[3]); }
                    s += __shfl_xor(s, 16); s += __shfl_xor(s, 32); q += __shfl_xor(q, 16); q += __shfl_xor(q, 32);
                    if (fq == 0) { float* d = vst + ((size_t)(row0 + ai * HALF + m * 16) * 16 + (u.pn - 4) * 4 + wc) * 2; *(f32x2*)d = (f32x2){s, q}; } }
        }
        if (u.pn >= 18 && u.pn < 30) {
            const int kv = u.pn >= 24 ? 1 : 0; const int t = u.pn - 18 - 6 * kv; const int g = t >> 1, half = t & 1;
            const int dcol = kv * 512 + half * 256 + wc * 32 + 8 * fq;
            const int R = g == 0 ? 128 : (g == 1 ? 512 : 2048);
            const size_t obp = g == 0 ? O_KVP0 : (g == 1 ? O_KVP1 : O_KVP2), obs = g == 0 ? O_KVS0 : (g == 1 ? O_KVS1 : O_KVS2);
#pragma unroll
            for (int ai = 0; ai < 2; ++ai)
#pragma unroll
                for (int m = 0; m < 4; ++m) { const int row = row0 + ai * HALF + m * 16; float* base = nullptr;
                    if (row < MP) { const int b = row >> 11, s = row & 2047, r = s - (2048 - R); if (r >= 0) base = out + obp + (size_t)(b * R + r) * 1024 + dcol; }
                    else base = out + obs + (size_t)(row - MP) * 1024 + dcol;
                    if (base) {
#pragma unroll
                        for (int bj = 0; bj < 2; ++bj)
#pragma unroll
                            for (int n = 0; n < 2; ++n) *(f32x4*)(base + bj * HALF + 4 * n) = acc[ai][bj][m][n]; } }
        }
    }
};
struct EpiMerge {
    static constexpr bool PERM = true, AFTER_DRAIN = false, HAS_MID = true; static constexpr int MID_T = 16;
    const bf16_t* P; bf16_t* mrg;
    __device__ __forceinline__ void mid(f32x4 (&acc)[2][2][4][2], const Unit& u, int wr, int wc, int fr, int fq) const {
        int ln = (int)__builtin_amdgcn_mbcnt_hi(~0u, __builtin_amdgcn_mbcnt_lo(~0u, 0u));
        asm volatile("" : "+v"(ln));
        const int row0 = u.pm * BM + wr * 64 + (ln & 15); const int colt = u.pn * BM + wc * 32 + 8 * (ln >> 4);
#pragma unroll
        for (int ai = 0; ai < 2; ++ai)
#pragma unroll
            for (int m = 0; m < 4; ++m) { const size_t row = (size_t)(row0 + ai * HALF + m * 16); const bf16_t* gp = P + row * DIN + colt;
#pragma unroll
                for (int bj = 0; bj < 2; ++bj)
#pragma unroll
                    for (int n = 0; n < 2; ++n) { typedef unsigned u32x2 __attribute__((ext_vector_type(2)));
                        const u32x2 ga = *(const u32x2*)(gp + C_GA + bj * HALF + 4 * n), gb = *(const u32x2*)(gp + C_GB + bj * HALF + 4 * n);
                        f32x4 r;
                        r[0] = (1.f + __expf(-fmaxf(bflo(gb.x), -60.f))) * __builtin_amdgcn_rcpf(1.f + __expf(-bflo(ga.x)));
                        r[1] = (1.f + __expf(-fmaxf(bfhi(gb.x), -60.f))) * __builtin_amdgcn_rcpf(1.f + __expf(-bfhi(ga.x)));
                        r[2] = (1.f + __expf(-fmaxf(bflo(gb.y), -60.f))) * __builtin_amdgcn_rcpf(1.f + __expf(-bflo(ga.y)));
                        r[3] = (1.f + __expf(-fmaxf(bfhi(gb.y), -60.f))) * __builtin_amdgcn_rcpf(1.f + __expf(-bfhi(ga.y)));
                        acc[ai][bj][m][n] *= r;
                        __builtin_amdgcn_sched_barrier(0); }
                asm volatile("" ::: "memory"); }
    }
    __device__ __forceinline__ void operator()(const f32x4 (&acc)[2][2][4][2], const Unit& u, int wr, int wc, int fr, int fq) const {
        const int row0 = u.pm * BM + wr * 64 + fr; const int colt = u.pn * BM + wc * 32 + 8 * fq;
#pragma unroll
        for (int ai = 0; ai < 2; ++ai)
#pragma unroll
            for (int m = 0; m < 4; ++m) { const size_t row = (size_t)(row0 + ai * HALF + m * 16); const bf16_t* gp = P + row * DIN + C_GB + colt;
#pragma unroll
                for (int bj = 0; bj < 2; ++bj) { const u32x4 gw = *(const u32x4*)(gp + bj * HALF); const f32x4 a0 = acc[ai][bj][m][0], a1 = acc[ai][bj][m][1];
                    const float b[8] = {bflo(gw.x), bfhi(gw.x), bflo(gw.y), bfhi(gw.y), bflo(gw.z), bfhi(gw.z), bflo(gw.w), bfhi(gw.w)};
                    float o[8];
#pragma unroll
                    for (int e = 0; e < 8; ++e) o[e] = (e < 4 ? a0[e & 3] : a1[e & 3]) * __builtin_amdgcn_rcpf(1.f + __expf(-fmaxf(b[e], -60.f)));
                    u32x4 w; w.x = cvt_pk_bf16(o[0], o[1]); w.y = cvt_pk_bf16(o[2], o[3]); w.z = cvt_pk_bf16(o[4], o[5]); w.w = cvt_pk_bf16(o[6], o[7]);
                    *(u32x4*)(mrg + row * DM + colt + bj * HALF) = w; } }
    }
};
struct EpiF32 {
    static constexpr bool PERM = true, AFTER_DRAIN = false, HAS_MID = false; static constexpr int MID_T = -1;
    bf16_t* O;
    __device__ __forceinline__ void operator()(const f32x4 (&acc)[2][2][4][2], const Unit& u, int wr, int wc, int fr, int fq) const {
        const int row0 = u.pm * BM + wr * 64 + fr; const int colt = u.pn * BM + wc * 32 + 8 * fq;
#pragma unroll
        for (int ai = 0; ai < 2; ++ai)
#pragma unroll
            for (int m = 0; m < 4; ++m) { bf16_t* pp = O + (size_t)(row0 + ai * HALF + m * 16) * DM + colt;
#pragma unroll
                for (int bj = 0; bj < 2; ++bj) { const f32x4 v0 = acc[ai][bj][m][0], v1 = acc[ai][bj][m][1];
                    u32x4 w; w.x = cvt_pk_bf16(v0[0], v0[1]); w.y = cvt_pk_bf16(v0[2], v0[3]); w.z = cvt_pk_bf16(v1[0], v1[1]); w.w = cvt_pk_bf16(v1[2], v1[3]);
                    *(u32x4*)(pp + bj * HALF) = w; } }
    }
};
}

__device__ __forceinline__ void p0_transpose_item(const float* W, int K, int N, bf16* WT, int ldk, int koff, LAS float* scr, int item, int lane) {
    const int nblk = N / 32, kb = item / nblk, nb = item % nblk, k0 = 64 * kb, n0 = 32 * nb;
#pragma unroll
    for (int i = 0; i < 32; ++i) { const int kk = 2 * i + (lane >> 5); scr[kk * 33 + (lane & 31)] = W[(size_t)(k0 + kk) * N + n0 + (lane & 31)]; }
    LDS_WAIT(); asm volatile("" ::: "memory");
    const int c = lane & 7;
#pragma unroll
    for (int j = 0; j < 4; ++j) { const int n = (lane >> 3) + 8 * j; const LAS float* s = scr + (8 * c) * 33 + n;
        v4u o; o.x = pk2(s[0 * 33], s[1 * 33]); o.y = pk2(s[2 * 33], s[3 * 33]); o.z = pk2(s[4 * 33], s[5 * 33]); o.w = pk2(s[6 * 33], s[7 * 33]);
        *(GAS v4u*)(WT + (size_t)(n0 + n) * ldk + koff + k0 + 8 * c) = o; }
    LDS_WAIT(); asm volatile("" ::: "memory");
}
__device__ __forceinline__ void mod_task(int task, const float* cp, const float* cs, const float* Wc, const float* bc, float* MODP, LAS unsigned char* lds, int tid, int wave, int lane) {
    const int chunk = task >> 2, kq = task & 3;
    const int k0 = kq * 256 + wave * 32;
    float sc[40], acc[40];
#pragma unroll
    for (int r = 0; r < 40; ++r) { const float* crow = (r < 8) ? cp + r * 1024 : cs + (r - 8) * 1024; sc[r] = silu(crow[k0 + (lane & 31)]); acc[r] = 0.f; }
    const float* wp = Wc + (size_t)k0 * 3072 + chunk * 64 + lane;
#pragma unroll 8
    for (int kk = 0; kk < 32; ++kk) { const float wv = wp[(size_t)kk * 3072];
#pragma unroll
        for (int r = 0; r < 40; ++r) acc[r] += rdlane(sc[r], kk) * wv; }
    LAS float* red = (LAS float*)lds;
#pragma unroll
    for (int r = 0; r < 40; ++r) red[(wave * 40 + r) * 64 + lane] = acc[r];
    __syncthreads();
    for (int idx = tid; idx < 2560; idx += NTHR) { const int r = idx >> 6, cl = idx & 63; float s = 0.f;
#pragma unroll
        for (int w = 0; w < 8; ++w) s += red[(w * 40 + r) * 64 + cl];
        if (kq == 0) s += bc[chunk * 64 + cl];
        MODP[((size_t)kq * 40 + r) * 3072 + chunk * 64 + cl] = s; }
    __syncthreads();
}

typedef short s16x4 __attribute__((ext_vector_type(4)));
__device__ __forceinline__ s16x4 lds_tr(const LAS bf16* p) { return __builtin_bit_cast(s16x4, __builtin_amdgcn_ds_read_tr16_b64_v4i16((LAS s16x4*)p)); }
__device__ __forceinline__ void att_decode(int idx, int& g, int& b, int& h, int& d, int& n, int& r) {
    b = 7 - idx / 384; int rem = idx % 384; g = rem >> 7; rem &= 127; h = rem >> 4; const int sub = rem & 15;
    if (g == 0) { d = 1; n = sub; r = 0; } else if (g == 1) { d = 4; r = sub >> 2; n = sub & 3; } else { d = 16; r = sub; n = 0; }
}
__device__ __forceinline__ void att_prefetch(int idx, const bf16* PROJ, int tid, int wave, int lane, v4u (&kk)[4], v4u (&vv)[4], bf16x8& Q0, bf16x8& Q1) {
    int g, b, h, d, n, r; att_decode(idx, g, b, h, d, n, r);
#pragma unroll
    for (int c = 0; c < 4; ++c) { const int f = c * 512 + tid; const int key = f >> 3, chunk = f & 7; const int m = 128 * (n - 1) + key;
        if (m >= 0) { const size_t row = (size_t)b * 2048 + (size_t)d * m + r; const bf16* src = PROJ + row * DIN + g * 512 + h * 64 + chunk * 8;
            kk[c] = *(const v4u*)(src + C_K); vv[c] = *(const v4u*)(src + C_VV); }
        else { kk[c] = (v4u){0u, 0u, 0u, 0u}; vv[c] = (v4u){0u, 0u, 0u, 0u}; } }
    const int fr = lane & 15, fq = lane >> 4; const int i = 16 * wave + fr;
    const size_t rowq = (size_t)b * 2048 + (size_t)d * (128 * n + i) + r;
    const bf16* qsrc = PROJ + rowq * DIN + C_Q + g * 512 + h * 64 + 8 * fq;
    Q0 = *(const bf16x8*)qsrc; Q1 = *(const bf16x8*)(qsrc + 32);
}
__device__ __forceinline__ void att_compute(int idx, bf16* O3, float* ML, LAS unsigned char* lds, int wave, int lane, const bf16x8 Q0, const bf16x8 Q1) {
    int g, b, h, d, n, r; att_decode(idx, g, b, h, d, n, r);
    const LAS bf16* Ks = (const LAS bf16*)lds;
    const LAS bf16* Vs = (const LAS bf16*)(lds + 36864);
    const int fr = lane & 15, fq = lane >> 4;
    const int i = 16 * wave + fr;
    const size_t rowq = (size_t)b * 2048 + (size_t)d * (128 * n + i) + r;
    const int start = wave & ~1; const int lo = (n == 0) ? 8 : start;
    f32x4 S[10]; float mx = -1e30f;
#pragma unroll
    for (int p = 0; p < 10; ++p) { const int tile = start + p;
        if (tile >= lo) {
            const LAS bf16* kp = Ks + (tile * 16 + fr) * 72 + 8 * fq;
            const bf16x8 K0 = *(const LAS bf16x8*)kp, K1 = *(const LAS bf16x8*)(kp + 32);
            f32x4 s = (f32x4){0.f, 0.f, 0.f, 0.f};
            s = __builtin_amdgcn_mfma_f32_16x16x32_bf16(K0, Q0, s, 0, 0, 0); s = __builtin_amdgcn_mfma_f32_16x16x32_bf16(K1, Q1, s, 0, 0, 0);
#pragma unroll
            for (int e = 0; e < 4; ++e) { const int j = tile * 16 + 4 * fq + e; const bool valid = (j >= i) && (j <= i + 128); s[e] = valid ? s[e] * 0.125f : -1e30f; mx = fmaxf(mx, s[e]); }
            S[p] = s;
        } else S[p] = (f32x4){-1e30f, -1e30f, -1e30f, -1e30f};
    }
    mx = fmaxf(mx, __shfl_xor(mx, 16)); mx = fmaxf(mx, __shfl_xor(mx, 32));
    float l = 0.f;
#pragma unroll
    for (int p = 0; p < 10; ++p)
#pragma unroll
        for (int e = 0; e < 4; ++e) { const float ex = __expf(S[p][e] - mx); S[p][e] = ex; l += ex; }
    l += __shfl_xor(l, 16); l += __shfl_xor(l, 32);
    f32x4 O[4];
#pragma unroll
    for (int dt = 0; dt < 4; ++dt) O[dt] = (f32x4){0.f, 0.f, 0.f, 0.f};
#pragma unroll
    for (int pp = 0; pp < 5; ++pp) {
        if (start + 2 * pp >= lo) {
            v4u pw; pw.x = pk2(S[2 * pp][0], S[2 * pp][1]); pw.y = pk2(S[2 * pp][2], S[2 * pp][3]); pw.z = pk2(S[2 * pp + 1][0], S[2 * pp + 1][1]); pw.w = pk2(S[2 * pp + 1][2], S[2 * pp + 1][3]);
            const bf16x8 Pf = __builtin_bit_cast(bf16x8, pw);
            const LAS bf16* vbase = Vs + ((start + 2 * pp) * 16 + 4 * fq + (fr >> 2)) * 72 + 4 * (fr & 3);
#pragma unroll
            for (int dt = 0; dt < 4; ++dt) { const s16x4 va = lds_tr(vbase + 16 * dt), vb = lds_tr(vbase + 16 * 72 + 16 * dt);
                const bf16x8 Vf = (bf16x8){va[0], va[1], va[2], va[3], vb[0], vb[1], vb[2], vb[3]};
                O[dt] = __builtin_amdgcn_mfma_f32_16x16x32_bf16(Vf, Pf, O[dt], 0, 0, 0); }
        }
    }
    const float inv = 1.f / l;
    bf16* op = O3 + ((size_t)g * MT + rowq) * 512 + h * 64 + 4 * fq;
#pragma unroll
    for (int dt = 0; dt < 4; ++dt) { v2u w; w.x = pk2(O[dt][0] * inv, O[dt][1] * inv); w.y = pk2(O[dt][2] * inv, O[dt][3] * inv); *(v2u*)(op + 16 * dt) = w; }
    if (fq == 0) { float* mp = ML + (((size_t)g * MT + rowq) * 8 + h) * 2; *(f32x2*)mp = (f32x2){mx, l}; }
}

#define GM_PREFETCH(idx_) do { const int ci_ = 127 - ((idx_) >> 3), g_ = (idx_) & 7; const int r0_ = ci_ * 128; \
        st0 = ((const f32x4*)(VST + (size_t)(r0_ + s) * 32))[2 * cp]; st1 = ((const f32x4*)(VST + (size_t)(r0_ + s) * 32))[2 * cp + 1]; \
        _Pragma("unroll") for (int c = 0; c < 4; ++c) { const bf16* p_ = PROJ + (size_t)(r0_ + 32 * c + prow) * DIN + g_ * 128 + piece * 8; \
            vraw[c] = *(const v4u*)(p_ + C_V); uraw[c] = *(const v4u*)(p_ + C_U); zraw[c] = *(const v4u*)(p_ + C_Z); } } while (0)
__device__ __forceinline__ void gmlp_phase(int bx, int G, int n_items, const bf16* PROJ, const float* VST, const float* Wsp, const float* bsp, const float* lng, const float* lnb, bf16* YA,
                                           LAS unsigned char* lds, int tid, int wave, int lane) {
    LAS bf16* VN = (LAS bf16*)lds;
    LAS bf16* WS = (LAS bf16*)(lds + 34816);
    LAS bf16* UY = (LAS bf16*)(lds + 69632);
    LAS bf16* ZZ = (LAS bf16*)(lds + 104448);
    LAS f32x2* ST = (LAS f32x2*)(lds + 139280);
    const int s = tid >> 2, cp = tid & 3;
    const int prow = tid >> 4, piece = tid & 15;
    const int fr = lane & 15, fq = lane >> 4;
    const int t = 16 * wave + fr;
    int g_staged = -1;
    f32x4 st0, st1; v4u vraw[4], uraw[4], zraw[4];
    f32x4 lg0, lg1, lb0, lb1;
    int it = bx;
    if (it < n_items) GM_PREFETCH(it);
    for (; it < n_items; it += G) {
        const int ci = 127 - (it >> 3), g = it & 7; const int row0 = ci * 128;
        if (g != g_staged) {
            const float* wp = Wsp + ((size_t)g * 128 + s) * 128 + cp * 32;
#pragma unroll
            for (int c = 0; c < 4; ++c) { const f32x4 a = ((const f32x4*)wp)[2 * c], b2 = ((const f32x4*)wp)[2 * c + 1]; const int s0 = cp * 32 + 8 * c;
                float v[8] = {a[0], a[1], a[2], a[3], b2[0], b2[1], b2[2], b2[3]};
#pragma unroll
                for (int e = 0; e < 8; ++e) v[e] = (s0 + e <= s) ? v[e] : 0.f;
                v4u w; w.x = pk2(v[0], v[1]); w.y = pk2(v[2], v[3]); w.z = pk2(v[4], v[5]); w.w = pk2(v[6], v[7]);
                *(LAS v4u*)(WS + s * 136 + s0) = w; }
            const int ch = g * 128 + piece * 8;
            lg0 = *(const f32x4*)(lng + ch); lg1 = *(const f32x4*)(lng + ch + 4); lb0 = *(const f32x4*)(lnb + ch); lb1 = *(const f32x4*)(lnb + ch + 4);
            g_staged = g;
        }
        float sm = (st0[0] + st0[2]) + (st1[0] + st1[2]), sq = (st0[1] + st0[3]) + (st1[1] + st1[3]);
        sm += __shfl_xor(sm, 1); sm += __shfl_xor(sm, 2); sq += __shfl_xor(sq, 1); sq += __shfl_xor(sq, 2);
        const float mu_s = sm * (1.f / 1024.f);
        if (cp == 0) ST[s] = (f32x2){mu_s, rsqrtf(sq * (1.f / 1024.f) - mu_s * mu_s + EPS)};
#pragma unroll
        for (int c = 0; c < 4; ++c) { *(LAS v4u*)(UY + (32 * c + prow) * 136 + piece * 8) = uraw[c]; *(LAS v4u*)(ZZ + (32 * c + prow) * 136 + piece * 8) = zraw[c]; }
        __syncthreads();
#pragma unroll
        for (int c = 0; c < 4; ++c) { const v4u raw = vraw[c]; const f32x2 mr = ST[32 * c + prow]; const float mu = mr[0], rstd = mr[1];
            v4u w;
            w.x = pk2((bflo(raw.x) - mu) * rstd * lg0[0] + lb0[0], (bfhi(raw.x) - mu) * rstd * lg0[1] + lb0[1]);
            w.y = pk2((bflo(raw.y) - mu) * rstd * lg0[2] + lb0[2], (bfhi(raw.y) - mu) * rstd * lg0[3] + lb0[3]);
            w.z = pk2((bflo(raw.z) - mu) * rstd * lg1[0] + lb1[0], (bfhi(raw.z) - mu) * rstd * lg1[1] + lb1[1]);
            w.w = pk2((bflo(raw.w) - mu) * rstd * lg1[2] + lb1[2], (bfhi(raw.w) - mu) * rstd * lg1[3] + lb1[3]);
            *(LAS v4u*)(VN + (32 * c + prow) * 136 + piece * 8) = w; }
        __syncthreads();
        if (it + G < n_items) GM_PREFETCH(it + G);
        const int nks = (wave >> 1) + 1;
        f32x4 acc[8];
#pragma unroll
        for (int ct = 0; ct < 8; ++ct) acc[ct] = (f32x4){0.f, 0.f, 0.f, 0.f};
#pragma unroll
        for (int ks = 0; ks < 4; ++ks) {
            if (ks < nks) { const bf16x8 Wf = *(const LAS bf16x8*)(WS + t * 136 + 32 * ks + 8 * fq);
                const LAS bf16* vb = VN + (32 * ks + 8 * fq + (fr >> 2)) * 136 + 4 * (fr & 3);
#pragma unroll
                for (int ct = 0; ct < 8; ++ct) { const s16x4 va = lds_tr(vb + 16 * ct), vb2 = lds_tr(vb + 4 * 136 + 16 * ct);
                    const bf16x8 Vf = (bf16x8){va[0], va[1], va[2], va[3], vb2[0], vb2[1], vb2[2], vb2[3]};
                    acc[ct] = __builtin_amdgcn_mfma_f32_16x16x32_bf16(Vf, Wf, acc[ct], 0, 0, 0); } }
        }
        const float bs = bsp[g * 128 + t];
#pragma unroll
        for (int ct = 0; ct < 8; ++ct) { LAS v2u* up = (LAS v2u*)(UY + t * 136 + 16 * ct + 4 * fq); const v2u uu = *up, zz = *(const LAS v2u*)(ZZ + t * 136 + 16 * ct + 4 * fq);
            const float y0 = bflo(uu.x) * (acc[ct][0] + bs) * silu(bflo(zz.x)), y1 = bfhi(uu.x) * (acc[ct][1] + bs) * silu(bfhi(zz.x));
            const float y2 = bflo(uu.y) * (acc[ct][2] + bs) * silu(bflo(zz.y)), y3 = bfhi(uu.y) * (acc[ct][3] + bs) * silu(bfhi(zz.y));
            v2u w; w.x = pk2(y0, y1); w.y = pk2(y2, y3); *up = w; }
        __syncthreads();
#pragma unroll
        for (int c = 0; c < 4; ++c) *(v4u*)(YA + ((size_t)row0 + 32 * c + prow) * 1536 + g * 128 + piece * 8) = *(const LAS v4u*)(UY + (32 * c + prow) * 136 + piece * 8);
        __syncthreads();
    }
}

__device__ __forceinline__ void gmlp_sample_item(int b, const bf16* PROJ, const float* VST, const float* Wsp, const float* bsp, const float* lng, const float* lnb, bf16* YA, float* out,
                                                 LAS unsigned char* lds, int tid, int wave, int lane) {
    const int r0 = MP + b * 8;
    LAS float* st = (LAS float*)lds;
    if (tid < 8) { const float* p = VST + (size_t)(r0 + tid) * 32; float s = 0.f, q = 0.f;
#pragma unroll
        for (int k = 0; k < 8; ++k) { const f32x4 a = ((const f32x4*)p)[k]; s += a[0] + a[2]; q += a[1] + a[3]; }
        const float mu = s * (1.f / 1024.f); const float var = q * (1.f / 1024.f) - mu * mu; st[2 * tid] = mu; st[2 * tid + 1] = rsqrtf(var + EPS); }
    __syncthreads();
    const int ch = 2 * tid, g = wave;
    const float lg0 = lng[ch], lg1 = lng[ch + 1], lb0 = lnb[ch], lb1 = lnb[ch + 1];
    float vn0[8], vn1[8];
#pragma unroll
    for (int s = 0; s < 8; ++s) { const unsigned raw = *(const unsigned*)(PROJ + (size_t)(r0 + s) * DIN + C_V + ch); const float mu = st[2 * s], rstd = st[2 * s + 1];
        vn0[s] = (bflo(raw) - mu) * rstd * lg0 + lb0; vn1[s] = (bfhi(raw) - mu) * rstd * lg1 + lb1;
        *(f32x2*)(out + O_VCH + (size_t)(b * 8 + s) * 1024 + ch) = (f32x2){vn0[s], vn1[s]}; }
#pragma unroll
    for (int t = 0; t < 8; ++t) { float z0 = bsp[g * 128 + t], z1 = z0;
#pragma unroll
        for (int s = 0; s < 8; ++s) if (s <= t) { const float w = Wsp[((size_t)g * 128 + t) * 128 + s]; z0 += w * vn0[s]; z1 += w * vn1[s]; }
        const unsigned uu = *(const unsigned*)(PROJ + (size_t)(r0 + t) * DIN + C_U + ch), zz = *(const unsigned*)(PROJ + (size_t)(r0 + t) * DIN + C_Z + ch);
        *(unsigned*)(YA + (size_t)(r0 + t) * 1536 + ch) = pk2(bflo(uu) * z0 * silu(bflo(zz)), bfhi(uu) * z1 * silu(bfhi(zz))); }
    __syncthreads();
}

__device__ __forceinline__ f32x4 sa_load(const bf16* PROJ, const float* cache, int b, int lw, int ix, int pcol, int ccol, bool maybe_new) {
    if (maybe_new && ix >= lw) { const v2u raw = *(const v2u*)(PROJ + (size_t)(MP + b * 8 + ix - lw) * DIN + pcol); return (f32x4){bflo(raw.x), bfhi(raw.x), bflo(raw.y), bfhi(raw.y)}; }
    const int ic = ix < lw ? ix : lw - 1;
    return *(const f32x4*)(cache + (size_t)ic * 1024 + ccol);
}
__device__ __forceinline__ void attn_sample_item(int idx, const bf16* PROJ, const float* c128, const float* c512, const float* c2048, bf16* O3, float* ML, int wave, int lane) {
    const int b = idx / 24; const int rem = idx - b * 24; const int g = rem >> 3, t = rem & 7; const int h = wave;
    const int lw = g == 0 ? 128 : (g == 1 ? 512 : 2048), d = g == 0 ? 1 : (g == 1 ? 4 : 16);
    const float* cache = (g == 0 ? c128 : (g == 1 ? c512 : c2048)) + (size_t)b * lw * 1024;
    const size_t rq = (size_t)MP + b * 8 + t;
    const int ks = lane >> 4, dq = lane & 15;
    const int hc = g * 512 + h * 64 + 4 * dq;
    const v2u qraw = *(const v2u*)(PROJ + rq * DIN + C_Q + hc);
    const float q0 = bflo(qraw.x) * 0.125f, q1 = bfhi(qraw.x) * 0.125f, q2 = bflo(qraw.y) * 0.125f, q3 = bfhi(qraw.y) * 0.125f;
    const float* kbase = cache + h * 64;
    const unsigned lo4 = 4u * (unsigned)dq;
    constexpr int NVA = 8;
    const int ixb = lw + t - d * ks;
    f32x4 kk[33], va[NVA];
#pragma unroll
    for (int it = 0; it < 33; ++it) { int ix = (it < 32 || ks == 0) ? ixb - 4 * d * it : lw + t - 128 * d; ix = ix < lw ? ix : lw - 1; kk[it] = *(const f32x4*)(kbase + ((unsigned)ix * 1024u + lo4)); }
#pragma unroll
    for (int it = 0; it < NVA; ++it) { int ix = ixb - 4 * d * it; ix = ix < lw ? ix : lw - 1; va[it] = *(const f32x4*)(kbase + ((unsigned)ix * 1024u + 512u + lo4)); }
#pragma unroll
    for (int it = 0; it < 2; ++it) { const int ix = ixb - 4 * d * it;
        if (ix >= lw) { const bf16* pr = PROJ + (size_t)(MP + b * 8 + ix - lw) * DIN + hc; const v2u rk = *(const v2u*)(pr + C_K), rv = *(const v2u*)(pr + C_VV);
            kk[it] = (f32x4){bflo(rk.x), bfhi(rk.x), bflo(rk.y), bfhi(rk.y)}; va[it] = (f32x4){bflo(rv.x), bfhi(rv.x), bflo(rv.y), bfhi(rv.y)}; } }
    float s[33]; float mx = -1e30f;
#pragma unroll
    for (int it = 0; it < 33; ++it) {
        float a = (kk[it][0] * q0 + kk[it][1] * q1) + (kk[it][2] * q2 + kk[it][3] * q3);
        a += __shfl_xor(a, 1); a += __shfl_xor(a, 2); a += __shfl_xor(a, 4); a += __shfl_xor(a, 8);
        s[it] = ((it < 32) || (ks == 0)) ? a : -1e30f; mx = fmaxf(mx, s[it]);
    }
    __builtin_amdgcn_sched_barrier(0);
    f32x4 vb[33 - NVA];
#pragma unroll
    for (int it = NVA; it < 33; ++it) { int ix = (it < 32 || ks == 0) ? ixb - 4 * d * it : lw + t - 128 * d; vb[it - NVA] = *(const f32x4*)(kbase + ((unsigned)ix * 1024u + 512u + lo4)); }
    mx = fmaxf(mx, __shfl_xor(mx, 16)); mx = fmaxf(mx, __shfl_xor(mx, 32));
    float l = 0.f;
#pragma unroll
    for (int it = 0; it < 33; ++it) { s[it] = __expf(s[it] - mx); l += s[it]; }
    l += __shfl_xor(l, 16); l += __shfl_xor(l, 32);
    f32x4 o = (f32x4){0.f, 0.f, 0.f, 0.f};
#pragma unroll
    for (int it = 0; it < NVA; ++it) o += va[it] * s[it];
#pragma unroll
    for (int it = NVA; it < 33; ++it) o += vb[it - NVA] * s[it];
#pragma unroll
    for (int e = 0; e < 4; ++e) { o[e] += __shfl_xor(o[e], 16); o[e] += __shfl_xor(o[e], 32); }
    const float inv = 1.f / l;
    if (ks == 0) { v2u w; w.x = pk2(o[0] * inv, o[1] * inv); w.y = pk2(o[2] * inv, o[3] * inv); *(v2u*)(O3 + ((size_t)g * MT + rq) * 512 + h * 64 + 4 * dq) = w; }
    if (lane == 0) { float* mp = ML + (((size_t)g * MT + rq) * 8 + h) * 2; mp[0] = mx; mp[1] = l; }
}

template <int MW, int NT>
__device__ __forceinline__ void sg_mma(f32x4 (&acc)[MW][NT], const bf16* A, const bf16* Bt, int K, int lane, int lda = 0, int ldb = 0) {
    const int fr = lane & 15, fq = lane >> 4;
    if (lda == 0) lda = K; if (ldb == 0) ldb = K;
    const bf16* ap = A + (size_t)fr * lda + 8 * fq; const bf16* bp = Bt + (size_t)fr * ldb + 8 * fq;
    constexpr int UNR = (MW * NT == 1) ? 16 : 4;
#pragma unroll UNR
    for (int ks = 0; ks < K / 32; ++ks) {
        bf16x8 a[MW], b[NT];
#pragma unroll
        for (int mi = 0; mi < MW; ++mi) a[mi] = *(const bf16x8*)(ap + (size_t)mi * 16 * lda + 32 * ks);
#pragma unroll
        for (int ni = 0; ni < NT; ++ni) b[ni] = *(const bf16x8*)(bp + (size_t)ni * 16 * ldb + 32 * ks);
#pragma unroll
        for (int mi = 0; mi < MW; ++mi)
#pragma unroll
            for (int ni = 0; ni < NT; ++ni) acc[mi][ni] = __builtin_amdgcn_mfma_f32_16x16x32_bf16(b[ni], a[mi], acc[mi][ni], 0, 0, 0);
    }
}
__device__ __forceinline__ void sg_proj_task(int ts, const bf16* H, const bf16* WIN_T, bf16* PROJ, float* out, float* VST, int wave, int lane) {
    const int fr = lane & 15, fq = lane >> 4; const int n0 = 64 * ts; const int r0 = MP + 32 * wave;
    f32x4 acc[2][4];
#pragma unroll
    for (int mi = 0; mi < 2; ++mi)
#pragma unroll
        for (int ni = 0; ni < 4; ++ni) acc[mi][ni] = (f32x4){0.f, 0.f, 0.f, 0.f};
    sg_mma<2, 4>(acc, H + (size_t)r0 * DM, WIN_T + (size_t)n0 * DM, DM, lane);
#pragma unroll
    for (int mi = 0; mi < 2; ++mi) { const int row = r0 + 16 * mi + fr;
#pragma unroll
        for (int ni = 0; ni < 4; ++ni) { const int col = n0 + 16 * ni + 4 * fq; const f32x4 v = acc[mi][ni];
            v2u w; w.x = pk2(v[0], v[1]); w.y = pk2(v[2], v[3]); *(v2u*)(PROJ + (size_t)row * DIN + col) = w;
            if (col >= C_K && col < C_ZB) { const int kv = col >= C_VV ? 1 : 0; const int cc = col - (kv ? C_VV : C_K); const int g = cc >> 9, hc = cc & 511;
                const size_t obs = g == 0 ? O_KVS0 : (g == 1 ? O_KVS1 : O_KVS2);
                *(f32x4*)(out + obs + (size_t)(row - MP) * 1024 + kv * 512 + hc) = v; } }
        if (n0 >= C_V && n0 < C_Z) { float s = 0.f, q = 0.f;
#pragma unroll
            for (int ni = 0; ni < 4; ++ni) { const f32x4 x = acc[mi][ni]; s += (x[0] + x[1]) + (x[2] + x[3]); q += (x[0] * x[0] + x[1] * x[1]) + (x[2] * x[2] + x[3] * x[3]); }
            s += __shfl_xor(s, 16); s += __shfl_xor(s, 32); q += __shfl_xor(q, 16); q += __shfl_xor(q, 32);
            if (fq == 0) *(f32x2*)(VST + ((size_t)row * 16 + ((n0 - C_V) >> 6)) * 2) = (f32x2){s, q}; } }
}
template <int KS>
__device__ __forceinline__ void sgk_mma(f32x4 (&acc)[2][2], const bf16* A, int lda, const bf16* Bt, int ldb, int lane) {
    const int fr = lane & 15, fq = lane >> 4;
    const bf16* ap = A + (size_t)fr * lda + 8 * fq; const bf16* bp = Bt + (size_t)fr * ldb + 8 * fq;
    bf16x8 a[KS][2], b[KS][2];
#pragma unroll
    for (int ks = 0; ks < KS; ++ks)
#pragma unroll
        for (int i = 0; i < 2; ++i) { a[ks][i] = *(const bf16x8*)(ap + (size_t)i * 16 * lda + 32 * ks); b[ks][i] = *(const bf16x8*)(bp + (size_t)i * 16 * ldb + 32 * ks); }
#pragma unroll
    for (int ks = 0; ks < KS; ++ks)
#pragma unroll
        for (int mi = 0; mi < 2; ++mi)
#pragma unroll
            for (int ni = 0; ni < 2; ++ni) acc[mi][ni] = __builtin_amdgcn_mfma_f32_16x16x32_bf16(b[ks][ni], a[ks][mi], acc[mi][ni], 0, 0, 0);
}
__device__ __forceinline__ void sgk_put(const f32x4 (&acc)[2][2], LAS unsigned char* lds, int prod, int wave, int lane) {
#pragma unroll
    for (int mi = 0; mi < 2; ++mi)
#pragma unroll
        for (int ni = 0; ni < 2; ++ni) *(LAS f32x4*)(lds + (size_t)(((prod * 8 + wave) * 4 + mi * 2 + ni) * 64 + lane) * 16) = acc[mi][ni];
}
__device__ __forceinline__ f32x4 sgk_get(LAS unsigned char* lds, int prod, int tile, int ln) {
    f32x4 s = (f32x4){0.f, 0.f, 0.f, 0.f};
#pragma unroll
    for (int w = 0; w < 8; ++w) s += *(const LAS f32x4*)(lds + (size_t)(((prod * 8 + w) * 4 + tile) * 64 + ln) * 16);
    return s;
}
__device__ __forceinline__ void sg_merge_task(int ts, const bf16* YAB, const bf16* WAB_T, const bf16* PROJ, bf16* MRG, LAS unsigned char* lds, int wave) {
    int lane = (int)__builtin_amdgcn_mbcnt_hi(~0u, __builtin_amdgcn_mbcnt_lo(~0u, 0u)); asm volatile("" : "+v"(lane));
    const int tid = wave * 64 + lane;
    const int r0 = MP + 32 * (ts >> 5), n0 = 32 * (ts & 31);
    f32x4 aa[2][2], ab[2][2];
#pragma unroll
    for (int mi = 0; mi < 2; ++mi)
#pragma unroll
        for (int ni = 0; ni < 2; ++ni) { aa[mi][ni] = (f32x4){0.f, 0.f, 0.f, 0.f}; ab[mi][ni] = (f32x4){0.f, 0.f, 0.f, 0.f}; }
    sgk_mma<4>(aa, YAB + (size_t)r0 * 1536 + 128 * wave, 1536, WAB_T + (size_t)n0 * 1536 + 128 * wave, 1536, lane);
    sgk_mma<2>(ab, YAB + (size_t)r0 * 1536 + 1024 + 64 * wave, 1536, WAB_T + (size_t)n0 * 1536 + 1024 + 64 * wave, 1536, lane);
    sgk_put(aa, lds, 0, wave, lane); sgk_put(ab, lds, 1, wave, lane);
    __syncthreads();
    if (tid < 256) { const int tile = tid >> 6, ln = tid & 63; const f32x4 sa = sgk_get(lds, 0, tile, ln), sb = sgk_get(lds, 1, tile, ln);
        const size_t row = (size_t)r0 + 16 * (tile >> 1) + (ln & 15); const int col = n0 + 16 * (tile & 1) + 4 * (ln >> 4);
        const v2u ga = *(const v2u*)(PROJ + row * DIN + C_GA + col), gb = *(const v2u*)(PROJ + row * DIN + C_GB + col);
        const float m0 = sa[0] * sigm(bflo(ga.x)) + sb[0] * sigm(bflo(gb.x)), m1 = sa[1] * sigm(bfhi(ga.x)) + sb[1] * sigm(bfhi(gb.x));
        const float m2 = sa[2] * sigm(bflo(ga.y)) + sb[2] * sigm(bflo(gb.y)), m3 = sa[3] * sigm(bfhi(ga.y)) + sb[3] * sigm(bfhi(gb.y));
        v2u w; w.x = pk2(m0, m1); w.y = pk2(m2, m3); *(v2u*)(MRG + row * DM + col) = w; }
    __syncthreads();
}
__device__ __forceinline__ void sg_out_task(int ts, const bf16* MRG, const bf16* WOUT_T, bf16* OUTB, LAS unsigned char* lds, int wave) {
    int lane = (int)__builtin_amdgcn_mbcnt_hi(~0u, __builtin_amdgcn_mbcnt_lo(~0u, 0u)); asm volatile("" : "+v"(lane));
    const int tid = wave * 64 + lane;
    const int r0 = MP + 32 * (ts >> 5), n0 = 32 * (ts & 31);
    f32x4 aa[2][2];
#pragma unroll
    for (int mi = 0; mi < 2; ++mi)
#pragma unroll
        for (int ni = 0; ni < 2; ++ni) aa[mi][ni] = (f32x4){0.f, 0.f, 0.f, 0.f};
    sgk_mma<4>(aa, MRG + (size_t)r0 * DM + 128 * wave, DM, WOUT_T + (size_t)n0 * DM + 128 * wave, DM, lane);
    sgk_put(aa, lds, 0, wave, lane);
    __syncthreads();
    if (tid < 256) { const int tile = tid >> 6, ln = tid & 63; const f32x4 sa = sgk_get(lds, 0, tile, ln);
        const size_t row = (size_t)r0 + 16 * (tile >> 1) + (ln & 15); const int col = n0 + 16 * (tile & 1) + 4 * (ln >> 4);
        v2u w; w.x = pk2(sa[0], sa[1]); w.y = pk2(sa[2], sa[3]); *(v2u*)(OUTB + row * DM + col) = w; }
    __syncthreads();
}

struct Args { const float* in[19]; float* out; unsigned char* ws; };
__global__ void __launch_bounds__(NTHR, 2) fwd_kernel(Args args) {
    extern __shared__ __attribute__((aligned(16))) unsigned char lds_raw[];
    cg::grid_group grid = cg::this_grid();
    LAS unsigned char* lds = (LAS unsigned char*)lds_raw;
    const int tid = threadIdx.x, lane = tid & 63, wave = __builtin_amdgcn_readfirstlane(tid >> 6);
    const int G = gridDim.x, bx = blockIdx.x;
    const int gw = bx * NWAVES + wave, NGW = G * NWAVES;
    const float* xp = args.in[0]; const float* xs = args.in[1];
    const float* c128 = args.in[2]; const float* c512 = args.in[3]; const float* c2048 = args.in[4];
    const float* cpr = args.in[5]; const float* csm = args.in[6]; const float* wcond = args.in[7]; const float* bcond = args.in[8]; const float* gpre = args.in[9];
    const float* win = args.in[10]; const float* lng = args.in[11]; const float* lnb = args.in[12]; const float* wsp = args.in[13]; const float* bsp = args.in[14];
    const float* wpa = args.in[15]; const float* wpb = args.in[16]; const float* wout = args.in[17]; const float* gpost = args.in[18];
    float* out = args.out; unsigned char* ws = args.ws;
    bf16* WIN_T = (bf16*)(ws + WS_WIN); bf16* WAB_T = (bf16*)(ws + WS_WPA); bf16* WOUT_T = (bf16*)(ws + WS_WOUT);
    float* MOD = (float*)(ws + WS_MOD); float* VST = (float*)(ws + WS_VST); float* ML = (float*)(ws + WS_ML);
    bf16* H = (bf16*)(ws + WS_H); bf16* YAB = (bf16*)(ws + WS_YA); bf16* MRG = (bf16*)(ws + WS_MRG); bf16* O3 = (bf16*)(ws + WS_O3);
    bf16* OUTB = (bf16*)(ws + WS_OUT); bf16* PROJ = (bf16*)(ws + WS_PROJ);

    unsigned* barw = (unsigned*)(ws + 16384);
    volatile LAS unsigned* bst = (volatile LAS unsigned*)(lds + 139264);
    if (tid < 2) bst[tid] = 0u;
    __syncthreads();
    const XcdBarrier xbar = xcd_barrier_post(barw, bst);
    if (args.ws == nullptr) grid.sync();
    if (bx < 192) mod_task(bx, cpr, csm, wcond, bcond, MOD, lds, tid, wave, lane);
    {
        LAS float* scr = (LAS float*)(lds + wave * 16384);
        constexpr int I_IN = (1024 / 64) * (DIN / 32), I_PA = (1024 / 64) * (1024 / 32), I_PB = (512 / 64) * (1024 / 32), I_OUT = I_PA;
        constexpr int NITEMS = I_IN + I_PA + I_PB + I_OUT;
        for (int it = gw; it < NITEMS; it += NGW) {
            int r = it;
            if (r < I_IN) { p0_transpose_item(win, 1024, DIN, WIN_T, 1024, 0, scr, r, lane); continue; } r -= I_IN;
            if (r < I_PA) { p0_transpose_item(wpa, 1024, 1024, WAB_T, 1536, 0, scr, r, lane); continue; } r -= I_PA;
            if (r < I_PB) { p0_transpose_item(wpb, 512, 1024, WAB_T, 1536, 1024, scr, r, lane); continue; } r -= I_PB;
            p0_transpose_item(wout, 1024, 1024, WOUT_T, 1024, 0, scr, r, lane);
        }
    }
    xcd_barrier(xbar);
    for (int rb = gw; rb < MT / 8; rb += NGW) {
        const int rowb = rb * 8;
        const float* mod = MOD + (rowb < MP ? (rowb >> 11) : 8 + ((rowb - MP) >> 3)) * 3072;
        f32x4 gs[4], sh[4];
#pragma unroll
        for (int j = 0; j < 4; ++j) { const int c = 4 * lane + 256 * j; f32x4 a = (f32x4){0.f, 0.f, 0.f, 0.f}, s2 = (f32x4){1.f, 1.f, 1.f, 1.f};
#pragma unroll
            for (int q = 0; q < 4; ++q) { a += *(const f32x4*)(mod + (size_t)q * 40 * 3072 + c); s2 += *(const f32x4*)(mod + (size_t)q * 40 * 3072 + 1024 + c); }
            sh[j] = a; gs[j] = s2 * *(const f32x4*)(gpre + c); }
        const float* xb = rowb < MP ? xp + (size_t)rowb * DM : xs + (size_t)(rowb - MP) * DM;
#pragma unroll 1
        for (int i0 = 0; i0 < 8; i0 += 4) {
            f32x4 v[4][4];
#pragma unroll
            for (int i = 0; i < 4; ++i)
#pragma unroll
                for (int j = 0; j < 4; ++j) v[i][j] = ((const f32x4*)(xb + (size_t)(i0 + i) * DM))[lane + 64 * j];
#pragma unroll
            for (int i = 0; i < 4; ++i) { float ss = 0.f;
#pragma unroll
                for (int j = 0; j < 4; ++j) ss += (v[i][j][0] * v[i][j][0] + v[i][j][1] * v[i][j][1]) + (v[i][j][2] * v[i][j][2] + v[i][j][3] * v[i][j][3]);
                const float rstd = rsqrtf(wave_sum(ss) * (1.f / DM) + EPS);
#pragma unroll
                for (int j = 0; j < 4; ++j) { const int c = 4 * lane + 256 * j; const f32x4 hh = v[i][j] * rstd * gs[j] + sh[j];
                    v2u w; w.x = pk2(hh[0], hh[1]); w.y = pk2(hh[2], hh[3]); *(v2u*)(H + (size_t)(rowb + i0 + i) * DM + c) = w; } } }
    }
    xcd_barrier(xbar);
    {
        if (bx < 160) sg_proj_task(bx, H, WIN_T, PROJ, out, VST, wave, lane);
        pg8::Gemm gm{H, WIN_T, MP, DIN, DM}; pg8::StaticOrder S; S.init(MP, DIN, G, bx);
        pg8::EpiProj E{PROJ, out, VST};
        pg8::gemm_phase<pg8::EpiProj, pg8::StaticOrder, true, true>(lds, gm, S, E);
    }
    xcd_barrier(xbar);
    {
        constexpr int N_ATT = 3072, N_GM = 1024, N_SA = 768, N_SG = 32;
        const bool sa_first = false;
        if (sa_first) {
            for (int it = bx; it < N_SA; it += G) attn_sample_item(it, PROJ, c128, c512, c2048, O3, ML, wave, lane);
        }
        {
            v4u kA[4], vA[4], kB[4], vB[4]; bf16x8 qA0, qA1, qB0, qB1;
            if (bx < N_ATT) att_prefetch(bx, PROJ, tid, wave, lane, kA, vA, qA0, qA1);
            if (bx + G < N_ATT) att_prefetch(bx + G, PROJ, tid, wave, lane, kB, vB, qB0, qB1);
            LAS bf16* kdst = (LAS bf16*)lds + (tid >> 3) * 72 + (tid & 7) * 8; LAS bf16* vdst = (LAS bf16*)(lds + 36864) + (tid >> 3) * 72 + (tid & 7) * 8;
            for (int it = bx; it < N_ATT; it += 2 * G) {
                {
#pragma unroll
                    for (int c = 0; c < 4; ++c) { *(LAS v4u*)(kdst + c * 64 * 72) = kA[c]; *(LAS v4u*)(vdst + c * 64 * 72) = vA[c]; }
                    const bf16x8 Qc0 = qA0, Qc1 = qA1;
                    __syncthreads();
                    if (it + 2 * G < N_ATT) att_prefetch(it + 2 * G, PROJ, tid, wave, lane, kA, vA, qA0, qA1);
                    att_compute(it, O3, ML, lds, wave, lane, Qc0, Qc1);
                    __syncthreads();
                }
                if (it + G < N_ATT) {
#pragma unroll
                    for (int c = 0; c < 4; ++c) { *(LAS v4u*)(kdst + c * 64 * 72) = kB[c]; *(LAS v4u*)(vdst + c * 64 * 72) = vB[c]; }
                    const bf16x8 Qc0 = qB0, Qc1 = qB1;
                    __syncthreads();
                    if (it + 3 * G < N_ATT) att_prefetch(it + 3 * G, PROJ, tid, wave, lane, kB, vB, qB0, qB1);
                    att_compute(it + G, O3, ML, lds, wave, lane, Qc0, Qc1);
                    __syncthreads();
                }
            }
        }
        gmlp_phase(bx, G, N_GM, PROJ, VST, wsp, bsp, lng, lnb, YAB, lds, tid, wave, lane);
        if (!sa_first) {
            for (int it = bx; it < N_SA; it += G) attn_sample_item(it, PROJ, c128, c512, c2048, O3, ML, wave, lane);
        }
        for (int it = bx; it < N_SG; it += G) gmlp_sample_item(it, PROJ, VST, wsp, bsp, lng, lnb, YAB, out, lds, tid, wave, lane);
    }
    xcd_barrier(xbar);
    for (int row = gw; row < MT; row += NGW) {
        const int head = lane >> 3;
        float mg[3], lg[3];
#pragma unroll
        for (int g = 0; g < 3; ++g) { const f32x2 a = *(const f32x2*)(ML + (((size_t)g * MT + row) * 8 + head) * 2); mg[g] = a[0]; lg[g] = a[1]; }
        const float mm = fmaxf(fmaxf(mg[0], mg[1]), mg[2]);
        float wg[3]; float den = 0.f;
#pragma unroll
        for (int g = 0; g < 3; ++g) { wg[g] = __expf(mg[g] - mm) * lg[g]; den += wg[g]; }
        const float rden = 1.f / den;
        float o[8] = {0.f, 0.f, 0.f, 0.f, 0.f, 0.f, 0.f, 0.f};
#pragma unroll
        for (int g = 0; g < 3; ++g) { const v4u raw = *(const v4u*)(O3 + ((size_t)g * MT + row) * 512 + lane * 8); const float w = wg[g] * rden;
            o[0] += w * bflo(raw.x); o[1] += w * bfhi(raw.x); o[2] += w * bflo(raw.y); o[3] += w * bfhi(raw.y); o[4] += w * bflo(raw.z); o[5] += w * bfhi(raw.z); o[6] += w * bflo(raw.w); o[7] += w * bfhi(raw.w); }
        const v4u zr = *(const v4u*)(PROJ + (size_t)row * DIN + C_ZB + lane * 8);
        v4u w; w.x = pk2(o[0] * silu(bflo(zr.x)), o[1] * silu(bfhi(zr.x))); w.y = pk2(o[2] * silu(bflo(zr.y)), o[3] * silu(bfhi(zr.y)));
        w.z = pk2(o[4] * silu(bflo(zr.z)), o[5] * silu(bfhi(zr.z))); w.w = pk2(o[6] * silu(bflo(zr.w)), o[7] * silu(bfhi(zr.w)));
        *(v4u*)(YAB + (size_t)row * 1536 + 1024 + lane * 8) = w;
    }
    xcd_barrier(xbar);
    {
        for (int ts = bx; ts < 256; ts += G) sg_merge_task(ts, YAB, WAB_T, PROJ, MRG, lds, wave);
        pg8::Gemm gm{YAB, WAB_T, MP, DM, 1536}; pg8::StaticOrder S; S.init(MP, DM, G, bx);
        pg8::EpiMerge E{PROJ, MRG};
        pg8::gemm_phase<pg8::EpiMerge, pg8::StaticOrder, true, true>(lds, gm, S, E);
    }
    xcd_barrier(xbar);
    {
        for (int ts = bx; ts < 256; ts += G) sg_out_task(ts, MRG, WOUT_T, OUTB, lds, wave);
        pg8::Gemm gm{MRG, WOUT_T, MP, DM, DM}; pg8::StaticOrder S; S.init(MP, DM, G, bx);
        pg8::EpiF32 E{OUTB};
        pg8::gemm_phase<pg8::EpiF32, pg8::StaticOrder, true, true>(lds, gm, S, E);
    }
    xcd_barrier(xbar);
    for (int rb = gw; rb < MT / 8; rb += NGW) {
        const int rowb = rb * 8;
        const float* gate = MOD + (rowb < MP ? (rowb >> 11) : 8 + ((rowb - MP) >> 3)) * 3072 + 2048;
        f32x4 gt[4];
#pragma unroll
        for (int j = 0; j < 4; ++j) { const int c = 4 * lane + 256 * j; f32x4 a = (f32x4){0.f, 0.f, 0.f, 0.f};
#pragma unroll
            for (int q = 0; q < 4; ++q) a += *(const f32x4*)(gate + (size_t)q * 40 * 3072 + c);
            gt[j] = a * *(const f32x4*)(gpost + c); }
        const float* xb = rowb < MP ? xp + (size_t)rowb * DM : xs + (size_t)(rowb - MP) * DM;
#pragma unroll 1
        for (int i0 = 0; i0 < 8; i0 += 4) {
            v2u ov[4][4]; f32x4 xv[4][4];
#pragma unroll
            for (int i = 0; i < 4; ++i)
#pragma unroll
                for (int j = 0; j < 4; ++j) { ov[i][j] = ((const v2u*)(OUTB + (size_t)(rowb + i0 + i) * DM))[lane + 64 * j]; xv[i][j] = ((const f32x4*)(xb + (size_t)(i0 + i) * DM))[lane + 64 * j]; }
#pragma unroll
            for (int i = 0; i < 4; ++i) { f32x4 v[4]; float ss = 0.f;
#pragma unroll
                for (int j = 0; j < 4; ++j) { v[j] = (f32x4){bflo(ov[i][j].x), bfhi(ov[i][j].x), bflo(ov[i][j].y), bfhi(ov[i][j].y)}; ss += (v[j][0] * v[j][0] + v[j][1] * v[j][1]) + (v[j][2] * v[j][2] + v[j][3] * v[j][3]); }
                const float rstd = rsqrtf(wave_sum(ss) * (1.f / DM) + EPS);
#pragma unroll
                for (int j = 0; j < 4; ++j) { const int c = 4 * lane + 256 * j;
                    *(f32x4*)(out + (size_t)(rowb + i0 + i) * DM + c) = xv[i][j] + gt[j] * (v[j] * rstd); } } }
    }
}

extern "C" void kernel_launch(void* const* d_in, const int* in_sizes, int n_in, void* d_out, int out_size, void* d_ws, size_t ws_size, hipStream_t stream) {
    static int grid = 0;
    if (grid == 0) {
        if (n_in != 19 || (size_t)out_size != O_END || ws_size < WS_END) { fprintf(stderr, "kernel_launch: unexpected shapes: n_in %d out %d ws %zu\n", n_in, out_size, ws_size); grid = -1; return; }
        int dev = 0, cus = 0, per_cu = 0;
        if (hipGetDevice(&dev) != hipSuccess || hipDeviceGetAttribute(&cus, hipDeviceAttributeMultiprocessorCount, dev) != hipSuccess) { fprintf(stderr, "kernel_launch: device query failed\n"); grid = -1; return; }
        if (hipFuncSetAttribute((const void*)fwd_kernel, hipFuncAttributeMaxDynamicSharedMemorySize, LDS_BYTES) != hipSuccess) { fprintf(stderr, "kernel_launch: hipFuncSetAttribute failed\n"); grid = -1; return; }
        if (hipOccupancyMaxActiveBlocksPerMultiprocessor(&per_cu, (const void*)fwd_kernel, NTHR, LDS_BYTES) != hipSuccess || per_cu < 1) { fprintf(stderr, "kernel_launch: occupancy query says %d blocks per CU\n", per_cu); }
        (void)hipGetLastError();
        grid = cus;
    }
    if (grid < 0) return;
    if (hipMemsetAsync((char*)d_ws + 16384, 0, 16384, stream) != hipSuccess) { fprintf(stderr, "kernel_launch: memset of the barrier words failed\n"); return; }
    Args a{};
    for (int i = 0; i < 19; ++i) a.in[i] = (const float*)d_in[i];
    a.out = (float*)d_out; a.ws = (unsigned char*)d_ws;
    void* kargs[] = {&a};
    hipError_t e = hipLaunchCooperativeKernel((const void*)fwd_kernel, dim3(grid), dim3(NTHR), kargs, LDS_BYTES, stream);
    if (e != hipSuccess) fprintf(stderr, "kernel_launch: cooperative launch failed: %s (grid %d)\n", hipGetErrorString(e), grid);
}
```
